# Optimizing an MI355X kernel written in HIP

```python
import jax, jax.numpy as jnp
from jax import lax
import numpy as np

D_MODEL = 1024
BATCH = 1
SEQ = 16384
DEPTH = 2

GMLP_GROUPS = 8
GMLP_GROUP_DIM = 64
GMLP_WIDTH = GMLP_GROUPS * GMLP_GROUP_DIM
CHUNK = 128
MLA_HEADS = 8
QK_NOPE_DIM = 64
QK_ROPE_DIM = 32
V_HEAD_DIM = 64
Q_LORA_RANK = 384
KV_LORA_RANK = 256
QK_HEAD_DIM = QK_NOPE_DIM + QK_ROPE_DIM
MLA_WIDTH = MLA_HEADS * V_HEAD_DIM
ROPE_THETA = 10000.0
Q_BLOCK = 128
IN_SPLITS = (
    GMLP_WIDTH,
    2 * GMLP_WIDTH,
    2 * GMLP_WIDTH + Q_LORA_RANK,
    2 * GMLP_WIDTH + Q_LORA_RANK + KV_LORA_RANK,
    2 * GMLP_WIDTH + Q_LORA_RANK + KV_LORA_RANK + QK_ROPE_DIM,
    2 * GMLP_WIDTH + Q_LORA_RANK + KV_LORA_RANK + QK_ROPE_DIM + D_MODEL,
)
IN_TOTAL = 2 * GMLP_WIDTH + Q_LORA_RANK + KV_LORA_RANK + QK_ROPE_DIM + 2 * D_MODEL
DENSE_FF = 2752
N_EXPERTS = 8
TOP_K = 2
EXPERT_FF = 3584
MOE_BLOCK = 128
N_DENSE = (DEPTH + 1) // 2
N_MOE = DEPTH // 2
EPS = 1e-6

kernel_name = "hybrid_gmlp_mla_moe_block"


def rms_norm(x, g):
    xf = x.astype(jnp.float32)
    y = xf * lax.rsqrt(jnp.mean(xf * xf, axis=-1, keepdims=True) + EPS)
    return (y * g.astype(jnp.float32)).astype(x.dtype)


def layer_norm(x, g, b):
    xf = x.astype(jnp.float32)
    mu = jnp.mean(xf, axis=-1, keepdims=True)
    xc = xf - mu
    y = xc * lax.rsqrt(jnp.mean(xc * xc, axis=-1, keepdims=True) + EPS)
    return (y * g.astype(jnp.float32) + b.astype(jnp.float32)).astype(x.dtype)


def rope_tables(positions, dtype):
    inv_freq = 1.0 / (ROPE_THETA ** (jnp.arange(0, QK_ROPE_DIM, 2, dtype=jnp.float32) / QK_ROPE_DIM))
    ang = positions.astype(jnp.float32)[..., None] * inv_freq
    return jnp.cos(ang).astype(dtype), jnp.sin(ang).astype(dtype)


def rope(x, cos, sin):
    x1, x2 = jnp.split(x, 2, axis=-1)
    return jnp.concatenate([x1 * cos - x2 * sin, x2 * cos + x1 * sin], axis=-1)


def gmlp_spatial_gating(u, v, ln_g, ln_b, w_s, b_s):
    B, S, _ = u.shape
    u = jax.nn.gelu(u, approximate=False)
    v = layer_norm(jax.nn.gelu(v, approximate=False), ln_g, ln_b)
    vc = v.reshape(B, S // CHUNK, CHUNK, GMLP_GROUPS, GMLP_GROUP_DIM)
    causal = jnp.tril(jnp.ones((CHUNK, CHUNK), dtype=bool))
    ws = jnp.where(causal[None], w_s, jnp.zeros((), w_s.dtype))
    z = jnp.einsum('gts,bcsgd->bctgd', ws, vc) + b_s.T[None, None, :, :, None]
    return u * z.reshape(B, S, GMLP_WIDTH)


def mla_attention(c_q, c_kv, k_rope, cos, sin, q_norm, w_uq, kv_norm, w_ukv):
    B, S, _ = c_q.shape
    q = (rms_norm(c_q, q_norm) @ w_uq).reshape(B, S, MLA_HEADS, QK_HEAD_DIM)
    q_nope, q_pe = jnp.split(q, [QK_NOPE_DIM], axis=-1)
    q_pe = rope(q_pe, cos[:, :, None, :], sin[:, :, None, :])
    kv = (rms_norm(c_kv, kv_norm) @ w_ukv).reshape(B, S, MLA_HEADS, QK_NOPE_DIM + V_HEAD_DIM)
    k_nope, v = jnp.split(kv, [QK_NOPE_DIM], axis=-1)
    k_pe = rope(k_rope, cos, sin)[:, :, None, :]
    q = jnp.concatenate([q_nope, q_pe], axis=-1)
    k = jnp.concatenate([k_nope, jnp.broadcast_to(k_pe, (B, S, MLA_HEADS, QK_ROPE_DIM))], axis=-1)
    scale = QK_HEAD_DIM ** -0.5
    kpos = jnp.arange(S)

    def attend(i):
        q0 = i * Q_BLOCK
        qb = lax.dynamic_slice_in_dim(q, q0, Q_BLOCK, axis=1)
        s = jnp.einsum('bqhd,bkhd->bhqk', qb, k).astype(jnp.float32) * scale
        qpos = q0 + jnp.arange(Q_BLOCK)
        s = jnp.where(kpos[None, :] <= qpos[:, None], s, -jnp.inf)
        p = jax.nn.softmax(s, axis=-1).astype(v.dtype)
        return jnp.einsum('bhqk,bkhd->bqhd', p, v)

    o = lax.map(attend, jnp.arange(S // Q_BLOCK))
    return jnp.moveaxis(o, 0, 1).reshape(B, S, MLA_WIDTH)


def hybrid_mixer(h, cos, sin, w_in, gln_g, gln_b, g_ws, g_bs, q_norm, w_uq, kv_norm, w_ukv,
                 w_branch_a, w_branch_b, w_out):
    proj = h @ w_in
    u, v, c_q, c_kv, k_rope, gate_a, gate_b = jnp.split(proj, IN_SPLITS, axis=-1)
    y_a = gmlp_spatial_gating(u, v, gln_g, gln_b, g_ws, g_bs) @ w_branch_a
    y_b = mla_attention(c_q, c_kv, k_rope, cos, sin, q_norm, w_uq, kv_norm, w_ukv) @ w_branch_b
    merged = jax.nn.sigmoid(gate_a) * y_a + jax.nn.sigmoid(gate_b) * y_b
    return merged @ w_out


def swiglu(h, w_gate, w_up, w_down):
    return (jax.nn.silu(h @ w_gate) * (h @ w_up)) @ w_down


def moe_swiglu(h, w_router, b_router, w1, w3, w2):
    B, S, D = h.shape
    N = B * S
    xt = h.reshape(N, D)
    logits = (xt @ w_router + b_router).astype(jnp.float32)
    top_val, top_idx = lax.top_k(logits, TOP_K)
    gates = jax.nn.softmax(top_val, axis=-1).astype(h.dtype)
    A = N * TOP_K
    flat_e = top_idx.reshape(A).astype(jnp.int32)
    flat_tok = jnp.arange(A, dtype=jnp.int32) // TOP_K
    flat_g = gates.reshape(A)
    order = jnp.argsort(flat_e)
    se, stok, sg = flat_e[order], flat_tok[order], flat_g[order]
    counts = jnp.bincount(flat_e, length=N_EXPERTS).astype(jnp.int32)
    padded = ((counts + MOE_BLOCK - 1) // MOE_BLOCK) * MOE_BLOCK
    start = jnp.cumsum(counts) - counts
    pend = jnp.cumsum(padded)
    pstart = pend - padded
    dest = pstart[se] + (jnp.arange(A, dtype=jnp.int32) - start[se])
    n_blocks = (A + MOE_BLOCK - 1) // MOE_BLOCK + N_EXPERTS
    P = n_blocks * MOE_BLOCK
    buf_tok = jnp.full((P,), N, dtype=jnp.int32).at[dest].set(stok)
    buf_g = jnp.zeros((P,), h.dtype).at[dest].set(sg)
    block_e = jnp.minimum(
        jnp.searchsorted(pend, jnp.arange(n_blocks, dtype=jnp.int32) * MOE_BLOCK, side='right'),
        N_EXPERTS - 1)
    x_pad = jnp.concatenate([xt, jnp.zeros((1, D), h.dtype)], axis=0)

    def run_block(args):
        tok, e = args
        xb = x_pad[tok]
        hb = jax.nn.silu(xb @ w1[e]) * (xb @ w3[e])
        return hb @ w2[e]

    yb = lax.map(run_block, (buf_tok.reshape(n_blocks, MOE_BLOCK), block_e))
    yb = yb.reshape(P, D) * buf_g[:, None]
    out = jnp.zeros((N + 1, D), h.dtype).at[buf_tok].add(yb)[:N]
    return out.reshape(B, S, D)


def setup_inputs(seed: int = 0) -> dict:
    key = jax.random.key(seed)
    ks = iter(jax.random.split(key, 32))
    L, D = DEPTH, D_MODEL

    def nrm(shape, scale):
        return jax.random.normal(next(ks), shape, jnp.float32) * scale

    return {
        "x": nrm((BATCH, SEQ, D), 1.0),
        "c": nrm((BATCH, D), 1.0),
        "positions": jnp.broadcast_to(jnp.arange(SEQ, dtype=jnp.int32)[None, :], (BATCH, SEQ)),
        "ada_w": nrm((L, D, 6 * D), D ** -0.5),
        "ada_b": nrm((L, 6 * D), 0.02),
        "norm_mix_pre": 1.0 + nrm((L, D), 0.05),
        "norm_mix_post": 1.0 + nrm((L, D), 0.05),
        "norm_ffn_pre": 1.0 + nrm((L, D), 0.05),
        "norm_ffn_post": 1.0 + nrm((L, D), 0.05),
        "w_in": nrm((L, D, IN_TOTAL), D ** -0.5),
        "gmlp_ln_g": 1.0 + nrm((L, GMLP_WIDTH), 0.05),
        "gmlp_ln_b": nrm((L, GMLP_WIDTH), 0.02),
        "gmlp_ws": nrm((L, GMLP_GROUPS, CHUNK, CHUNK), CHUNK ** -0.5),
        "gmlp_bs": 1.0 + nrm((L, GMLP_GROUPS, CHUNK), 0.02),
        "mla_q_norm": 1.0 + nrm((L, Q_LORA_RANK), 0.05),
        "mla_w_uq": nrm((L, Q_LORA_RANK, MLA_HEADS * QK_HEAD_DIM), Q_LORA_RANK ** -0.5),
        "mla_kv_norm": 1.0 + nrm((L, KV_LORA_RANK), 0.05),
        "mla_w_ukv": nrm((L, KV_LORA_RANK, MLA_HEADS * (QK_NOPE_DIM + V_HEAD_DIM)), KV_LORA_RANK ** -0.5),
        "w_branch_a": nrm((L, GMLP_WIDTH, D), GMLP_WIDTH ** -0.5),
        "w_branch_b": nrm((L, MLA_WIDTH, D), MLA_WIDTH ** -0.5),
        "w_out": nrm((L, D, D), D ** -0.5),
        "ffn_w_gate": nrm((N_DENSE, D, DENSE_FF), D ** -0.5),
        "ffn_w_up": nrm((N_DENSE, D, DENSE_FF), D ** -0.5),
        "ffn_w_down": nrm((N_DENSE, DENSE_FF, D), DENSE_FF ** -0.5),
        "moe_router": nrm((N_MOE, D, N_EXPERTS), D ** -0.5),
        "moe_router_bias": nrm((N_MOE, N_EXPERTS), 0.01),
        "moe_w1": nrm((N_MOE, N_EXPERTS, D, EXPERT_FF), D ** -0.5),
        "moe_w3": nrm((N_MOE, N_EXPERTS, D, EXPERT_FF), D ** -0.5),
        "moe_w2": nrm((N_MOE, N_EXPERTS, EXPERT_FF, D), EXPERT_FF ** -0.5),
    }


def reference(x, c, positions, ada_w, ada_b, norm_mix_pre, norm_mix_post, norm_ffn_pre, norm_ffn_post,
              w_in, gmlp_ln_g, gmlp_ln_b, gmlp_ws, gmlp_bs, mla_q_norm, mla_w_uq, mla_kv_norm, mla_w_ukv,
              w_branch_a, w_branch_b, w_out, ffn_w_gate, ffn_w_up, ffn_w_down,
              moe_router, moe_router_bias, moe_w1, moe_w3, moe_w2):
    cos, sin = rope_tables(positions, x.dtype)
    c_act = jax.nn.silu(c)
    for l in range(DEPTH):
        mod = (c_act @ ada_w[l] + ada_b[l])[:, None, :]
        sh_m, sc_m, g_m, sh_f, sc_f, g_f = jnp.split(mod, 6, axis=-1)
        h = rms_norm(x, norm_mix_pre[l]) * (1 + sc_m) + sh_m
        y = hybrid_mixer(h, cos, sin, w_in[l], gmlp_ln_g[l], gmlp_ln_b[l], gmlp_ws[l], gmlp_bs[l],
                         mla_q_norm[l], mla_w_uq[l], mla_kv_norm[l], mla_w_ukv[l],
                         w_branch_a[l], w_branch_b[l], w_out[l])
        x = x + g_m * rms_norm(y, norm_mix_post[l])
        h = rms_norm(x, norm_ffn_pre[l]) * (1 + sc_f) + sh_f
        if l % 2 == 0:
            j = l // 2
            y = swiglu(h, ffn_w_gate[j], ffn_w_up[j], ffn_w_down[j])
        else:
            j = l // 2
            y = moe_swiglu(h, moe_router[j], moe_router_bias[j], moe_w1[j], moe_w3[j], moe_w2[j])
        x = x + g_f * rms_norm(y, norm_ffn_post[l])
    return x
```

```cpp
#include <hip/hip_runtime.h>
#include <hip/hip_bf16.h>
#include <cstdio>
#include <cstdint>
#include <cmath>
#define SWZ_XOR(x) (((x) << 10) | 0x1f)
__device__ __forceinline__ float swz_xor1(float v) { return __builtin_bit_cast(float, __builtin_amdgcn_ds_swizzle(__builtin_bit_cast(int, v), SWZ_XOR(1))); }
__device__ __forceinline__ float swz_xor2(float v) { return __builtin_bit_cast(float, __builtin_amdgcn_ds_swizzle(__builtin_bit_cast(int, v), SWZ_XOR(2))); }
__device__ __forceinline__ float swz_xor4(float v) { return __builtin_bit_cast(float, __builtin_amdgcn_ds_swizzle(__builtin_bit_cast(int, v), SWZ_XOR(4))); }
__device__ __forceinline__ float swz_xor8(float v) { return __builtin_bit_cast(float, __builtin_amdgcn_ds_swizzle(__builtin_bit_cast(int, v), SWZ_XOR(8))); }
__device__ __forceinline__ float swz_xor16(float v) { return __builtin_bit_cast(float, __builtin_amdgcn_ds_swizzle(__builtin_bit_cast(int, v), SWZ_XOR(16))); }
__device__ __forceinline__ float xsum32(float v) { auto rr = __builtin_amdgcn_permlane32_swap(__builtin_bit_cast(unsigned, v), __builtin_bit_cast(unsigned, v), false, false); return __builtin_bit_cast(float, rr[0]) + __builtin_bit_cast(float, rr[1]); }
__device__ __forceinline__ float xmax32(float v) { auto rr = __builtin_amdgcn_permlane32_swap(__builtin_bit_cast(unsigned, v), __builtin_bit_cast(unsigned, v), false, false); return fmaxf(__builtin_bit_cast(float, rr[0]), __builtin_bit_cast(float, rr[1])); }
namespace pg8 {
#define PG8_LAS __attribute__((address_space(3)))
#ifndef PG8_SP2_DEFAULT
#define PG8_SP2_DEFAULT true
#endif
#ifndef PG8_AUX
#define PG8_AUX 0
#endif
typedef unsigned short bf16_t;
typedef short bf16x8 __attribute__((ext_vector_type(8)));
typedef float f32x4 __attribute__((ext_vector_type(4)));
typedef unsigned u32x4 __attribute__((ext_vector_type(4)));
constexpr int BM = 256, BK = 64, HALF = 128, HTB = HALF * BK * 2  , STAGE_BYTES = 8 * HTB, NXCD = 8, WGM = 8;

__host__ __device__ __forceinline__ int lds_byte(int r, int c) { const int st = (r >> 4) * 2 + (c >> 5), rr = r & 15, cc = c & 31, ob = rr * 64 + cc * 2; return st * 1024 + (ob ^ (((ob >> 9) & 1) << 5)); }
__host__ __device__ __forceinline__ void stage_rc(int b, int& R, int& C) { const int st = b / 1024, sb = b % 1024, swz = sb ^ (((sb >> 9) & 1) << 5); R = (st >> 1) * 16 + swz / 64; C = (st & 1) * 32 + (swz % 64) / 2; }
__host__ __device__ __forceinline__ int perm32(int rho) { const int n = rho >> 4, i = rho & 15; return 8 * (i >> 2) + 4 * n + (i & 3); }


struct Unit { int pm, pn, aux; size_t aoff, boff; };
struct Gemm { const bf16_t* A; const bf16_t* Bt; int lda, ldb, K; };
struct StaticOrder {
    int nM, nN, nwg, G, c; size_t astep, bstep;
    __device__ void init(int M, int N, int lda, int ldb, int G_, int c_) { nM = M / BM; nN = N / BM; nwg = nM * nN; G = G_; c = c_; astep = (size_t)BM * lda * 2; bstep = (size_t)BM * ldb * 2; }
    __device__ bool next(int i, Unit& u) const {
        const long L = (long)i * G + c; if (L >= nwg) return false;
        int wgid = (int)L; { const int q = nwg / NXCD, r = nwg % NXCD, xcd = wgid % NXCD, off = wgid / NXCD; wgid = (xcd < r ? xcd * (q + 1) : r * (q + 1) + (xcd - r) * q) + off; }
        const int nig = WGM * nN, gid = wgid / nig, fm = gid * WGM, gsz = (nM - fm) < WGM ? (nM - fm) : WGM;
        u.pm = fm + ((wgid % nig) % gsz); u.pn = (wgid % nig) / gsz; u.aux = 0; u.aoff = (size_t)u.pm * astep; u.boff = (size_t)u.pn * bstep; return true;
    }
};

typedef float f32x2cv_t __attribute__((ext_vector_type(2))); typedef __bf16 bf16x2cv_t __attribute__((ext_vector_type(2)));
__device__ __forceinline__ unsigned cvt_pk_bf16(float lo, float hi) { const f32x2cv_t v = {lo, hi}; const bf16x2cv_t b = __builtin_convertvector(v, bf16x2cv_t); return __builtin_bit_cast(unsigned, b); }
typedef float f32x2 __attribute__((ext_vector_type(2)));
__device__ __forceinline__ f32x2 gelu_pk(f32x2 v) {
    const f32x2 av = __builtin_elementwise_abs(v), d = av * 0.2316418882f + 1.0f;
    f32x2 t; t.x = __builtin_amdgcn_rcpf(d.x); t.y = __builtin_amdgcn_rcpf(d.y);
    f32x2 q = t * 0.5307027145f + (-0.7265760135f); q = q * t + 0.7107068705f; q = q * t + (-0.142248368f); q = q * t + 0.127414796f; q = q * t;
    const f32x2 s = (v * v) * (-0.72134752044f);
    f32x2 e; e.x = __builtin_amdgcn_exp2f(s.x); e.y = __builtin_amdgcn_exp2f(s.y);
    const f32x2 m = v * (q * e), r = v - m;
    f32x2 o; o.x = v.x < 0.f ? m.x : r.x; o.y = v.y < 0.f ? m.y : r.y; return o;
}
template <class Epi, class Sched, bool ALIGN_EPI = true, bool SP2 = PG8_SP2_DEFAULT>
__device__ __forceinline__ void gemm_phase(PG8_LAS unsigned char* lds, const Gemm g, const Sched& S, const Epi& E, const int wave_id) {
    int ln_; asm volatile("v_mbcnt_lo_u32_b32 %0, -1, 0\n\tv_mbcnt_hi_u32_b32 %0, -1, %0" : "=v"(ln_)); const int tid_ = wave_id * 64 + ln_;
    const int tid = tid_, wid = __builtin_amdgcn_readfirstlane(tid >> 6), lane = tid & 63, wr = wid >> 2, wc = wid & 3, fr = lane & 15, fq = lane >> 4;
    const int K = g.K, nt = K / BK;
    unsigned voffA[2], voffB[2];
#pragma unroll
    for (int i = 0; i < 2; ++i) { int R, C; stage_rc(tid * 16 + i * 8192, R, C); const int Rb = Epi::PERM ? ((R & ~31) + perm32(R & 31)) : R;
        voffA[i] = (unsigned)(R * g.lda + C) * 2u; voffB[i] = (unsigned)(Rb * g.ldb + C) * 2u; }
    const size_t kstep = (size_t)(BK * 2);
    const size_t hstepA = (size_t)HALF * g.lda * 2, hstepB = (size_t)HALF * g.ldb * 2;
    const unsigned ldsw = (unsigned)wid * 1024u;
    const int aoff = lds_byte(wr * 64 + fr, fq * 8), boff = lds_byte(wc * 32 + fr, fq * 8);
#define PG8_SA(b, h) (((b) * 2 + (h)) * HTB)
#define PG8_SB(b, h) ((4 + (b) * 2 + (h)) * HTB)
#define PG8_STAGE(bufoff, gbase, voff) do { _Pragma("unroll") for (int _i = 0; _i < 2; ++_i) \
        __builtin_amdgcn_global_load_lds((const unsigned*)((const char*)(gbase) + (voff)[_i]), (PG8_LAS unsigned*)(lds + (bufoff) + ldsw + _i * 8192), 16, 0, PG8_AUX); } while (0)
#define PG8_LDA(dst, b, h) do { _Pragma("unroll") for (int m = 0; m < 4; ++m) _Pragma("unroll") for (int k = 0; k < 2; ++k) dst[m][k] = *(const PG8_LAS bf16x8*)(lds + PG8_SA(b, h) + aoff + m * 2048 + k * 1024); } while (0)
#define PG8_LDB(dst, b, h) do { _Pragma("unroll") for (int n = 0; n < 2; ++n) _Pragma("unroll") for (int k = 0; k < 2; ++k) dst[n][k] = *(const PG8_LAS bf16x8*)(lds + PG8_SB(b, h) + boff + n * 2048 + k * 1024); } while (0)
#define PG8_MMA(ai, bj, At, Bt) do { __builtin_amdgcn_s_setprio(1); _Pragma("unroll") for (int m = 0; m < 4; ++m) _Pragma("unroll") for (int n = 0; n < 2; ++n) _Pragma("unroll") for (int k = 0; k < 2; ++k) \
        acc[ai][bj][m][n] = __builtin_amdgcn_mfma_f32_16x16x32_bf16(Bt[n][k], At[m][k], acc[ai][bj][m][n], 0, 0, 0); __builtin_amdgcn_s_setprio(0); } while (0)
#define PG8_WAIT_V(n) asm volatile("s_waitcnt vmcnt(" #n ")" ::: "memory")
#define PG8_WAIT_L(n) asm volatile("s_waitcnt lgkmcnt(" #n ")" ::: "memory")
#define PG8_BAR __builtin_amdgcn_s_barrier()
#define PG8_SCHED __builtin_amdgcn_sched_barrier(0)
    Unit cur, nxt; int ui = 0;
    if (!S.next(0, cur)) return;
    f32x4 acc[2][2][4][2];
#pragma unroll
    for (int a = 0; a < 2; ++a)
#pragma unroll
        for (int b = 0; b < 2; ++b)
#pragma unroll
            for (int m = 0; m < 4; ++m)
#pragma unroll
                for (int n = 0; n < 2; ++n) acc[a][b][m][n] = (f32x4){0.f, 0.f, 0.f, 0.f};
    bf16x8 At[4][2], B0[2][2], B1[2][2];
    const char* cA = (const char*)g.A + cur.aoff; const char* cB = (const char*)g.Bt + cur.boff;
    if constexpr (SP2) {
        PG8_STAGE(PG8_SB(0, 0), cB, voffB); PG8_STAGE(PG8_SB(0, 1), cB + hstepB, voffB); PG8_STAGE(PG8_SA(0, 0), cA, voffA); PG8_STAGE(PG8_SA(0, 1), cA + hstepA, voffA);
        if (wr == 1) PG8_BAR;
        PG8_WAIT_V(2); PG8_BAR;
        PG8_STAGE(PG8_SB(1, 0), cB + kstep, voffB); PG8_STAGE(PG8_SA(1, 0), cA + kstep, voffA); PG8_STAGE(PG8_SB(1, 1), cB + hstepB + kstep, voffB);
        PG8_WAIT_V(6); PG8_BAR;
    } else {
        PG8_STAGE(PG8_SB(0, 0), cB, voffB); PG8_STAGE(PG8_SA(0, 0), cA, voffA); PG8_STAGE(PG8_SB(0, 1), cB + hstepB, voffB); PG8_STAGE(PG8_SA(0, 1), cA + hstepA, voffA);
        if (wr == 1) PG8_BAR;
        PG8_WAIT_V(4); PG8_BAR;
        PG8_STAGE(PG8_SB(1, 0), cB + kstep, voffB); PG8_STAGE(PG8_SA(1, 0), cA + kstep, voffA); PG8_STAGE(PG8_SB(1, 1), cB + hstepB + kstep, voffB);
        PG8_WAIT_V(6); PG8_BAR;
    }
    for (;;) {
        const bool has_next = S.next(ui + 1, nxt);
        const char* nA = has_next ? (const char*)g.A + nxt.aoff : cA; const char* nB = has_next ? (const char*)g.Bt + nxt.boff : cB;
        for (int t = 0; t < nt; t += 2) {
            const bool last = (t == nt - 2);
            const char* a1 = cA + (size_t)(t + 1) * kstep;
            const char* a2 = last ? nA : cA + (size_t)(t + 2) * kstep; const char* b2 = last ? nB : cB + (size_t)(t + 2) * kstep;
            const char* a3 = a2 + kstep; const char* b3 = b2 + kstep;
            if constexpr (SP2) {
            PG8_LDB(B0, 0, 0); PG8_LDB(B1, 0, 1); PG8_SCHED; PG8_LDA(At, 0, 0); PG8_STAGE(PG8_SA(1, 1), a1 + hstepA, voffA);
            PG8_WAIT_V(8); PG8_WAIT_L(0); PG8_BAR; PG8_MMA(0, 0, At, B0); PG8_MMA(0, 1, At, B1); PG8_BAR; PG8_SCHED;
            PG8_LDA(At, 0, 1); PG8_STAGE(PG8_SB(0, 0), b2, voffB); PG8_STAGE(PG8_SB(0, 1), b2 + hstepB, voffB); PG8_STAGE(PG8_SA(0, 0), a2, voffA);
            PG8_WAIT_V(8); PG8_WAIT_L(0); PG8_BAR; PG8_MMA(1, 0, At, B0); PG8_MMA(1, 1, At, B1); PG8_BAR; PG8_SCHED;
            PG8_LDB(B0, 1, 0); PG8_LDB(B1, 1, 1); PG8_SCHED; PG8_LDA(At, 1, 0); PG8_STAGE(PG8_SA(0, 1), a2 + hstepA, voffA);
            PG8_WAIT_V(8); PG8_WAIT_L(0); PG8_BAR; PG8_MMA(0, 0, At, B0); PG8_MMA(0, 1, At, B1); PG8_BAR; PG8_SCHED;
            PG8_LDA(At, 1, 1); PG8_STAGE(PG8_SB(1, 0), b3, voffB); PG8_STAGE(PG8_SB(1, 1), b3 + hstepB, voffB); PG8_STAGE(PG8_SA(1, 0), a3, voffA);
            PG8_WAIT_V(8); PG8_WAIT_L(0); PG8_BAR; PG8_MMA(1, 0, At, B0); PG8_MMA(1, 1, At, B1); PG8_BAR; PG8_SCHED;
            } else {
            PG8_LDB(B0, 0, 0); PG8_SCHED; PG8_LDA(At, 0, 0); PG8_STAGE(PG8_SA(1, 1), a1 + hstepA, voffA);
            PG8_WAIT_L(8); PG8_BAR; PG8_WAIT_L(0); PG8_MMA(0, 0, At, B0); PG8_BAR; PG8_SCHED;
            PG8_LDB(B1, 0, 1); PG8_STAGE(PG8_SB(0, 0), b2, voffB);
            PG8_BAR; PG8_WAIT_L(0); PG8_MMA(0, 1, At, B1); PG8_BAR;
            PG8_LDA(At, 0, 1); PG8_STAGE(PG8_SA(0, 0), a2, voffA);
            PG8_BAR; PG8_WAIT_L(0); PG8_MMA(1, 0, At, B0); PG8_BAR; PG8_SCHED;
            PG8_STAGE(PG8_SB(0, 1), b2 + hstepB, voffB);
            PG8_WAIT_V(6); PG8_BAR; PG8_MMA(1, 1, At, B1); PG8_BAR;
            PG8_LDB(B0, 1, 0); PG8_SCHED; PG8_LDA(At, 1, 0); PG8_STAGE(PG8_SA(0, 1), a2 + hstepA, voffA);
            PG8_WAIT_L(8); PG8_BAR; PG8_WAIT_L(0); PG8_MMA(0, 0, At, B0); PG8_BAR; PG8_SCHED;
            PG8_LDB(B1, 1, 1); PG8_STAGE(PG8_SB(1, 0), b3, voffB);
            PG8_BAR; PG8_WAIT_L(0); PG8_MMA(0, 1, At, B1); PG8_BAR;
            PG8_LDA(At, 1, 1); PG8_STAGE(PG8_SA(1, 0), a3, voffA);
            PG8_BAR; PG8_WAIT_L(0); PG8_MMA(1, 0, At, B0); PG8_BAR; PG8_SCHED;
            PG8_STAGE(PG8_SB(1, 1), b3 + hstepB, voffB);
            PG8_WAIT_V(6); PG8_BAR; PG8_MMA(1, 1, At, B1); PG8_BAR;
            }
        }
        if constexpr (ALIGN_EPI) { if (wr == 0) PG8_BAR; }
        if constexpr (!Epi::AFTER_DRAIN) { E(acc, cur, wr, wc, fr, fq); }
        if (!has_next) break;
#pragma unroll
        for (int a = 0; a < 2; ++a)
#pragma unroll
            for (int b = 0; b < 2; ++b)
#pragma unroll
                for (int m = 0; m < 4; ++m)
#pragma unroll
                    for (int n = 0; n < 2; ++n) acc[a][b][m][n] = (f32x4){0.f, 0.f, 0.f, 0.f};
        cur = nxt; cA = nA; cB = nB; ++ui;
        if constexpr (ALIGN_EPI) { if (wr == 1) PG8_BAR; }
    }
    PG8_WAIT_V(0);
    if constexpr (!ALIGN_EPI) { if (wr == 0) PG8_BAR; }
    PG8_BAR;

#undef PG8_SA
#undef PG8_SB
#undef PG8_STAGE
#undef PG8_LDA
#undef PG8_LDB
#undef PG8_MMA
#undef PG8_WAIT_V
#undef PG8_WAIT_L
#undef PG8_BAR
#undef PG8_SCHED
}
typedef unsigned u32x4_t __attribute__((ext_vector_type(4)));
__device__ __forceinline__ u32x4_t pack8(const f32x4& v0, const f32x4& v1) { u32x4_t w; w.x = cvt_pk_bf16(v0[0], v0[1]); w.y = cvt_pk_bf16(v0[2], v0[3]); w.z = cvt_pk_bf16(v1[0], v1[1]); w.w = cvt_pk_bf16(v1[2], v1[3]); return w; }
__device__ __forceinline__ float bf_lo(unsigned w) { return __uint_as_float(w << 16); }
__device__ __forceinline__ float bf_hi(unsigned w) { return __uint_as_float(w & 0xffff0000u); }
__device__ __forceinline__ void unpack8(const u32x4_t& w, f32x4& v0, f32x4& v1) { v0 = (f32x4){bf_lo(w.x), bf_hi(w.x), bf_lo(w.y), bf_hi(w.y)}; v1 = (f32x4){bf_lo(w.z), bf_hi(w.z), bf_lo(w.w), bf_hi(w.w)}; }
__device__ __forceinline__ float sigmoidf_(float x) { return __builtin_amdgcn_rcpf(1.0f + __builtin_amdgcn_exp2f(-1.4426950408889634f * x)); }
__device__ __forceinline__ f32x4 gelu4(const f32x4& v) { const f32x2 a = gelu_pk((f32x2){v[0], v[1]}), b = gelu_pk((f32x2){v[2], v[3]}); return (f32x4){a.x, a.y, b.x, b.y}; }
__device__ __forceinline__ f32x4 sig4(const f32x4& v) { return (f32x4){sigmoidf_(v[0]), sigmoidf_(v[1]), sigmoidf_(v[2]), sigmoidf_(v[3])}; }
__device__ __forceinline__ float sum4(const f32x4& v) { return (v[0] + v[1]) + (v[2] + v[3]); }
__device__ __forceinline__ float red_fq(float s) { s += swz_xor16(s); return xsum32(s); }

struct EpiProj {
    static constexpr bool PERM = true, AFTER_DRAIN = false;
    bf16_t* P; bf16_t* KPE; float* sumv; float* ssqv; float* ssqq; float* ssqkv; const float* cosT; const float* sinT;
    __device__ __forceinline__ void operator()(const f32x4 (&acc)[2][2][4][2], const Unit& u, int wr, int wc, int fr, int fq) const {
        const int row0 = u.pm * BM + wr * 64 + fr, col0 = u.pn * BM + wc * 32 + 8 * fq, pn = u.pn;
#pragma unroll
        for (int ai = 0; ai < 2; ++ai)
#pragma unroll
            for (int m = 0; m < 4; ++m) {
                const int row = row0 + ai * HALF + m * 16; bf16_t* rowp = P + (size_t)row * 3840 + col0;
                if (pn < 4) {
                    float s = 0.f, q = 0.f;
#pragma unroll
                    for (int bj = 0; bj < 2; ++bj) { const f32x4 v0 = gelu4(acc[ai][bj][m][0]), v1 = gelu4(acc[ai][bj][m][1]); *(u32x4_t*)(rowp + bj * HALF) = pack8(v0, v1);
                        s += sum4(v0) + sum4(v1); q += sum4(v0 * v0) + sum4(v1 * v1); }
                    if (pn >= 2) { s = red_fq(s); q = red_fq(q); if (fq == 0) { sumv[row * 8 + (pn - 2) * 4 + wc] = s; ssqv[row * 8 + (pn - 2) * 4 + wc] = q; } }
                } else if (pn < 12) {
#pragma unroll
                    for (int bj = 0; bj < 2; ++bj) *(u32x4_t*)(rowp + bj * HALF) = pack8(sig4(acc[ai][bj][m][0]), sig4(acc[ai][bj][m][1]));
                } else if (pn < 14) {
                    float q = 0.f;
#pragma unroll
                    for (int bj = 0; bj < 2; ++bj) { const f32x4 v0 = acc[ai][bj][m][0], v1 = acc[ai][bj][m][1]; *(u32x4_t*)(rowp + bj * HALF) = pack8(v0, v1); q += sum4(v0 * v0) + sum4(v1 * v1); }
                    q = red_fq(q); if (fq == 0) { if (pn == 12) ssqkv[row * 4 + wc] = q; else ssqq[row * 8 + wc] = q; }
                } else {
                    { const f32x4 v0 = acc[ai][0][m][0], v1 = acc[ai][0][m][1]; *(u32x4_t*)(rowp) = pack8(v0, v1); float q = sum4(v0 * v0) + sum4(v1 * v1); q = red_fq(q); if (fq == 0) ssqq[row * 8 + 4 + wc] = q; }
                    if (wc == 0) { const f32x4 v0 = acc[ai][1][m][0], v1 = acc[ai][1][m][1];
                        const f32x4 cs = *(const f32x4*)(cosT + (size_t)row * 16 + 4 * fq), sn = *(const f32x4*)(sinT + (size_t)row * 16 + 4 * fq);
                        const f32x4 o0 = (f32x4){v0[0] * cs[0] - v0[1] * sn[0], v0[1] * cs[0] + v0[0] * sn[0], v0[2] * cs[1] - v0[3] * sn[1], v0[3] * cs[1] + v0[2] * sn[1]};
                        const f32x4 o1 = (f32x4){v1[0] * cs[2] - v1[1] * sn[2], v1[1] * cs[2] + v1[0] * sn[2], v1[2] * cs[3] - v1[3] * sn[3], v1[3] * cs[3] + v1[2] * sn[3]};
                        *(u32x4_t*)(KPE + (size_t)row * 32 + 8 * fq) = pack8(o0, o1); }
                }
#ifndef DIAG_NOFENCE
                asm volatile("" ::: "memory");
#endif
            }
    }
};
struct EpiQ {
    static constexpr bool PERM = true, AFTER_DRAIN = false;
    bf16_t* Q; const float* ssqq; const float* cosT; const float* sinT; float c2;
    __device__ __forceinline__ void operator()(const f32x4 (&acc)[2][2][4][2], const Unit& u, int wr, int wc, int fr, int fq) const {
        const int row0 = u.pm * BM + wr * 64 + fr, col0 = u.pn * BM + wc * 32 + 8 * fq;
#pragma unroll
        for (int ai = 0; ai < 2; ++ai)
#pragma unroll
            for (int m = 0; m < 4; ++m) {
                const int row = row0 + ai * HALF + m * 16; const f32x4 qa = *(const f32x4*)(ssqq + row * 8), qb = *(const f32x4*)(ssqq + row * 8 + 4);
                const float sc = c2 * __builtin_amdgcn_rsqf((((qa[0] + qa[1]) + (qa[2] + qa[3])) + ((qb[0] + qb[1]) + (qb[2] + qb[3]))) * (1.0f / 384.0f) + 1e-6f);
#pragma unroll
                for (int bj = 0; bj < 2; ++bj) { const int c = col0 + bj * HALF, off = c % 96; f32x4 v0 = acc[ai][bj][m][0] * sc, v1 = acc[ai][bj][m][1] * sc;
                    if (off >= 64) { const int j0 = (off - 64) >> 1; const f32x4 cs = *(const f32x4*)(cosT + (size_t)row * 16 + j0), sn = *(const f32x4*)(sinT + (size_t)row * 16 + j0);
                        const f32x4 o0 = (f32x4){v0[0] * cs[0] - v0[1] * sn[0], v0[1] * cs[0] + v0[0] * sn[0], v0[2] * cs[1] - v0[3] * sn[1], v0[3] * cs[1] + v0[2] * sn[1]};
                        const f32x4 o1 = (f32x4){v1[0] * cs[2] - v1[1] * sn[2], v1[1] * cs[2] + v1[0] * sn[2], v1[2] * cs[3] - v1[3] * sn[3], v1[3] * cs[3] + v1[2] * sn[3]};
                        v0 = o0; v1 = o1; }
                    *(u32x4_t*)(Q + (size_t)row * 768 + c) = pack8(v0, v1); }
                asm volatile("" ::: "memory");
            }
    }
};
struct EpiKV {
    static constexpr bool PERM = true, AFTER_DRAIN = false;
    bf16_t* KN; bf16_t* VV; const float* ssqkv;
    __device__ __forceinline__ void operator()(const f32x4 (&acc)[2][2][4][2], const Unit& u, int wr, int wc, int fr, int fq) const {
        const int row0 = u.pm * BM + wr * 64 + fr, col0 = (u.pn & 1) * BM + wc * 32 + 8 * fq; bf16_t* base = (u.pn < 2) ? KN : VV;
#pragma unroll
        for (int ai = 0; ai < 2; ++ai)
#pragma unroll
            for (int m = 0; m < 4; ++m) {
                const int row = row0 + ai * HALF + m * 16; const f32x4 qa = *(const f32x4*)(ssqkv + row * 4); const float sc = __builtin_amdgcn_rsqf(((qa[0] + qa[1]) + (qa[2] + qa[3])) * (1.0f / 256.0f) + 1e-6f);
#pragma unroll
                for (int bj = 0; bj < 2; ++bj) *(u32x4_t*)(base + (size_t)row * 512 + col0 + bj * HALF) = pack8(acc[ai][bj][m][0] * sc, acc[ai][bj][m][1] * sc);
                asm volatile("" ::: "memory");
            }
    }
};
template <int MODE> struct EpiGate {
    static constexpr bool PERM = true, AFTER_DRAIN = false;
    bf16_t* O; const bf16_t* G;
    __device__ __forceinline__ void operator()(const f32x4 (&acc)[2][2][4][2], const Unit& u, int wr, int wc, int fr, int fq) const {
        const int row0 = u.pm * BM + wr * 64 + fr, col0 = u.pn * BM + wc * 32 + 8 * fq;
#pragma unroll
        for (int ai = 0; ai < 2; ++ai)
#pragma unroll
            for (int m = 0; m < 4; ++m) {
                const int row = row0 + ai * HALF + m * 16;
#pragma unroll
                for (int bj = 0; bj < 2; ++bj) { const int c = col0 + bj * HALF; f32x4 g0, g1; unpack8(*(const u32x4_t*)(G + (size_t)row * 3840 + c), g0, g1);
                    f32x4 v0 = acc[ai][bj][m][0] * g0, v1 = acc[ai][bj][m][1] * g1;
                    if (MODE == 1) { f32x4 t0, t1; unpack8(*(const u32x4_t*)(O + (size_t)row * 1024 + c), t0, t1); v0 += t0; v1 += t1; }
                    *(u32x4_t*)(O + (size_t)row * 1024 + c) = pack8(v0, v1); }
                asm volatile("" ::: "memory");
            }
    }
};
struct EpiPlain {
    static constexpr bool PERM = true, AFTER_DRAIN = false;
    bf16_t* O; int ldc;
    __device__ __forceinline__ void operator()(const f32x4 (&acc)[2][2][4][2], const Unit& u, int wr, int wc, int fr, int fq) const {
        const int row0 = u.pm * BM + wr * 64 + fr, col0 = u.pn * BM + wc * 32 + 8 * fq;
#pragma unroll
        for (int ai = 0; ai < 2; ++ai)
#pragma unroll
            for (int m = 0; m < 4; ++m) {
                const int row = row0 + ai * HALF + m * 16;
#pragma unroll
                for (int bj = 0; bj < 2; ++bj) *(u32x4_t*)(O + (size_t)row * ldc + col0 + bj * HALF) = pack8(acc[ai][bj][m][0], acc[ai][bj][m][1]);
            }
    }
};
struct EpiSwiGLU {
    static constexpr bool PERM = true, AFTER_DRAIN = false;
    bf16_t* O; int ldc;
    __device__ __forceinline__ void operator()(const f32x4 (&acc)[2][2][4][2], const Unit& u, int wr, int wc, int fr, int fq) const {
        const int row0 = u.pm * BM + wr * 64 + fr, col0 = u.pn * HALF + wc * 32 + 8 * fq;
#pragma unroll
        for (int ai = 0; ai < 2; ++ai)
#pragma unroll
            for (int m = 0; m < 4; ++m) {
                const int row = row0 + ai * HALF + m * 16;
                const f32x4 g0 = acc[ai][0][m][0], g1 = acc[ai][0][m][1];
#ifdef DIAG_NOSIG
#if DIAG_NOSIG == 2
                const f32x4 v0 = g0, v1 = g1;
#elif DIAG_NOSIG == 3
                const f32x4 v0 = acc[ai][1][m][0], v1 = acc[ai][1][m][1];
#else
                const f32x4 v0 = g0 * acc[ai][1][m][0], v1 = g1 * acc[ai][1][m][1];
#endif
#else
                const f32x4 v0 = g0 * sig4(g0) * acc[ai][1][m][0], v1 = g1 * sig4(g1) * acc[ai][1][m][1];
#endif
#ifdef DIAG_SWIGLU_WIDE
#ifndef DIAG_WIDE_SHIFT
#define DIAG_WIDE_SHIFT 0
#endif
                *(u32x4_t*)(O + (size_t)row * (2 * ldc) + u.pn * BM + DIAG_WIDE_SHIFT + wc * 32 + 8 * fq) = pack8(v0, v1);
#ifndef DIAG_WIDE_8
                *(u32x4_t*)(O + (size_t)row * (2 * ldc) + u.pn * BM + wc * 32 + 8 * fq + HALF) = pack8(acc[ai][1][m][0], acc[ai][1][m][1]);
#endif
#else
                *(u32x4_t*)(O + (size_t)row * ldc + col0) = pack8(v0, v1);
#endif
#ifdef DIAG_STORE_NOP
                asm volatile("s_nop 7\n\ts_nop 7" ::: "memory");
#endif
            }
    }
};
struct EpiMoeDown {
    static constexpr bool PERM = true, AFTER_DRAIN = false;
    bf16_t* Y2; const int* dest; const float* gate;
    __device__ __forceinline__ void operator()(const f32x4 (&acc)[2][2][4][2], const Unit& u, int wr, int wc, int fr, int fq) const {
        const int row0 = u.aux * BM + wr * 64 + fr, col0 = u.pn * BM + wc * 32 + 8 * fq;
#pragma unroll
        for (int ai = 0; ai < 2; ++ai)
#pragma unroll
            for (int m = 0; m < 4; ++m) {
                const int p = row0 + ai * HALF + m * 16; const int d = dest[p]; const float g = gate[p];
                if (d >= 0) {
#pragma unroll
                    for (int bj = 0; bj < 2; ++bj) *(u32x4_t*)(Y2 + (size_t)d * 1024 + col0 + bj * HALF) = pack8(acc[ai][bj][m][0] * g, acc[ai][bj][m][1] * g); }
                asm volatile("" ::: "memory");
            }
    }
};
}
namespace attn1 {
using bf16x8 = __attribute__((ext_vector_type(8))) short;
using s16x4 = __attribute__((ext_vector_type(4))) short;
using f32x16 = __attribute__((ext_vector_type(16))) float;
using u32x4 = __attribute__((ext_vector_type(4))) unsigned;
typedef short v4i16_t __attribute__((ext_vector_type(4)));
typedef __attribute__((address_space(3))) unsigned char* lptr;
constexpr int KSLOT = 12288, VSLOT = 8192;
constexpr int L_K = 0, L_V = 2 * KSLOT, L_WS = L_V + 2 * VSLOT, L_OST = L_WS + 8 * 256, L_BYTES = L_OST + 8 * 4096;
__device__ __forceinline__ int crow(int r, int hi) { return (r & 3) + 8 * (r >> 2) + 4 * hi; }
__device__ __forceinline__ unsigned cvtpk(float lo, float hi) { return pg8::cvt_pk_bf16(lo, hi); }
#define ATT_MFMA(a, b, c) __builtin_amdgcn_mfma_f32_32x32x16_bf16(a, b, c, 0, 0, 0)
__device__ __forceinline__ void attn_unit(int h, int qb, const unsigned short* Q, const unsigned short* KN, const unsigned short* KPE, const unsigned short* VV, unsigned short* O, lptr L, const int wave_id) {
    int ln_; asm volatile("v_mbcnt_lo_u32_b32 %0, -1, 0\n\tv_mbcnt_hi_u32_b32 %0, -1, %0" : "=v"(ln_)); const int tid_ = wave_id * 64 + ln_;
    const int tid = tid_, lane = tid & 63, r32 = lane & 31, hi = lane >> 5; const int wid = __builtin_amdgcn_readfirstlane(tid >> 6);
    const int q0 = qb * 256, qrow = q0 + wid * 32 + r32;
    bf16x8 qr[6];
#pragma unroll
    for (int s = 0; s < 6; ++s) qr[s] = *(const bf16x8*)(Q + (size_t)qrow * 768 + h * 96 + s * 16 + hi * 8);
    const int NT = 4 * qb + 4;
    const unsigned short* kn_src = KN + (size_t)lane * 512 + h * 64 + wid * 8;
    const unsigned short* kp_src = KPE + (size_t)lane * 32 + (wid & 3) * 8;
    const unsigned short* v_src = VV + (size_t)(16 * (wid & 3) + (lane >> 2)) * 512 + h * 64 + (wid >> 2) * 32 + (lane & 3) * 8;
    const int kn_dst = L_K + wid * 1024 + lane * 16, kp_dst = L_K + (8 + (wid & 3)) * 1024 + lane * 16, v_dst = L_V + wid * 1024 + lane * 16;
    u32x4 rk = *(const u32x4*)kn_src, rp = *(const u32x4*)kp_src, rv = *(const u32x4*)v_src;
    float mrun = -INFINITY, lrun = 0.f; f32x16 o0 = {}, o1 = {};
    __attribute__((address_space(3))) float* wsf = (__attribute__((address_space(3))) float*)(L + L_WS) + wid * 64;
    const int vrd = ((lane >> 4) & 1) * 32 + (lane & 3) * 8 + (4 * hi + ((lane & 15) >> 2)) * 64;
    for (int t = 0; t < NT; ++t) {
        const int kb = (t & 1) * KSLOT, vb = (t & 1) * VSLOT;
        *(__attribute__((address_space(3))) u32x4*)(L + kb + kn_dst) = rk;
        if (wid < 4) *(__attribute__((address_space(3))) u32x4*)(L + kb + kp_dst) = rp;
        *(__attribute__((address_space(3))) u32x4*)(L + vb + v_dst) = rv;
        __syncthreads();
        if (t + 1 < NT) { const size_t adv = (size_t)(t + 1) * 64; rk = *(const u32x4*)(kn_src + adv * 512); rp = *(const u32x4*)(kp_src + adv * 32); rv = *(const u32x4*)(v_src + adv * 512); }
        if (64 * t > q0 + wid * 32 + 31) continue;
        f32x16 p0 = {}, p1 = {};
#pragma unroll
        for (int s = 0; s < 6; ++s) {
            const bf16x8 k0 = *(const __attribute__((address_space(3))) bf16x8*)(L + kb + L_K + (2 * s + hi) * 1024 + r32 * 16);
            const bf16x8 k1 = *(const __attribute__((address_space(3))) bf16x8*)(L + kb + L_K + (2 * s + hi) * 1024 + 512 + r32 * 16);
            p0 = ATT_MFMA(k0, qr[s], p0); p1 = ATT_MFMA(k1, qr[s], p1);
        }
        if (64 * t + 63 > q0 + wid * 32) {
#pragma unroll
            for (int r = 0; r < 16; ++r) { const int kv = 64 * t + crow(r, hi); if (kv > qrow) p0[r] = -INFINITY; if (kv + 32 > qrow) p1[r] = -INFINITY; }
        }
        float rm = fmaxf(p0[0], p1[0]);
#pragma unroll
        for (int r = 1; r < 16; ++r) rm = fmaxf(rm, fmaxf(p0[r], p1[r]));
        rm = xmax32(rm);
        const float mnew = fmaxf(mrun, rm), alpha = __builtin_amdgcn_exp2f(mrun - mnew);
        float rs = 0.f;
#pragma unroll
        for (int r = 0; r < 16; ++r) { p0[r] = __builtin_amdgcn_exp2f(p0[r] - mnew); p1[r] = __builtin_amdgcn_exp2f(p1[r] - mnew); rs += p0[r] + p1[r]; }
        rs = xsum32(rs);
        lrun = lrun * alpha + rs; mrun = mnew;
        if (hi == 0) wsf[r32] = alpha;
        u32x4 pw0, pw1, pw2, pw3;
        pw0 = (u32x4){cvtpk(p0[0], p0[1]), cvtpk(p0[2], p0[3]), cvtpk(p0[4], p0[5]), cvtpk(p0[6], p0[7])};
        pw1 = (u32x4){cvtpk(p0[8], p0[9]), cvtpk(p0[10], p0[11]), cvtpk(p0[12], p0[13]), cvtpk(p0[14], p0[15])};
        pw2 = (u32x4){cvtpk(p1[0], p1[1]), cvtpk(p1[2], p1[3]), cvtpk(p1[4], p1[5]), cvtpk(p1[6], p1[7])};
        pw3 = (u32x4){cvtpk(p1[8], p1[9]), cvtpk(p1[10], p1[11]), cvtpk(p1[12], p1[13]), cvtpk(p1[14], p1[15])};
        __builtin_amdgcn_fence(__ATOMIC_RELEASE, "wavefront"); __builtin_amdgcn_wave_barrier(); __builtin_amdgcn_fence(__ATOMIC_ACQUIRE, "wavefront");
#pragma unroll
        for (int r = 0; r < 16; ++r) { const float a = wsf[crow(r, hi)]; o0[r] *= a; o1[r] *= a; }
        const bf16x8 pa[4] = {__builtin_bit_cast(bf16x8, pw0), __builtin_bit_cast(bf16x8, pw1), __builtin_bit_cast(bf16x8, pw2), __builtin_bit_cast(bf16x8, pw3)};
#pragma unroll
        for (int ks = 0; ks < 4; ++ks) {
#pragma unroll
            for (int d0 = 0; d0 < 2; ++d0) {
                const s16x4 lo = __builtin_bit_cast(s16x4, __builtin_amdgcn_ds_read_tr16_b64_v4i16((__attribute__((address_space(3))) v4i16_t*)(L + vb + L_V + vrd + d0 * 4096 + ks * 1024)));
                const s16x4 hh = __builtin_bit_cast(s16x4, __builtin_amdgcn_ds_read_tr16_b64_v4i16((__attribute__((address_space(3))) v4i16_t*)(L + vb + L_V + vrd + d0 * 4096 + ks * 1024 + 512)));
                const bf16x8 vf = (bf16x8){lo[0], lo[1], lo[2], lo[3], hh[0], hh[1], hh[2], hh[3]};
                if (d0 == 0) o0 = ATT_MFMA(pa[ks], vf, o0); else o1 = ATT_MFMA(pa[ks], vf, o1);
            }
        }
        __builtin_amdgcn_wave_barrier();
    }
    __syncthreads();
    if (hi == 0) wsf[r32] = 1.0f / lrun;
    __builtin_amdgcn_fence(__ATOMIC_RELEASE, "wavefront"); __builtin_amdgcn_wave_barrier(); __builtin_amdgcn_fence(__ATOMIC_ACQUIRE, "wavefront");
    __attribute__((address_space(3))) unsigned short* stg = (__attribute__((address_space(3))) unsigned short*)(L + L_OST) + wid * 2048;
#pragma unroll
    for (int r = 0; r < 16; ++r) { const int orow = crow(r, hi); const float a = wsf[orow];
        stg[orow * 64 + r32] = (unsigned short)(cvtpk(o0[r] * a, 0.f) & 0xffffu); stg[orow * 64 + 32 + r32] = (unsigned short)(cvtpk(o1[r] * a, 0.f) & 0xffffu); }
    __builtin_amdgcn_fence(__ATOMIC_RELEASE, "wavefront"); __builtin_amdgcn_wave_barrier(); __builtin_amdgcn_fence(__ATOMIC_ACQUIRE, "wavefront");
    unsigned short* Ow = O + (size_t)(q0 + wid * 32) * 512 + h * 64;
#pragma unroll
    for (int i = 0; i < 4; ++i) { const int row = i * 8 + (lane >> 3), ch = lane & 7; const u32x4 v = *(const __attribute__((address_space(3))) u32x4*)(stg + row * 64 + ch * 8); *(u32x4*)(Ow + (size_t)row * 512 + ch * 8) = v; }
    __syncthreads();
}
#undef ATT_MFMA
}
#define GAS __attribute__((address_space(1)))
#define LAS __attribute__((address_space(3)))
typedef unsigned short bf16;
typedef unsigned v4u __attribute__((ext_vector_type(4)));
typedef float f32x4 __attribute__((ext_vector_type(4)));
typedef short bf16x8 __attribute__((ext_vector_type(8)));
typedef GAS unsigned gu32;
typedef GAS unsigned long long gu64;
#define RLX_AGENT __ATOMIC_RELAXED, __HIP_MEMORY_SCOPE_AGENT
#define LDS_WAIT() asm volatile("s_waitcnt lgkmcnt(0)" ::: "memory")
#define VM_WAIT() asm volatile("s_waitcnt vmcnt(0)" ::: "memory")
__device__ __forceinline__ unsigned long long rt() { return __builtin_amdgcn_s_memrealtime(); }
__device__ __forceinline__ unsigned f2bf(float f) { unsigned u = __builtin_bit_cast(unsigned, f); return (u + 0x7fffu + ((u >> 16) & 1u)) >> 16; }
__device__ __forceinline__ unsigned pk2(float lo, float hi) { return f2bf(lo) | (f2bf(hi) << 16); }

#define XB_TMO      128
#define XB_XCNT(j)  (256  + 64 * (j))
#define XB_XSUB(j)  (1280 + 64 * (j))
#define XB_XGEN(j)  (2304 + 64 * (j))
#define XB_TOP      3328
#define XB_TOPGEN   3392
#define XCD_BAR_WORDS 3456
#define XB_SPIN_CAP (1u << 18)

__device__ __forceinline__ unsigned xb_ld(unsigned* p)              { return __hip_atomic_load(p, __ATOMIC_RELAXED, __HIP_MEMORY_SCOPE_AGENT); }
__device__ __forceinline__ unsigned xb_add(unsigned* p, unsigned v) { return __hip_atomic_fetch_add(p, v, __ATOMIC_RELAXED, __HIP_MEMORY_SCOPE_AGENT); }
__device__ __forceinline__ unsigned xb_xcc_id() { return (unsigned)__builtin_amdgcn_s_getreg((3 << 11) | 20) & 0xFu; }
#define XB_SPIN(cond, bar) do { unsigned _sp = 0; while (cond) { __builtin_amdgcn_s_sleep(1); \
    if ((++_sp & 255u) == 0u) { if (xb_ld(&(bar)[XB_TMO])) break; if (_sp > XB_SPIN_CAP) { atomicAdd(&(bar)[XB_TMO], 1u); break; } } } } while (0)

struct XcdBarrier {
    unsigned* bar; unsigned x;
    volatile LAS unsigned* st;
};

__device__ __forceinline__ XcdBarrier xcd_barrier_post(unsigned* bar, volatile LAS unsigned* st) {
    XcdBarrier b; b.bar = bar; b.x = xb_xcc_id(); b.st = st;
    if (threadIdx.x == 0) (void)xb_add(&bar[XB_XCNT(b.x)], 1u);
    return b;
}
__device__ __forceinline__ void xcd_barrier_complete(unsigned* bar, unsigned x, unsigned& nloc, unsigned& nx) {
    const unsigned G = gridDim.x * gridDim.y * gridDim.z;
    unsigned sum, cnt, mine, sp = 0u;
    for (;;) {
        sum = 0u; cnt = 0u; mine = 0u;
#pragma unroll
        for (unsigned j = 0; j < 16; ++j) { const unsigned c = xb_ld(&bar[XB_XCNT(j)]); sum += c; cnt += (c > 0u) ? 1u : 0u; mine = (j == x) ? c : mine; }
        if (sum == G) break;
        __builtin_amdgcn_s_sleep(1);
        if ((++sp & 255u) == 0u) { if (xb_ld(&bar[XB_TMO])) break; if (sp > XB_SPIN_CAP) { atomicAdd(&bar[XB_TMO], 1u); break; } }
    }
    nloc = mine > 0u ? mine : 1u; nx = cnt > 0u ? cnt : 1u;
}

__device__ __forceinline__ void xcd_barrier(const XcdBarrier& b, const bool leader  ) {
    asm volatile("s_waitcnt vmcnt(0)" ::: "memory");
    __syncthreads();
    if (leader) {
        unsigned* bar = b.bar;
        __builtin_amdgcn_s_waitcnt(0);
        unsigned nloc = b.st[0], nx = b.st[1];
        if (nloc == 0u) { xcd_barrier_complete(bar, b.x, nloc, nx); b.st[0] = nloc; b.st[1] = nx; }
        const unsigned old = xb_add(&bar[XB_XSUB(b.x)], 1u);
        const unsigned gen = old / nloc;
        if (old + 1u == (gen + 1u) * nloc) {
            __builtin_amdgcn_fence(__ATOMIC_RELEASE, "agent");
            asm volatile("s_waitcnt vmcnt(0)" ::: "memory");
            const unsigned og = xb_add(&bar[XB_TOP], 1u);
            const unsigned tg = og / nx;
            if (og + 1u == (tg + 1u) * nx) xb_add(&bar[XB_TOPGEN], 1u);
            else XB_SPIN(xb_ld(&bar[XB_TOPGEN]) == tg, bar);
            __builtin_amdgcn_fence(__ATOMIC_ACQUIRE, "agent");
            xb_add(&bar[XB_XGEN(b.x)], 1u);
            asm volatile("s_waitcnt vmcnt(0)" ::: "memory");
        } else {
            XB_SPIN(xb_ld(&bar[XB_XGEN(b.x)]) == gen, bar);
            __builtin_amdgcn_fence(__ATOMIC_ACQUIRE, "agent");
            asm volatile("s_waitcnt vmcnt(0)" ::: "memory");
        }
    }
    __syncthreads();
}
constexpr int NWAVES = 8;
constexpr int M = 16384, D = 1024, NL = 2;
constexpr int GW = 512, CHUNK = 128, NGRP = 8;
constexpr int NH = 8, DQK = 96, DNOPE = 64, DROPE = 32, DV = 64, QLORA = 384, KVLORA = 256;
constexpr int IN_TOTAL = 3744, NPROJ = 3840;
constexpr int FF = 2752, FFP = 2816;
#ifndef ACT_LD_DEF
#define ACT_LD_DEF 2816
#endif
constexpr int ACT_LD = ACT_LD_DEF;
constexpr int NE = 8, EFF = 3584;
constexpr float EPS = 1e-6f;
constexpr int PC_U = 0, PC_V = 512, PC_GA = 1024, PC_GB = 2048, PC_CKV = 3072, PC_CQ = 3328, PC_KR = 3712;
constexpr int MOE_ROWS = 2 * M + NE * 256;
constexpr int MOE_PANELS = MOE_ROWS / 256, MOE_PASS_PANELS = 68;

constexpr size_t MiB = 1u << 20;
constexpr size_t WS_CTL = 0, CTL_ZERO_BYTES = 3 * MiB;
constexpr size_t WS_STATS = 1 * MiB;
constexpr size_t WS_MOD = 2 * MiB;
constexpr size_t WS_COS = 3 * MiB, WS_SIN = 4 * MiB;
constexpr size_t WS_TOPI = 5 * MiB, WS_TOPG = 5 * MiB + 128 * 1024, WS_LIST = 5 * MiB + 256 * 1024;
constexpr size_t WS_ROWDEST = 6 * MiB + 512 * 1024, WS_ROWGATE = 6 * MiB + 768 * 1024;
constexpr size_t WS_WST = 7 * MiB;
constexpr size_t WS_WIN = 8 * MiB, WS_WUQ = 23 * MiB, WS_WUKV = 25 * MiB, WS_WA = 26 * MiB, WS_WB = 28 * MiB, WS_WO = 30 * MiB;
constexpr size_t WS_WGU = 34 * MiB, WS_WD = 45 * MiB, WS_W13 = 51 * MiB, WS_W2 = 163 * MiB;
constexpr size_t WS_H = 220 * MiB;
constexpr size_t WS_PROJ = 252 * MiB;
constexpr size_t WS_Q = 372 * MiB, WS_KN = 396 * MiB, WS_VV = 412 * MiB, WS_KPE = 428 * MiB, WS_GM = 429 * MiB, WS_ATT = 445 * MiB, WS_Y = 461 * MiB;
constexpr size_t WS_ACT = WS_PROJ;
constexpr size_t WS_XG = 252 * MiB, WS_ACTM = 320 * MiB, WS_Y2 = 439 * MiB;
constexpr size_t WS_PST = 503 * MiB;
constexpr size_t WS_END = 507 * MiB;
static_assert(WS_XG + (size_t)MOE_ROWS * D * 2 <= WS_ACTM && WS_ACTM + (size_t)MOE_PASS_PANELS * 256 * EFF * 2 <= WS_Y2 && WS_Y2 + (size_t)M * 2 * D * 2 <= WS_END, "moe map");
static_assert(WS_W13 + (size_t)NE * 2 * EFF * D * 2 <= WS_W2 && WS_W2 + (size_t)NE * D * EFF * 2 <= WS_H, "weights map");
constexpr int CW_TMO = 0, CW_CODE = 1;
constexpr int CW_BAR = 4096;
constexpr int CW_XRANK = 12288;
constexpr int CW_MOE = 8192;
constexpr int CW_DIAG = 16384;
constexpr int RING_OFF = 0, RING_BYTES = 131072;
constexpr int LDSCTL_OFF = RING_BYTES, MISC_OFF = LDSCTL_OFF + 320;
constexpr int LDS_BYTES = 147456;
struct Args { const void* in[29]; float* out; unsigned char* ws; int ph_lo, ph_hi; };
__device__ __forceinline__ float sum4f(const f32x4& v) { return (v[0] + v[1]) + (v[2] + v[3]); }
__device__ __forceinline__ int fresh_lane() { int ln_; asm volatile("v_mbcnt_lo_u32_b32 %0, -1, 0\n\tv_mbcnt_hi_u32_b32 %0, -1, %0" : "=v"(ln_)); return ln_; }
__device__ __forceinline__ const float* inptr(const LAS unsigned long long* ptab, int i) { const unsigned long long v = ptab[i]; const unsigned lo = __builtin_amdgcn_readfirstlane((unsigned)v), hi = __builtin_amdgcn_readfirstlane((unsigned)(v >> 32)); return (const float*)(((unsigned long long)hi << 32) | lo); }
struct Ctx { LAS unsigned char* lds; gu32* ctl; unsigned char* ws; int tid, lane, wave, vcu, G, gw, NGW; };
__device__ __forceinline__ float wave_sum(float v) { v += swz_xor1(v); v += swz_xor2(v); v += swz_xor4(v); v += swz_xor8(v); v += swz_xor16(v); return xsum32(v); }
__device__ __forceinline__ float siluf_(float x) { return x / (1.0f + __expf(-x)); }
template <class Map>
__device__ __forceinline__ void p0_item(const Map& mp, int Ksrc, const float* gain, bf16* WT, int ldt, int nblk, LAS float* scr, int item, int lane) {
    const int kb = item / nblk, nb = item % nblk, k0 = 64 * kb, n0 = 32 * nb;
    const float* src; int ldw; const int sc = mp(n0 + (lane & 31), src, ldw);
#pragma unroll 8
    for (int i = 0; i < 32; ++i) { const int kk = 2 * i + (lane >> 5), k = k0 + kk; float v = 0.f; if (sc >= 0 && k < Ksrc) { v = src[(size_t)k * ldw + sc]; if (gain) v *= gain[k]; } scr[kk * 33 + (lane & 31)] = v; }
    LDS_WAIT(); asm volatile("" ::: "memory");
    const int c = lane & 7;
#pragma unroll
    for (int j = 0; j < 4; ++j) { const int n = (lane >> 3) + 8 * j; const LAS float* s = scr + (8 * c) * 33 + n;
        v4u o; o.x = pk2(s[0 * 33], s[1 * 33]); o.y = pk2(s[2 * 33], s[3 * 33]); o.z = pk2(s[4 * 33], s[5 * 33]); o.w = pk2(s[6 * 33], s[7 * 33]);
        *(GAS v4u*)(WT + (size_t)(n0 + n) * ldt + k0 + 8 * c) = o; }
    LDS_WAIT(); asm volatile("" ::: "memory");
}
struct MapIdent { const float* W; int ld; __device__ __forceinline__ int operator()(int n, const float*& s, int& l) const { s = W; l = ld; return n; } };
struct MapWin { const float* W; __device__ __forceinline__ int operator()(int n, const float*& s, int& l) const { s = W; l = IN_TOTAL;
    if (n < 1024) return n; if (n < 2048) return 1696 + (n - 1024); if (n < 3072) return 2720 + (n - 2048); if (n < 3328) return 1408 + (n - 3072); if (n < 3712) return 1024 + (n - 3328);
    if (n < 3744) { const int j = (n - 3712) >> 1, p = (n - 3712) & 1; return 1664 + j + 16 * p; } return -1; } };
struct MapWuq { const float* W; __device__ __forceinline__ int operator()(int n, const float*& s, int& l) const { s = W; l = 768; const int h = n / 96, o = n % 96;
    if (o < 64) return 96 * h + o; const int j = (o - 64) >> 1, p = (o - 64) & 1; return 96 * h + 64 + j + 16 * p; } };
struct MapWukv { const float* W; __device__ __forceinline__ int operator()(int n, const float*& s, int& l) const { s = W; l = 1024; if (n < 512) return 128 * (n >> 6) + (n & 63); const int m = n - 512; return 128 * (m >> 6) + 64 + (m & 63); } };
struct MapGU { const float* Wg; const float* Wu; int ld, nch; __device__ __forceinline__ int operator()(int n, const float*& s, int& l) const { const int r = n & 255, ch = 128 * (n >> 8) + (r & 127); s = Wg + ((r < 128) ? (ptrdiff_t)0 : (Wu - Wg)); l = ld; return ch < nch ? ch : -1; } };

__device__ __forceinline__ void phase_prologue(const Ctx& C, const LAS unsigned long long* ptab) {
    LAS float* scr = (LAS float*)(C.lds + C.wave * 16384);
    unsigned char* ws = C.ws;
    constexpr int I_WIN = 16 * (NPROJ / 32), I_UQ = 6 * (768 / 32), I_UKV = 4 * (1024 / 32), I_AB = 8 * 32, I_WO = 16 * 32, I_GU = 16 * (2 * FFP / 32), I_WD = (FFP / 64) * 32, I_13 = 16 * (2 * EFF / 32), I_2 = (EFF / 64) * 32;
    constexpr int I_L = I_WIN + I_UQ + I_UKV + 2 * I_AB + I_WO;
    constexpr int NT_ITEMS = NL * I_L + I_GU + I_WD + NE * (I_13 + I_2);
    for (int it = C.gw; it < NT_ITEMS; it += C.NGW) {
        int r = it;
        if (r < NL * I_L) { const int l = r / I_L; r -= l * I_L;
            if (r < I_WIN) { p0_item(MapWin{inptr(ptab, 9) + (size_t)l * D * IN_TOTAL}, D, nullptr, (bf16*)(ws + WS_WIN) + (size_t)l * NPROJ * D, D, NPROJ / 32, scr, r, C.lane); continue; } r -= I_WIN;
            if (r < I_UQ) { p0_item(MapWuq{inptr(ptab, 15) + (size_t)l * QLORA * 768}, QLORA, inptr(ptab, 14) + l * QLORA, (bf16*)(ws + WS_WUQ) + (size_t)l * 768 * QLORA, QLORA, 768 / 32, scr, r, C.lane); continue; } r -= I_UQ;
            if (r < I_UKV) { p0_item(MapWukv{inptr(ptab, 17) + (size_t)l * KVLORA * 1024}, KVLORA, inptr(ptab, 16) + l * KVLORA, (bf16*)(ws + WS_WUKV) + (size_t)l * 1024 * KVLORA, KVLORA, 1024 / 32, scr, r, C.lane); continue; } r -= I_UKV;
            if (r < I_AB) { p0_item(MapIdent{inptr(ptab, 18) + (size_t)l * GW * D, D}, GW, nullptr, (bf16*)(ws + WS_WA) + (size_t)l * D * GW, GW, D / 32, scr, r, C.lane); continue; } r -= I_AB;
            if (r < I_AB) { p0_item(MapIdent{inptr(ptab, 19) + (size_t)l * GW * D, D}, GW, nullptr, (bf16*)(ws + WS_WB) + (size_t)l * D * GW, GW, D / 32, scr, r, C.lane); continue; } r -= I_AB;
            p0_item(MapIdent{inptr(ptab, 20) + (size_t)l * D * D, D}, D, nullptr, (bf16*)(ws + WS_WO) + (size_t)l * D * D, D, D / 32, scr, r, C.lane); continue; }
        r -= NL * I_L;
        if (r < I_GU) { p0_item(MapGU{inptr(ptab, 21), inptr(ptab, 22), FF, FF}, D, nullptr, (bf16*)(ws + WS_WGU), D, 2 * FFP / 32, scr, r, C.lane); continue; } r -= I_GU;
        if (r < I_WD) { p0_item(MapIdent{inptr(ptab, 23), D}, FF, nullptr, (bf16*)(ws + WS_WD), FFP, D / 32, scr, r, C.lane); continue; } r -= I_WD;
        { const int e = r / (I_13 + I_2); r -= e * (I_13 + I_2);
          if (r < I_13) { p0_item(MapGU{inptr(ptab, 26) + (size_t)e * D * EFF, inptr(ptab, 27) + (size_t)e * D * EFF, EFF, EFF}, D, nullptr, (bf16*)(ws + WS_W13) + (size_t)e * 2 * EFF * D, D, 2 * EFF / 32, scr, r, C.lane); continue; } r -= I_13;
          p0_item(MapIdent{inptr(ptab, 28) + (size_t)e * EFF * D, D}, EFF, nullptr, (bf16*)(ws + WS_W2) + (size_t)e * D * EFF, EFF, D / 32, scr, r, C.lane); }
    }
    { float* MOD = (float*)(ws + WS_MOD); const float* cc = inptr(ptab, 1); const float* aw = inptr(ptab, 3); const float* ab = inptr(ptab, 4);
      LAS float* part = (LAS float*)(C.lds + 12288);
      for (int it = C.vcu; it < NL * 96; it += C.G) { const int l = it / 96, jb = it % 96, j = jb * 64 + C.lane, ds = C.wave;
          float s = 0.f; const float* w = aw + ((size_t)l * D + ds * 128) * (6 * D) + j;
#pragma unroll 8
          for (int d = 0; d < 128; ++d) s += siluf_(cc[ds * 128 + d]) * w[(size_t)d * 6 * D];
          part[ds * 64 + C.lane] = s;
          __syncthreads();
          if (C.wave == 0) { float t = ab[l * 6 * D + j];
#pragma unroll
              for (int q = 0; q < 8; ++q) t += part[q * 64 + C.lane];
              MOD[l * 6 * D + j] = t; }
          __syncthreads(); } }
    { const float invf[16] = {1.000000000e+00f, 5.623413324e-01f, 3.162277639e-01f, 1.778279394e-01f, 1.000000015e-01f, 5.623412877e-02f, 3.162277862e-02f, 1.778279431e-02f, 9.999999776e-03f, 5.623413250e-03f, 3.162277862e-03f, 1.778279431e-03f, 1.000000047e-03f, 5.623413017e-04f, 3.162277862e-04f, 1.778279402e-04f};
      const int* pos = (const int*)inptr(ptab, 2); float* ct = (float*)(ws + WS_COS); float* st = (float*)(ws + WS_SIN);
      const int j = C.lane & 15; float f = invf[0];
#pragma unroll
      for (int q = 1; q < 16; ++q) f = (j == q) ? invf[q] : f;
      for (int it = C.gw; it < M / 4; it += C.NGW) { const int row = it * 4 + (C.lane >> 4); const float ang = (float)pos[row] * f;
          const double rev = (double)ang * 0.15915494309189533577; const float fr = (float)(rev - floor(rev));
          ct[row * 16 + j] = __builtin_amdgcn_cosf(fr); st[row * 16 + j] = __builtin_amdgcn_sinf(fr); } }
    { const float* wsrc = inptr(ptab, 12); bf16* wst = (bf16*)(ws + WS_WST);
      for (int it = C.gw; it < NL * NGRP * CHUNK * CHUNK / 256; it += C.NGW) { const int e0 = it * 256 + C.lane * 4; const int t = (e0 >> 7) & 127, s0 = e0 & 127;
          const f32x4 v = *(const f32x4*)(wsrc + e0); unsigned long long o = (unsigned long long)pk2(s0 <= t ? v.x : 0.f, s0 + 1 <= t ? v.y : 0.f) | ((unsigned long long)pk2(s0 + 2 <= t ? v.z : 0.f, s0 + 3 <= t ? v.w : 0.f) << 32);
          *(unsigned long long*)(wst + e0) = o; } }
}
__device__ __forceinline__ void phase_prenorm(const Ctx& C, const float* x, const float* w, const float* sc, const float* sh, bf16* H) {
    f32x4 ca[4], cb[4];
#pragma unroll
    for (int j = 0; j < 4; ++j) { const int c = 4 * C.lane + 256 * j; const f32x4 ww = *(const f32x4*)(w + c), s1 = *(const f32x4*)(sc + c); ca[j] = ww * (s1 + 1.0f); cb[j] = *(const f32x4*)(sh + c); }
    for (int blk = C.vcu; blk < M / 64; blk += C.G)
    for (int m = blk * 64 + C.wave * 8; m < blk * 64 + C.wave * 8 + 8; ++m) {
        const f32x4* xr = (const f32x4*)(x + (size_t)m * D) + C.lane; f32x4 v[4]; float s2 = 0.f;
#pragma unroll
        for (int j = 0; j < 4; ++j) { v[j] = xr[64 * j]; s2 += sum4f(v[j] * v[j]); }
        const float rstd = 1.0f / sqrtf(wave_sum(s2) * (1.0f / D) + EPS);
        unsigned long long* o8 = (unsigned long long*)(H + (size_t)m * D) + C.lane;
#pragma unroll
        for (int j = 0; j < 4; ++j) { const f32x4 hv = v[j] * rstd * ca[j] + cb[j]; o8[64 * j] = (unsigned long long)pk2(hv.x, hv.y) | ((unsigned long long)pk2(hv.z, hv.w) << 32); }
    }
}
__device__ __forceinline__ void ld_bf4(const bf16* p, f32x4& v) { const unsigned long long w = *(const unsigned long long*)p; const unsigned lo = (unsigned)w, hi = (unsigned)(w >> 32);
    v = (f32x4){__uint_as_float(lo << 16), __uint_as_float(lo & 0xffff0000u), __uint_as_float(hi << 16), __uint_as_float(hi & 0xffff0000u)}; }
template <int MODE>
__device__ __forceinline__ void phase_resid(const Ctx& C, const float* xin, float* xout, const bf16* Y, const bf16* Ysecond, int ypitch, const float* g, const float* wpost,
                                            const float* wpre, const float* sc, const float* sh, bf16* H, const float* wr, const float* br, int* topi, float* topg, int* list, gu32* cnt) {
    f32x4 cg[4], ca[4], cb[4];
#pragma unroll
    for (int j = 0; j < 4; ++j) { const int c = 4 * C.lane + 256 * j; cg[j] = *(const f32x4*)(g + c) * *(const f32x4*)(wpost + c);
        if (MODE >= 1) { ca[j] = *(const f32x4*)(wpre + c) * (*(const f32x4*)(sc + c) + 1.0f); cb[j] = *(const f32x4*)(sh + c); } }
    LAS float* WR = (LAS float*)C.lds;
    LAS int* lcnt = (LAS int*)(C.lds + 32768);
    LAS int* lsel = (LAS int*)(C.lds + 32768 + 64);
    LAS float* rsc = (LAS float*)(C.lds + 36864) + C.wave * 1024;
    if (MODE == 2) { for (int i = C.tid; i < D * NE / 4; i += NWAVES * 64) ((LAS f32x4*)WR)[i] = ((const f32x4*)wr)[i]; if (C.tid < 16) lcnt[C.tid] = 0; __syncthreads(); }
    for (int blk = C.vcu; blk < M / 64; blk += C.G) {
        const int m_begin = blk * 64 + C.wave * 8, m_end = m_begin + 8;
        for (int m = m_begin; m < m_end; ++m) {
            f32x4 y[4], xv[4]; float s2 = 0.f;
#pragma unroll
            for (int j = 0; j < 4; ++j) { ld_bf4(Y + (size_t)m * ypitch + 4 * C.lane + 256 * j, y[j]); if (Ysecond) { f32x4 t; ld_bf4(Ysecond + (size_t)m * ypitch + 4 * C.lane + 256 * j, t); y[j] += t; }
                xv[j] = *((const f32x4*)(xin + (size_t)m * D) + C.lane + 64 * j); s2 += sum4f(y[j] * y[j]); }
            const float rstd = 1.0f / sqrtf(wave_sum(s2) * (1.0f / D) + EPS); float s3 = 0.f;
#pragma unroll
            for (int j = 0; j < 4; ++j) { xv[j] += cg[j] * (y[j] * rstd); *((f32x4*)(xout + (size_t)m * D) + C.lane + 64 * j) = xv[j]; s3 += sum4f(xv[j] * xv[j]); }
            if (MODE >= 1) {
                const float rstd2 = 1.0f / sqrtf(wave_sum(s3) * (1.0f / D) + EPS);
                unsigned long long* o8 = (unsigned long long*)(H + (size_t)m * D) + C.lane; float lg[8];
                if (MODE == 2) {
#pragma unroll
                    for (int e = 0; e < 8; ++e) lg[e] = 0.f; }
#pragma unroll
                for (int j = 0; j < 4; ++j) { const f32x4 hv = xv[j] * rstd2 * ca[j] + cb[j]; o8[64 * j] = (unsigned long long)pk2(hv.x, hv.y) | ((unsigned long long)pk2(hv.z, hv.w) << 32);
                    if (MODE == 2) {
#pragma unroll
                        for (int q = 0; q < 4; ++q) { const int c = 4 * C.lane + 256 * j + q; const f32x4 w0 = *(const LAS f32x4*)(WR + c * 8), w1 = *(const LAS f32x4*)(WR + c * 8 + 4); const float hq = hv[q];
                            lg[0] += hq * w0.x; lg[1] += hq * w0.y; lg[2] += hq * w0.z; lg[3] += hq * w0.w; lg[4] += hq * w1.x; lg[5] += hq * w1.y; lg[6] += hq * w1.z; lg[7] += hq * w1.w; } } }
                if (MODE == 2) {
#pragma unroll
                    for (int e = 0; e < 8; ++e) rsc[e * 64 + C.lane] = lg[e];
                    __builtin_amdgcn_fence(__ATOMIC_RELEASE, "wavefront"); __builtin_amdgcn_wave_barrier(); __builtin_amdgcn_fence(__ATOMIC_ACQUIRE, "wavefront");
                    if (C.lane < 8) { float t = br[C.lane];
                        for (int i = 0; i < 64; ++i) t += rsc[C.lane * 64 + i];
                        rsc[512 + C.lane] = t; }
                    __builtin_amdgcn_fence(__ATOMIC_RELEASE, "wavefront"); __builtin_amdgcn_wave_barrier(); __builtin_amdgcn_fence(__ATOMIC_ACQUIRE, "wavefront");
#pragma unroll
                    for (int e = 0; e < 8; ++e) lg[e] = rsc[512 + e];
                    __builtin_amdgcn_fence(__ATOMIC_RELEASE, "wavefront"); __builtin_amdgcn_wave_barrier(); __builtin_amdgcn_fence(__ATOMIC_ACQUIRE, "wavefront");
#ifdef DIAG_LOGITS
                    if (C.lane == 0) { float* LG = (float*)(C.ws + 507 * MiB) + (size_t)m * 8;
#pragma unroll
                        for (int e = 0; e < 8; ++e) LG[e] = lg[e]; }
#endif
                    int i0 = 0; float v0 = lg[0];
#pragma unroll
                    for (int e = 1; e < 8; ++e) if (lg[e] > v0) { v0 = lg[e]; i0 = e; }
                    int i1 = -1; float v1 = -INFINITY;
#pragma unroll
                    for (int e = 0; e < 8; ++e) if (e != i0 && lg[e] > v1) { v1 = lg[e]; i1 = e; }
                    const float e1 = __expf(v1 - v0), g0 = 1.0f / (1.0f + e1), g1 = e1 * g0;
                    if (C.lane == 0) { topi[2 * m] = i0; topi[2 * m + 1] = i1; topg[2 * m] = g0; topg[2 * m + 1] = g1;
                        const int r0 = atomicAdd((int*)&lcnt[i0], 1), r1 = atomicAdd((int*)&lcnt[i1], 1); const int lr = m - blk * 64; lsel[2 * lr] = (i0 << 16) | r0; lsel[2 * lr + 1] = (i1 << 16) | r1; }
                }
            }
        }
        if (MODE == 2) {
            __syncthreads();
            if (C.tid < 8) lcnt[8 + C.tid] = (int)__hip_atomic_fetch_add(cnt + 64 * C.tid, (unsigned)lcnt[C.tid], RLX_AGENT);
            __syncthreads();
            if (C.tid < 128) { const int s = lsel[C.tid], e = s >> 16, r = s & 0xffff; list[e * M + lcnt[8 + e] + r] = ((blk * 64 + (C.tid >> 1)) << 1) | (C.tid & 1); }
            __syncthreads();
            if (C.tid < 8) lcnt[C.tid] = 0;
            __syncthreads();
        }
    }
}
__device__ __forceinline__ void phase_gmlp(const Ctx& C, const bf16* PROJ, const float* sumv, const float* ssqv, const float* lng, const float* lnb, const bf16* WST, const float* bs, bf16* GM) {
    typedef __attribute__((ext_vector_type(16))) float f32x16; typedef unsigned u32x4v __attribute__((ext_vector_type(4)));
    LAS bf16* VT = (LAS bf16*)C.lds;
    const int r32 = C.lane & 31, hi = C.lane >> 5;
    const int xg = C.G >> 3, xq = C.vcu / (xg > 0 ? xg : 1), xr = C.vcu - xq * xg;
    for (int uu = xr; uu < 128; uu += xg) {
        const int u = xq * 128 + uu;
        const int c = u >> 3, g = u & 7, t0 = c * CHUNK, ch0 = g * 64;
        { const int s = C.tid >> 2, dq = (C.tid & 3) * 16, row = t0 + s; const f32x4 sa = *(const f32x4*)(sumv + row * 8), sb = *(const f32x4*)(sumv + row * 8 + 4), qa = *(const f32x4*)(ssqv + row * 8), qb = *(const f32x4*)(ssqv + row * 8 + 4);
          const float mean = (((sa[0] + sa[1]) + (sa[2] + sa[3])) + ((sb[0] + sb[1]) + (sb[2] + sb[3]))) * (1.0f / GW), var = (((qa[0] + qa[1]) + (qa[2] + qa[3])) + ((qb[0] + qb[1]) + (qb[2] + qb[3]))) * (1.0f / GW) - mean * mean, rstd = 1.0f / sqrtf(var + EPS);
          const u32x4v w0 = *(const u32x4v*)(PROJ + (size_t)row * NPROJ + PC_V + ch0 + dq), w1 = *(const u32x4v*)(PROJ + (size_t)row * NPROJ + PC_V + ch0 + dq + 8);
#pragma unroll
          for (int i = 0; i < 8; ++i) { const unsigned wa = (i < 4) ? w0[i] : w1[i - 4]; const int d = dq + 2 * i;
              const float a = (__uint_as_float(wa << 16) - mean) * rstd * lng[ch0 + d] + lnb[ch0 + d], b = (__uint_as_float(wa & 0xffff0000u) - mean) * rstd * lng[ch0 + d + 1] + lnb[ch0 + d + 1];
              VT[d * 136 + s] = (bf16)f2bf(a); VT[(d + 1) * 136 + s] = (bf16)f2bf(b); } }
        __syncthreads();
        const int dblk = C.wave & 1, tblk = C.wave >> 1; f32x16 acc = {};
        const bf16* wrow = WST + ((size_t)g * CHUNK + 32 * tblk + r32) * CHUNK + 8 * hi;
        for (int ks = 0; ks <= 2 * tblk + 1; ++ks) {
            const bf16x8 af = *(const LAS bf16x8*)(VT + (32 * dblk + r32) * 136 + 16 * ks + 8 * hi);
            const bf16x8 bfr = *(const bf16x8*)(wrow + 16 * ks);
            acc = __builtin_amdgcn_mfma_f32_32x32x16_bf16(af, bfr, acc, 0, 0, 0);
        }
        const int tl = 32 * tblk + r32, row = t0 + tl; const float bias = bs[g * CHUNK + tl];
#pragma unroll
        for (int q = 0; q < 4; ++q) { const int ch = ch0 + 32 * dblk + 8 * q + 4 * hi; f32x4 uv; ld_bf4(PROJ + (size_t)row * NPROJ + PC_U + ch, uv);
            const f32x4 z = (f32x4){acc[4 * q] + bias, acc[4 * q + 1] + bias, acc[4 * q + 2] + bias, acc[4 * q + 3] + bias}, o = uv * z;
            *(unsigned long long*)(GM + (size_t)row * GW + ch) = (unsigned long long)pk2(o.x, o.y) | ((unsigned long long)pk2(o.z, o.w) << 32); }
        __syncthreads();
    }
}
__device__ __forceinline__ void moe_tab_build(const Ctx& C, gu32* cnt, LAS int* tab) {
    __syncthreads();
    if (C.tid == 0) { int acc = 0;
        for (int e = 0; e < 8; ++e) { const int c = (int)__hip_atomic_load(cnt + 64 * e, RLX_AGENT); tab[16 + e] = c; tab[e] = acc; acc += (c + 255) >> 8; } tab[8] = acc; }
    __syncthreads();
}
__device__ __forceinline__ int moe_expert_of(const LAS int* tab, int panel) { int e = 0;
#pragma unroll
    for (int q = 1; q < 8; ++q) e += (panel >= tab[q]) ? 1 : 0; return e; }
__device__ __forceinline__ void phase_gather(const Ctx& C, const LAS int* tab, const bf16* H, const int* list, const float* topg, bf16* XG, int* rowdest, float* rowgate) {
    typedef unsigned u32x4v __attribute__((ext_vector_type(4)));
    const int total = tab[8] * 256;
    for (int p = C.gw; p < total; p += C.NGW) {
        const int e = moe_expert_of(tab, p >> 8), i = p - tab[e] * 256; u32x4v v0 = {0u, 0u, 0u, 0u}, v1 = {0u, 0u, 0u, 0u}; int dest = -1; float gt = 0.f;
        if (i < tab[16 + e]) { dest = list[e * M + i]; gt = topg[dest]; const u32x4v* src = (const u32x4v*)(H + (size_t)(dest >> 1) * D); v0 = src[C.lane]; v1 = src[64 + C.lane]; }
        u32x4v* dst = (u32x4v*)(XG + (size_t)p * D); dst[C.lane] = v0; dst[64 + C.lane] = v1;
        if (C.lane == 0) { rowdest[p] = dest; rowgate[p] = gt; }
    }
}
struct MoeOrder {
    pg8::StaticOrder S; int p0; size_t estride; int absA; const LAS int* tab;
    __device__ bool next(int i, pg8::Unit& u) const { if (!S.next(i, u)) return false; const int P = p0 + u.pm; const int e = moe_expert_of(tab, P); u.aux = P; u.aoff = (size_t)(absA ? P : u.pm) * S.astep; u.boff += (size_t)e * estride; return true; }
};
#ifndef EN_ALL
#define EN_ALL 1
#endif
#ifndef DIAG_TWIN_OFF
#define DIAG_TWIN_OFF WS_ACT
#endif
#ifndef EN_FFN2
#define EN_FFN2 1
#endif
#ifndef EN_BR2
#define EN_BR2 1
#endif
#ifndef EN_C1
#define EN_C1 1
#endif
#ifndef EN_C2
#define EN_C2 1
#endif
#ifndef EN_C3
#define EN_C3 1
#endif
#ifndef EN_P0
#define EN_P0 EN_ALL
#endif
#ifndef EN_P1
#define EN_P1 EN_ALL
#endif
#ifndef EN_G1
#define EN_G1 EN_ALL
#endif
#ifndef EN_C
#define EN_C EN_ALL
#endif
#ifndef EN_ATT
#define EN_ATT EN_ALL
#endif
#ifndef EN_BR
#define EN_BR EN_ALL
#endif
#ifndef EN_OUT
#define EN_OUT EN_ALL
#endif
#ifndef EN_T1
#define EN_T1 EN_ALL
#endif
#ifndef EN_FFN
#define EN_FFN EN_ALL
#endif
#ifndef EN_T2
#define EN_T2 EN_ALL
#endif
#ifndef EN_GA
#define EN_GA EN_ALL
#endif
#ifndef EN_MOE
#define EN_MOE EN_ALL
#endif
#ifndef EN_FIN
#define EN_FIN EN_ALL
#endif
constexpr int NPHASES = 23;
__global__ void __launch_bounds__(NWAVES * 64, 2) mega_fwd(Args args) {
    extern __shared__ __attribute__((aligned(16))) unsigned char lds[];
    Ctx C; C.lds = (LAS unsigned char*)lds; C.ws = args.ws; C.ctl = (gu32*)(args.ws + WS_CTL);
    C.tid = threadIdx.x; C.lane = C.tid & 63; C.wave = __builtin_amdgcn_readfirstlane(C.tid >> 6);
    for (int u = threadIdx.x; u < (LDS_BYTES - LDSCTL_OFF) / 4; u += NWAVES * 64) ((LAS unsigned*)(C.lds + LDSCTL_OFF))[u] = 0u;
    __syncthreads();
    C.G = gridDim.x;
    int cid = blockIdx.x;
    { volatile LAS unsigned* MI = (volatile LAS unsigned*)(C.lds + MISC_OFF);
      if (threadIdx.x == 0) { const unsigned xcc = xb_xcc_id(); const unsigned rk = __hip_atomic_fetch_add((gu32*)(args.ws + WS_CTL) + CW_XRANK + 64 * xcc, 1u, RLX_AGENT); MI[16] = xcc; MI[17] = rk; }
      __syncthreads();
      const int xcc = (int)MI[16], rk = (int)MI[17], per = C.G >> 3;
      if ((C.G & 7) == 0 && xcc < 8 && rk < per) { C.vcu = xcc * per + rk; cid = rk * 8 + xcc; } else { const int bx = blockIdx.x; C.vcu = (C.G % 8 == 0) ? (bx % 8) * (C.G / 8) + bx / 8 : bx; cid = bx; } }
    C.gw = C.vcu * NWAVES + C.wave; C.NGW = C.G * NWAVES;
    volatile LAS unsigned* MISC = (volatile LAS unsigned*)(C.lds + MISC_OFF);
    LAS int* moetab = (LAS int*)(C.lds + MISC_OFF + 256);
    LAS unsigned long long* ptab = (LAS unsigned long long*)(C.lds + MISC_OFF + 512);
    if (threadIdx.x < 29) ptab[threadIdx.x] = (unsigned long long)args.in[threadIdx.x];
    __syncthreads();
    XcdBarrier bar = xcd_barrier_post((unsigned*)(C.ctl + CW_BAR), MISC + 8);
    const int lo = args.ph_lo, hi = args.ph_hi;
    unsigned char* ws = args.ws;
#define IN(k) (lo <= (k) && (k) < hi)
#define FRESH() do { C.lane = fresh_lane(); C.tid = C.wave * 64 + C.lane; } while (0)
#define SEAM(k) do { if ((k) + 1 < hi) { XcdBarrier b_ = bar; asm volatile("" : "+s"(b_.bar)); xcd_barrier(b_, C.wave == 0 && fresh_lane() == 0); } } while (0)
#define INF(i) (inptr(ptab, (i)))
    bf16* const Hb = (bf16*)(ws + WS_H); bf16* const PROJ = (bf16*)(ws + WS_PROJ); bf16* const Qb = (bf16*)(ws + WS_Q); bf16* const KNb = (bf16*)(ws + WS_KN); bf16* const VVb = (bf16*)(ws + WS_VV);
    bf16* const KPEb = (bf16*)(ws + WS_KPE); bf16* const GMb = (bf16*)(ws + WS_GM); bf16* const ATTb = (bf16*)(ws + WS_ATT); bf16* const Yb = (bf16*)(ws + WS_Y); bf16* const MRG = Hb; bf16* const H1b = (bf16*)(ws + WS_GM);
    const float* const MOD = (const float*)(ws + WS_MOD); const float* const cosT = (const float*)(ws + WS_COS); const float* const sinT = (const float*)(ws + WS_SIN);
    float* const xres = args.out;

    if (IN(0)) { FRESH(); if (EN_P0) phase_prologue(C, ptab); SEAM(0); }
    if (IN(1)) { FRESH(); if (EN_P1) phase_prenorm(C, INF(0), INF(5), MOD + 1 * D, MOD + 0 * D, Hb); SEAM(1); }
#pragma unroll
    for (int l = 0; l < NL; ++l) {
        const int pb = (l == 0) ? 1 : 10;
        const float* mod = MOD + l * 6 * D;
        float* st_sumv = (float*)(ws + WS_PST + (size_t)l * 2 * MiB); float* st_ssqv = st_sumv + 8 * M; float* st_ssqq = st_sumv + 16 * M; float* st_ssqkv = st_sumv + 24 * M;
        if (EN_G1 && IN(pb + 1)) { FRESH();
#ifdef DIAG_L2FLUSH
            if (l == 1) { typedef unsigned u32x4f __attribute__((ext_vector_type(4))); const u32x4f* src = (const u32x4f*)(ws + WS_W13 + (size_t)C.vcu * (DIAG_L2FLUSH * 65536)); u32x4f acc_ = {0u, 0u, 0u, 0u};
                for (int i = 0; i < DIAG_L2FLUSH * 8; ++i) { const u32x4f v = src[i * 512 + C.tid]; acc_ ^= v; }
                if ((acc_.x ^ acc_.y ^ acc_.z ^ acc_.w) == 0x12345678u) ((unsigned*)(ws + WS_TOPI))[C.tid] = 1u; __syncthreads(); }
#endif
            pg8::Gemm g{l == 0 ? Hb : H1b, (const bf16*)(ws + WS_WIN) + (size_t)l * NPROJ * D, D, D, D}; pg8::StaticOrder S; S.init(M, NPROJ, D, D, C.G, cid);
            pg8::EpiProj E{PROJ, KPEb, st_sumv, st_ssqv, st_ssqq, st_ssqkv, cosT, sinT};
#if 1
            pg8::gemm_phase<pg8::EpiProj, pg8::StaticOrder>(C.lds + RING_OFF, g, S, E, C.wave);
#endif
            SEAM(pb + 1);
        }
        if (EN_C && IN(pb + 2)) { FRESH();
            if (EN_C1) phase_gmlp(C, PROJ, st_sumv, st_ssqv, INF(10) + l * GW, INF(11) + l * GW, (const bf16*)(ws + WS_WST) + (size_t)l * NGRP * CHUNK * CHUNK, INF(13) + l * NGRP * CHUNK, GMb);
            if (EN_C2) { pg8::Gemm g{PROJ + PC_CQ, (const bf16*)(ws + WS_WUQ) + (size_t)l * 768 * QLORA, NPROJ, QLORA, QLORA}; pg8::StaticOrder S; S.init(M, 768, NPROJ, QLORA, C.G, cid);
              pg8::EpiQ E{Qb, st_ssqq, cosT, sinT, 0.10206207261596577f * 1.4426950408889634f};
              pg8::gemm_phase<pg8::EpiQ, pg8::StaticOrder>(C.lds + RING_OFF, g, S, E, C.wave); }
            if (EN_C3) { pg8::Gemm g{PROJ + PC_CKV, (const bf16*)(ws + WS_WUKV) + (size_t)l * 1024 * KVLORA, NPROJ, KVLORA, KVLORA}; pg8::StaticOrder S; S.init(M, 1024, NPROJ, KVLORA, C.G, cid);
              pg8::EpiKV E{KNb, VVb, st_ssqkv};
              pg8::gemm_phase<pg8::EpiKV, pg8::StaticOrder>(C.lds + RING_OFF, g, S, E, C.wave); }
            SEAM(pb + 2);
        }
        if (EN_ATT && IN(pb + 3)) { FRESH();
            for (int ui = C.vcu; ui < 256; ui += C.G) { const int h = ui >> 5, s = ui & 31;
                attn1::attn_unit(h, 63 - s, Qb, KNb, KPEb, VVb, ATTb, C.lds + RING_OFF, C.wave);
                attn1::attn_unit(h, s, Qb, KNb, KPEb, VVb, ATTb, C.lds + RING_OFF, C.wave); }
            SEAM(pb + 3);
        }
        if (EN_BR && IN(pb + 4)) { FRESH();
            { pg8::Gemm g{GMb, (const bf16*)(ws + WS_WA) + (size_t)l * D * GW, GW, GW, GW}; pg8::StaticOrder S; S.init(M, D, GW, GW, C.G, cid);
#ifdef DIAG_BR_PLAIN
              pg8::EpiPlain E{MRG, D}; pg8::gemm_phase<pg8::EpiPlain, pg8::StaticOrder>(C.lds + RING_OFF, g, S, E, C.wave); }
#else
              pg8::EpiGate<0> E{MRG, PROJ + PC_GA}; pg8::gemm_phase<pg8::EpiGate<0>, pg8::StaticOrder>(C.lds + RING_OFF, g, S, E, C.wave); }
#endif
            if (EN_BR2) { pg8::Gemm g{ATTb, (const bf16*)(ws + WS_WB) + (size_t)l * D * GW, GW, GW, GW}; pg8::StaticOrder S; S.init(M, D, GW, GW, C.G, cid);
              pg8::EpiGate<1> E{MRG, PROJ + PC_GB}; pg8::gemm_phase<pg8::EpiGate<1>, pg8::StaticOrder>(C.lds + RING_OFF, g, S, E, C.wave); }
            SEAM(pb + 4);
        }
        if (EN_OUT && IN(pb + 5)) { FRESH();
            pg8::Gemm g{MRG, (const bf16*)(ws + WS_WO) + (size_t)l * D * D, D, D, D}; pg8::StaticOrder S; S.init(M, D, D, D, C.G, cid);
            pg8::EpiPlain E{Yb, D}; pg8::gemm_phase<pg8::EpiPlain, pg8::StaticOrder>(C.lds + RING_OFF, g, S, E, C.wave);
            SEAM(pb + 5);
        }
        if (l == 0) {
            if (EN_T1 && IN(7)) { FRESH(); phase_resid<1>(C, INF(0), xres, Yb, nullptr, D, mod + 2 * D, INF(6) + l * D, INF(7) + l * D, mod + 4 * D, mod + 3 * D, H1b, nullptr, nullptr, nullptr, nullptr, nullptr, nullptr); SEAM(7); }
            if (EN_FFN && IN(8)) { FRESH();
                pg8::Gemm g{H1b, (const bf16*)(ws + WS_WGU), D, D, D}; pg8::StaticOrder S; S.init(M, 2 * FFP, D, D, C.G, cid);
#ifdef DIAG_FFN1_PLAIN
#ifndef DIAG_PLAIN_SHIFT
#define DIAG_PLAIN_SHIFT 0
#endif
                pg8::EpiPlain E{(bf16*)(ws + WS_ACT) + DIAG_PLAIN_SHIFT, 2 * FFP}; pg8::gemm_phase<pg8::EpiPlain, pg8::StaticOrder>(C.lds + RING_OFF, g, S, E, C.wave);
#else
#ifdef DIAG_FFN1_NOALIGN
                pg8::EpiSwiGLU E{(bf16*)(ws + WS_ACT), FFP}; pg8::gemm_phase<pg8::EpiSwiGLU, pg8::StaticOrder, false, true>(C.lds + RING_OFF, g, S, E, C.wave);
#else
                pg8::EpiSwiGLU E{(bf16*)(ws + WS_ACT), ACT_LD}; pg8::gemm_phase<pg8::EpiSwiGLU, pg8::StaticOrder>(C.lds + RING_OFF, g, S, E, C.wave);
#endif
#ifdef DIAG_FFN1_TWICE
                { pg8::EpiSwiGLU E2{(bf16*)(ws + DIAG_TWIN_OFF), FFP}; pg8::gemm_phase<pg8::EpiSwiGLU, pg8::StaticOrder>(C.lds + RING_OFF, g, S, E2, C.wave); }
#endif
#endif
                SEAM(8);
            }
            if (EN_FFN && EN_FFN2 && IN(9)) { FRESH();
                pg8::Gemm g{(const bf16*)(ws + WS_ACT), (const bf16*)(ws + WS_WD), FFP, FFP, FFP}; pg8::StaticOrder S; S.init(M, D, FFP, FFP, C.G, cid);
                pg8::EpiPlain E{Yb, D}; pg8::gemm_phase<pg8::EpiPlain, pg8::StaticOrder>(C.lds + RING_OFF, g, S, E, C.wave);
                SEAM(9);
            }
            if (EN_T1 && IN(10)) { FRESH(); const float* mod1 = MOD + 6 * D;
                phase_resid<1>(C, xres, xres, Yb, nullptr, D, mod + 5 * D, INF(8) + l * D, INF(5) + D, mod1 + 1 * D, mod1 + 0 * D, H1b, nullptr, nullptr, nullptr, nullptr, nullptr, nullptr); SEAM(10); }
        } else {
            int* topi = (int*)(ws + WS_TOPI); float* topg = (float*)(ws + WS_TOPG); int* list = (int*)(ws + WS_LIST); int* rowdest = (int*)(ws + WS_ROWDEST); float* rowgate = (float*)(ws + WS_ROWGATE);
            bf16* XG = (bf16*)(ws + WS_XG); bf16* ACTM = (bf16*)(ws + WS_ACTM); bf16* Y2 = (bf16*)(ws + WS_Y2);
            if (EN_T2 && IN(16)) { FRESH(); phase_resid<2>(C, xres, xres, Yb, nullptr, D, mod + 2 * D, INF(6) + l * D, INF(7) + l * D, mod + 4 * D, mod + 3 * D, Hb, INF(24), INF(25), topi, topg, list, C.ctl + CW_MOE); SEAM(16); }
            if (EN_GA && IN(17)) { FRESH(); moe_tab_build(C, C.ctl + CW_MOE, moetab); phase_gather(C, moetab, Hb, list, topg, XG, rowdest, rowgate); SEAM(17); }
#pragma unroll
            for (int ps = 0; ps < 2; ++ps) {
                if (EN_MOE && IN(18 + 2 * ps)) { FRESH();
                    moe_tab_build(C, C.ctl + CW_MOE, moetab);
                    const int np_all = moetab[8], p0 = ps * MOE_PASS_PANELS, np = min(max(np_all - p0, 0), MOE_PASS_PANELS);
                    pg8::Gemm g{XG, (const bf16*)(ws + WS_W13), D, D, D}; MoeOrder S; S.S.init(np * 256, 2 * EFF, D, D, C.G, cid); S.p0 = p0; S.estride = (size_t)2 * EFF * D * 2; S.absA = 1; S.tab = moetab;
                    pg8::EpiSwiGLU E{ACTM, EFF}; pg8::gemm_phase<pg8::EpiSwiGLU, MoeOrder>(C.lds + RING_OFF, g, S, E, C.wave);
                    SEAM(18 + 2 * ps);
                }
                if (EN_MOE && IN(19 + 2 * ps)) { FRESH();
                    moe_tab_build(C, C.ctl + CW_MOE, moetab);
                    const int np_all = moetab[8], p0 = ps * MOE_PASS_PANELS, np = min(max(np_all - p0, 0), MOE_PASS_PANELS);
                    pg8::Gemm g{ACTM, (const bf16*)(ws + WS_W2), EFF, EFF, EFF}; MoeOrder S; S.S.init(np * 256, D, EFF, EFF, C.G, cid); S.p0 = p0; S.estride = (size_t)D * EFF * 2; S.absA = 0; S.tab = moetab;
                    pg8::EpiMoeDown E{Y2, rowdest, rowgate}; pg8::gemm_phase<pg8::EpiMoeDown, MoeOrder>(C.lds + RING_OFF, g, S, E, C.wave);
                    SEAM(19 + 2 * ps);
                }
            }
            if (EN_FIN && IN(22)) { FRESH(); phase_resid<0>(C, xres, xres, Y2, Y2 + D, 2 * D, mod + 5 * D, INF(8) + l * D, nullptr, nullptr, nullptr, nullptr, nullptr, nullptr, nullptr, nullptr, nullptr, nullptr); }
        }
    }
#undef IN
#undef SEAM
#undef INF
}
#ifndef MK_DIAG
#define MK_DIAG 0
#endif
extern "C" void kernel_launch(void* const* d_in, const int* in_sizes, int n_in, void* d_out, int out_size, void* d_ws, size_t ws_size, hipStream_t stream) {
    static int grid = 0;
    if (grid == 0) {
        if (n_in != 29 || in_sizes[0] != M * D || out_size != M * D || ws_size < WS_END) { fprintf(stderr, "kernel_launch: unexpected sizes n_in %d in0 %d out %d ws %zu\n", n_in, n_in > 0 ? in_sizes[0] : -1, out_size, ws_size); grid = -1; return; }
        int dev = 0, cus = 0, per_cu = 0;
        if (hipGetDevice(&dev) != hipSuccess || hipDeviceGetAttribute(&cus, hipDeviceAttributeMultiprocessorCount, dev) != hipSuccess) { grid = -1; return; }
        if (hipFuncSetAttribute((const void*)mega_fwd, hipFuncAttributeMaxDynamicSharedMemorySize, LDS_BYTES) != hipSuccess) { fprintf(stderr, "hipFuncSetAttribute failed\n"); grid = -1; return; }
        if (hipOccupancyMaxActiveBlocksPerMultiprocessor(&per_cu, (const void*)mega_fwd, NWAVES * 64, LDS_BYTES) != hipSuccess || per_cu < 1) fprintf(stderr, "occupancy query reports %d\n", per_cu);
        (void)hipGetLastError();
        grid = cus;
    }
    if (grid < 0) return;
    if (hipMemsetAsync((char*)d_ws + WS_CTL, 0, CTL_ZERO_BYTES, stream) != hipSuccess) return;
    Args a{};
    for (int i = 0; i < 29; ++i) a.in[i] = d_in[i];
    a.out = (float*)d_out; a.ws = (unsigned char*)d_ws;
#if MK_DIAG
    diag_run(a, grid, stream);
#else
    a.ph_lo = 0; a.ph_hi = NPHASES;
    hipLaunchKernelGGL(mega_fwd, dim3(grid), dim3(NWAVES * 64), LDS_BYTES, stream, a);
#endif
}
```

```cpp
#include <hip/hip_runtime.h>
#include <hip/hip_bf16.h>
#include <cstdio>
#include <cstdint>
#include <cmath>
__device__ __forceinline__ int xor_idx16() { int i_; asm volatile("v_mbcnt_lo_u32_b32 %0, -1, 0\n\tv_mbcnt_hi_u32_b32 %0, -1, %0\n\tv_xor_b32 %0, 16, %0\n\tv_lshlrev_b32 %0, 2, %0" : "=v"(i_)); return i_; }
__device__ __forceinline__ int xor_idx32() { int i_; asm volatile("v_mbcnt_lo_u32_b32 %0, -1, 0\n\tv_mbcnt_hi_u32_b32 %0, -1, %0\n\tv_xor_b32 %0, 32, %0\n\tv_lshlrev_b32 %0, 2, %0" : "=v"(i_)); return i_; }
__device__ __forceinline__ float bperm_f(int idx, float v) { return __builtin_bit_cast(float, __builtin_amdgcn_ds_bpermute(idx, __builtin_bit_cast(int, v))); }
__device__ __forceinline__ float xsum32(float v) { return v + bperm_f(xor_idx32(), v); }
__device__ __forceinline__ float xmax32(float v) { return fmaxf(v, bperm_f(xor_idx32(), v)); }
#define dpp_f(v, ctrl, rmask, bmask) __builtin_bit_cast(float, __builtin_amdgcn_update_dpp(0, __builtin_bit_cast(int, (float)(v)), (ctrl), (rmask), (bmask), false))
__device__ __forceinline__ unsigned q8x4(float a, float b, float c, float d, float inv) {
    const int qa = __builtin_amdgcn_fmed3f(rintf(a * inv), -127.f, 127.f), qb = __builtin_amdgcn_fmed3f(rintf(b * inv), -127.f, 127.f), qc = __builtin_amdgcn_fmed3f(rintf(c * inv), -127.f, 127.f), qd = __builtin_amdgcn_fmed3f(rintf(d * inv), -127.f, 127.f);
    return (unsigned)(qa & 255) | ((unsigned)(qb & 255) << 8) | ((unsigned)(qc & 255) << 16) | ((unsigned)(qd & 255) << 24); }
__device__ __forceinline__ float wave_max_nn(float v) {
    float s = fmaxf(v, dpp_f(v, 0x111, 0xf, 0xf)); s = fmaxf(s, dpp_f(v, 0x112, 0xf, 0xf)); s = fmaxf(s, dpp_f(v, 0x113, 0xf, 0xf));
    s = fmaxf(s, dpp_f(s, 0x114, 0xf, 0xe)); s = fmaxf(s, dpp_f(s, 0x118, 0xf, 0xc)); s = fmaxf(s, dpp_f(s, 0x142, 0xa, 0xf)); s = fmaxf(s, dpp_f(s, 0x143, 0xc, 0xf));
    return __builtin_bit_cast(float, __builtin_amdgcn_readlane(__builtin_bit_cast(int, s), 63)); }
namespace pg8 {
#define PG8_LAS __attribute__((address_space(3)))
#ifndef PG8_SP2_DEFAULT
#define PG8_SP2_DEFAULT true
#endif
#ifndef PG8_AUX
#define PG8_AUX 0
#endif
typedef unsigned short bf16_t;
typedef short bf16x8 __attribute__((ext_vector_type(8)));
typedef float f32x4 __attribute__((ext_vector_type(4)));
typedef unsigned u32x4 __attribute__((ext_vector_type(4)));
typedef int i32x4 __attribute__((ext_vector_type(4)));
constexpr int BM = 256, BK = 64, HALF = 128, HTB = HALF * BK * 2  , STAGE_BYTES = 8 * HTB, NXCD = 8, WGM = 8;

__host__ __device__ __forceinline__ int lds_byte(int r, int c) { const int st = (r >> 4) * 2 + (c >> 5), rr = r & 15, cc = c & 31, ob = rr * 64 + cc * 2; return st * 1024 + (ob ^ (((ob >> 9) & 1) << 5)); }
__host__ __device__ __forceinline__ void stage_rc(int b, int& R, int& C) { const int st = b / 1024, sb = b % 1024, swz = sb ^ (((sb >> 9) & 1) << 5); R = (st >> 1) * 16 + swz / 64; C = (st & 1) * 32 + (swz % 64) / 2; }
__host__ __device__ __forceinline__ int perm32(int rho) { const int n = rho >> 4, i = rho & 15; return 8 * (i >> 2) + 4 * n + (i & 3); }


struct Unit { int pm, pn, aux; size_t aoff, boff; };
struct Gemm { const bf16_t* A; const bf16_t* Bt; int lda, ldb, K; const float* rowscale; float bscale; };
struct StaticOrder {
    int nM, nN, nwg, G, c; size_t astep, bstep;
    __device__ void init(int M, int N, int lda, int ldb, int G_, int c_) { nM = M / BM; nN = N / BM; nwg = nM * nN; G = G_; c = c_; astep = (size_t)BM * lda * 2; bstep = (size_t)BM * ldb * 2; }
    __device__ bool next(int i, Unit& u) const { return at((long)i * G + c, u); }
    __device__ bool at(long L, Unit& u) const {
        if (L >= nwg) return false;
        int wgid = (int)L; { const int q = nwg / NXCD, r = nwg % NXCD, xcd = wgid % NXCD, off = wgid / NXCD; wgid = (xcd < r ? xcd * (q + 1) : r * (q + 1) + (xcd - r) * q) + off; }
        const int nig = WGM * nN, gid = wgid / nig, fm = gid * WGM, gsz = (nM - fm) < WGM ? (nM - fm) : WGM;
        u.pm = fm + ((wgid % nig) % gsz); u.pn = (wgid % nig) / gsz; u.aux = 0; u.aoff = (size_t)u.pm * astep; u.boff = (size_t)u.pn * bstep; return true;
    }
};

typedef float f32x2cv_t __attribute__((ext_vector_type(2))); typedef __bf16 bf16x2cv_t __attribute__((ext_vector_type(2)));
__device__ __forceinline__ unsigned cvt_pk_bf16(float lo, float hi) { const f32x2cv_t v = {lo, hi}; const bf16x2cv_t b = __builtin_convertvector(v, bf16x2cv_t); return __builtin_bit_cast(unsigned, b); }
typedef float f32x2 __attribute__((ext_vector_type(2)));
__device__ __forceinline__ f32x2 gelu_pk(f32x2 v) {
    const f32x2 av = __builtin_elementwise_abs(v), d = av * 0.2316418882f + 1.0f;
    f32x2 t; t.x = __builtin_amdgcn_rcpf(d.x); t.y = __builtin_amdgcn_rcpf(d.y);
    f32x2 q = t * 0.5307027145f + (-0.7265760135f); q = q * t + 0.7107068705f; q = q * t + (-0.142248368f); q = q * t + 0.127414796f; q = q * t;
    const f32x2 s = (v * v) * (-0.72134752044f);
    f32x2 e; e.x = __builtin_amdgcn_exp2f(s.x); e.y = __builtin_amdgcn_exp2f(s.y);
    const f32x2 m = v * (q * e), r = v - m;
    f32x2 o; o.x = v.x < 0.f ? m.x : r.x; o.y = v.y < 0.f ? m.y : r.y; return o;
}
template <class Epi, class Sched, bool ALIGN_EPI = true, bool SP2 = PG8_SP2_DEFAULT, bool GATHER = false, bool I8 = false, bool PSC = false>
__device__ __forceinline__ void gemm_phase(PG8_LAS unsigned char* lds, const Gemm g, const Sched& S, const Epi& E, const int wave_id) {
    int ln_; asm volatile("v_mbcnt_lo_u32_b32 %0, -1, 0\n\tv_mbcnt_hi_u32_b32 %0, -1, %0" : "=v"(ln_)); const int tid_ = wave_id * 64 + ln_;
    const int tid = tid_, wid = __builtin_amdgcn_readfirstlane(tid >> 6), lane = tid & 63, wr = wid >> 2, wc = wid & 3, fr = lane & 15, fq = lane >> 4;
    const int K = g.K, nt = K / BK;
    unsigned voffA[2], voffB[2];
#pragma unroll
    for (int i = 0; i < 2; ++i) { int R, C; stage_rc(tid * 16 + i * 8192, R, C); const int Rb = Epi::PERM ? ((R & ~31) + perm32(R & 31)) : R;
        voffA[i] = (unsigned)(R * g.lda + C) * 2u; voffB[i] = (unsigned)(Rb * g.ldb + C) * 2u; }
    unsigned vg[2][2] = {{0u, 0u}, {0u, 0u}}, vn[2][2] = {{0u, 0u}, {0u, 0u}}; int gR[2], gC[2];
#pragma unroll
    for (int i = 0; i < 2; ++i) { stage_rc(tid * 16 + i * 8192, gR[i], gC[i]); }
    const size_t kstep = (size_t)(BK * 2);
    const size_t hstepA = (size_t)HALF * g.lda * 2, hstepB = (size_t)HALF * g.ldb * 2;
    const unsigned ldsw = (unsigned)wid * 1024u;
    const int aoff = lds_byte(wr * 64 + fr, fq * 8), boff = lds_byte(wc * 32 + fr, fq * 8);
#define PG8_SA(b, h) (((b) * 2 + (h)) * HTB)
#define PG8_SB(b, h) ((4 + (b) * 2 + (h)) * HTB)
#define PG8_STAGE(bufoff, gbase, voff) do { _Pragma("unroll") for (int _i = 0; _i < 2; ++_i) \
        __builtin_amdgcn_global_load_lds((const unsigned*)((const char*)(gbase) + (voff)[_i]), (PG8_LAS unsigned*)(lds + (bufoff) + ldsw + _i * 8192), 16, 0, PG8_AUX); } while (0)
#define PG8_LDA(dst, b, h) do { _Pragma("unroll") for (int m = 0; m < 4; ++m) _Pragma("unroll") for (int k = 0; k < 2; ++k) dst[m][k] = *(const PG8_LAS bf16x8*)(lds + PG8_SA(b, h) + aoff + m * 2048 + k * 1024); } while (0)
#define PG8_LDB(dst, b, h) do { _Pragma("unroll") for (int n = 0; n < 2; ++n) _Pragma("unroll") for (int k = 0; k < 2; ++k) dst[n][k] = *(const PG8_LAS bf16x8*)(lds + PG8_SB(b, h) + boff + n * 2048 + k * 1024); } while (0)
#define PG8_MMA(ai, bj, At, Bt) do { __builtin_amdgcn_s_setprio(1); _Pragma("unroll") for (int m = 0; m < 4; ++m) _Pragma("unroll") for (int n = 0; n < 2; ++n) _Pragma("unroll") for (int k = 0; k < 2; ++k) \
        { if constexpr (I8) acc[ai][bj][m][n] = __builtin_bit_cast(f32x4, __builtin_amdgcn_mfma_i32_16x16x64_i8(__builtin_bit_cast(i32x4, Bt[n][k]), __builtin_bit_cast(i32x4, At[m][k]), __builtin_bit_cast(i32x4, acc[ai][bj][m][n]), 0, 0, 0)); \
          else acc[ai][bj][m][n] = __builtin_amdgcn_mfma_f32_16x16x32_bf16(Bt[n][k], At[m][k], acc[ai][bj][m][n], 0, 0, 0); } __builtin_amdgcn_s_setprio(0); } while (0)
#define PG8_WAIT_V(n) asm volatile("s_waitcnt vmcnt(" #n ")" ::: "memory")
#define PG8_WAIT_L(n) asm volatile("s_waitcnt lgkmcnt(" #n ")" ::: "memory")
#define PG8_BAR __builtin_amdgcn_s_barrier()
#define PG8_SCHED __builtin_amdgcn_sched_barrier(0)
    static_assert(!GATHER || SP2, "GATHER is written for the SP2 loop");
    Unit cur, nxt; int ui = 0;
    if (!S.next(0, cur)) return;
    f32x4 acc[2][2][4][2];
#pragma unroll
    for (int a = 0; a < 2; ++a)
#pragma unroll
        for (int b = 0; b < 2; ++b)
#pragma unroll
            for (int m = 0; m < 4; ++m)
#pragma unroll
                for (int n = 0; n < 2; ++n) acc[a][b][m][n] = (f32x4){0.f, 0.f, 0.f, 0.f};
    bf16x8 At[4][2], B0[2][2], B1[2][2];
    const char* cA = (const char*)g.A + (GATHER ? (size_t)0 : cur.aoff); const char* cB = (const char*)g.Bt + cur.boff;
    if constexpr (GATHER) S.avoff(cur, gR, gC, vg);
#define PG8_STAGE_A(bufoff, ptr, h, useNext) do { if constexpr (GATHER) { if (useNext) PG8_STAGE(bufoff, ptr, vn[h]); else PG8_STAGE(bufoff, ptr, vg[h]); } else PG8_STAGE(bufoff, (ptr) + (h) * hstepA, voffA); } while (0)
    if constexpr (SP2) {
        PG8_STAGE(PG8_SB(0, 0), cB, voffB); PG8_STAGE(PG8_SB(0, 1), cB + hstepB, voffB); PG8_STAGE_A(PG8_SA(0, 0), cA, 0, false); PG8_STAGE_A(PG8_SA(0, 1), cA, 1, false);
        if (wr == 1) PG8_BAR;
        PG8_WAIT_V(2); PG8_BAR;
        PG8_STAGE(PG8_SB(1, 0), cB + kstep, voffB); PG8_STAGE_A(PG8_SA(1, 0), cA + kstep, 0, false); PG8_STAGE(PG8_SB(1, 1), cB + hstepB + kstep, voffB);
        PG8_WAIT_V(6); PG8_BAR;
    } else {
        PG8_STAGE(PG8_SB(0, 0), cB, voffB); PG8_STAGE(PG8_SA(0, 0), cA, voffA); PG8_STAGE(PG8_SB(0, 1), cB + hstepB, voffB); PG8_STAGE(PG8_SA(0, 1), cA + hstepA, voffA);
        if (wr == 1) PG8_BAR;
        PG8_WAIT_V(4); PG8_BAR;
        PG8_STAGE(PG8_SB(1, 0), cB + kstep, voffB); PG8_STAGE(PG8_SA(1, 0), cA + kstep, voffA); PG8_STAGE(PG8_SB(1, 1), cB + hstepB + kstep, voffB);
        PG8_WAIT_V(6); PG8_BAR;
    }
    for (;;) {
        const bool has_next = S.next(ui + 1, nxt);
        const char* nA = GATHER ? (const char*)g.A : (has_next ? (const char*)g.A + nxt.aoff : cA); const char* nB = has_next ? (const char*)g.Bt + nxt.boff : cB;
        if constexpr (GATHER) { if (has_next && nxt.aux != cur.aux) S.avoff(nxt, gR, gC, vn); else { vn[0][0] = vg[0][0]; vn[0][1] = vg[0][1]; vn[1][0] = vg[1][0]; vn[1][1] = vg[1][1]; } }
        for (int t = 0; t < nt; t += 2) {
            const bool last = (t == nt - 2);
            const char* a1 = cA + (size_t)(t + 1) * kstep;
            const char* a2 = last ? nA : cA + (size_t)(t + 2) * kstep; const char* b2 = last ? nB : cB + (size_t)(t + 2) * kstep;
            const char* a3 = a2 + kstep; const char* b3 = b2 + kstep;
            if constexpr (SP2) {
            PG8_LDB(B0, 0, 0); PG8_LDB(B1, 0, 1); PG8_SCHED; PG8_LDA(At, 0, 0); PG8_STAGE_A(PG8_SA(1, 1), a1, 1, false);
            PG8_WAIT_V(8); PG8_WAIT_L(0); PG8_BAR; PG8_MMA(0, 0, At, B0); PG8_MMA(0, 1, At, B1); PG8_BAR; PG8_SCHED;
            PG8_LDA(At, 0, 1); PG8_STAGE(PG8_SB(0, 0), b2, voffB); PG8_STAGE(PG8_SB(0, 1), b2 + hstepB, voffB); PG8_STAGE_A(PG8_SA(0, 0), a2, 0, last);
            PG8_WAIT_V(8); PG8_WAIT_L(0); PG8_BAR; PG8_MMA(1, 0, At, B0); PG8_MMA(1, 1, At, B1); PG8_BAR; PG8_SCHED;
            PG8_LDB(B0, 1, 0); PG8_LDB(B1, 1, 1); PG8_SCHED; PG8_LDA(At, 1, 0); PG8_STAGE_A(PG8_SA(0, 1), a2, 1, last);
            PG8_WAIT_V(8); PG8_WAIT_L(0); PG8_BAR; PG8_MMA(0, 0, At, B0); PG8_MMA(0, 1, At, B1); PG8_BAR; PG8_SCHED;
            PG8_LDA(At, 1, 1); PG8_STAGE(PG8_SB(1, 0), b3, voffB); PG8_STAGE(PG8_SB(1, 1), b3 + hstepB, voffB); PG8_STAGE_A(PG8_SA(1, 0), a3, 0, last);
            PG8_WAIT_V(8); PG8_WAIT_L(0); PG8_BAR; PG8_MMA(1, 0, At, B0); PG8_MMA(1, 1, At, B1); PG8_BAR; PG8_SCHED;
            } else {
            PG8_LDB(B0, 0, 0); PG8_SCHED; PG8_LDA(At, 0, 0); PG8_STAGE(PG8_SA(1, 1), a1 + hstepA, voffA);
            PG8_WAIT_L(8); PG8_BAR; PG8_WAIT_L(0); PG8_MMA(0, 0, At, B0); PG8_BAR; PG8_SCHED;
            PG8_LDB(B1, 0, 1); PG8_STAGE(PG8_SB(0, 0), b2, voffB);
            PG8_BAR; PG8_WAIT_L(0); PG8_MMA(0, 1, At, B1); PG8_BAR;
            PG8_LDA(At, 0, 1); PG8_STAGE(PG8_SA(0, 0), a2, voffA);
            PG8_BAR; PG8_WAIT_L(0); PG8_MMA(1, 0, At, B0); PG8_BAR; PG8_SCHED;
            PG8_STAGE(PG8_SB(0, 1), b2 + hstepB, voffB);
            PG8_WAIT_V(6); PG8_BAR; PG8_MMA(1, 1, At, B1); PG8_BAR;
            PG8_LDB(B0, 1, 0); PG8_SCHED; PG8_LDA(At, 1, 0); PG8_STAGE(PG8_SA(0, 1), a2 + hstepA, voffA);
            PG8_WAIT_L(8); PG8_BAR; PG8_WAIT_L(0); PG8_MMA(0, 0, At, B0); PG8_BAR; PG8_SCHED;
            PG8_LDB(B1, 1, 1); PG8_STAGE(PG8_SB(1, 0), b3, voffB);
            PG8_BAR; PG8_WAIT_L(0); PG8_MMA(0, 1, At, B1); PG8_BAR;
            PG8_LDA(At, 1, 1); PG8_STAGE(PG8_SA(1, 0), a3, voffA);
            PG8_BAR; PG8_WAIT_L(0); PG8_MMA(1, 0, At, B0); PG8_BAR; PG8_SCHED;
            PG8_STAGE(PG8_SB(1, 1), b3 + hstepB, voffB);
            PG8_WAIT_V(6); PG8_BAR; PG8_MMA(1, 1, At, B1); PG8_BAR;
            }
        }
        if constexpr (ALIGN_EPI) { if (wr == 0) PG8_BAR; }
        int lnE_; asm volatile("v_mbcnt_lo_u32_b32 %0, -1, 0\n\tv_mbcnt_hi_u32_b32 %0, -1, %0" : "=v"(lnE_)); const int frE = lnE_ & 15, fqE = lnE_ >> 4;
        if constexpr (I8) {
            float rsv[2][4];
            if constexpr (GATHER || PSC) {
#pragma unroll
                for (int a = 0; a < 2; ++a)
#pragma unroll
                    for (int m = 0; m < 4; ++m) rsv[a][m] = S.rowscale_of(cur, wr * 64 + frE + a * HALF + m * 16) * g.bscale;
            } else {
#pragma unroll
                for (int a = 0; a < 2; ++a)
#pragma unroll
                    for (int m = 0; m < 4; ++m) rsv[a][m] = g.rowscale[cur.pm * BM + wr * 64 + frE + a * HALF + m * 16] * g.bscale; }
#pragma unroll
            for (int a = 0; a < 2; ++a)
#pragma unroll
                for (int m = 0; m < 4; ++m)
#pragma unroll
                    for (int b = 0; b < 2; ++b)
#pragma unroll
                        for (int n = 0; n < 2; ++n) acc[a][b][m][n] = __builtin_convertvector(__builtin_bit_cast(i32x4, acc[a][b][m][n]), f32x4) * rsv[a][m]; }
        if constexpr (!Epi::AFTER_DRAIN) { E(acc, cur, wr, wc, frE, fqE); }
        if (!has_next) break;
#pragma unroll
        for (int a = 0; a < 2; ++a)
#pragma unroll
            for (int b = 0; b < 2; ++b)
#pragma unroll
                for (int m = 0; m < 4; ++m)
#pragma unroll
                    for (int n = 0; n < 2; ++n) acc[a][b][m][n] = (f32x4){0.f, 0.f, 0.f, 0.f};
        cur = nxt; cA = nA; cB = nB; ++ui;
        if constexpr (GATHER) { vg[0][0] = vn[0][0]; vg[0][1] = vn[0][1]; vg[1][0] = vn[1][0]; vg[1][1] = vn[1][1]; }
        if constexpr (ALIGN_EPI) { if (wr == 1) PG8_BAR; }
    }
    PG8_WAIT_V(0);
    if constexpr (!ALIGN_EPI) { if (wr == 0) PG8_BAR; }
    PG8_BAR;

#undef PG8_SA
#undef PG8_SB
#undef PG8_STAGE
#undef PG8_STAGE_A
#undef PG8_LDA
#undef PG8_LDB
#undef PG8_MMA
#undef PG8_WAIT_V
#undef PG8_WAIT_L
#undef PG8_BAR
#undef PG8_SCHED
}
typedef unsigned u32x4_t __attribute__((ext_vector_type(4)));
__device__ __forceinline__ u32x4_t pack8(const f32x4& v0, const f32x4& v1) { u32x4_t w; w.x = cvt_pk_bf16(v0[0], v0[1]); w.y = cvt_pk_bf16(v0[2], v0[3]); w.z = cvt_pk_bf16(v1[0], v1[1]); w.w = cvt_pk_bf16(v1[2], v1[3]); return w; }
__device__ __forceinline__ float bf_lo(unsigned w) { return __uint_as_float(w << 16); }
__device__ __forceinline__ float bf_hi(unsigned w) { return __uint_as_float(w & 0xffff0000u); }
__device__ __forceinline__ void unpack8(const u32x4_t& w, f32x4& v0, f32x4& v1) { v0 = (f32x4){bf_lo(w.x), bf_hi(w.x), bf_lo(w.y), bf_hi(w.y)}; v1 = (f32x4){bf_lo(w.z), bf_hi(w.z), bf_lo(w.w), bf_hi(w.w)}; }
__device__ __forceinline__ float sigmoidf_(float x) { return __builtin_amdgcn_rcpf(1.0f + __builtin_amdgcn_exp2f(-1.4426950408889634f * x)); }
__device__ __forceinline__ f32x4 gelu4(const f32x4& v) { const f32x2 a = gelu_pk((f32x2){v[0], v[1]}), b = gelu_pk((f32x2){v[2], v[3]}); return (f32x4){a.x, a.y, b.x, b.y}; }
__device__ __forceinline__ f32x4 sig4(const f32x4& v) { return (f32x4){sigmoidf_(v[0]), sigmoidf_(v[1]), sigmoidf_(v[2]), sigmoidf_(v[3])}; }
__device__ __forceinline__ float sum4(const f32x4& v) { return (v[0] + v[1]) + (v[2] + v[3]); }
__device__ __forceinline__ float red_fq(float s) { s += bperm_f(xor_idx16(), s); return xsum32(s); }

struct EpiProj {
    static constexpr bool PERM = true, AFTER_DRAIN = false;
    bf16_t* P; bf16_t* KPE; float* sumv; float* ssqv; float* ssqq; float* ssqkv; const float* cosT; const float* sinT;
    __device__ __forceinline__ void operator()(const f32x4 (&acc)[2][2][4][2], const Unit& u, int wr, int wc, int fr, int fq) const {
        const int row0 = u.pm * BM + wr * 64 + fr, col0 = u.pn * BM + wc * 32 + 8 * fq, pn = u.pn;
#pragma unroll
        for (int ai = 0; ai < 2; ++ai)
#pragma unroll
            for (int m = 0; m < 4; ++m) {
                const int row = row0 + ai * HALF + m * 16; bf16_t* rowp = P + (size_t)row * 3840 + col0;
                if (pn < 4) {
                    float s = 0.f, q = 0.f;
#pragma unroll
                    for (int bj = 0; bj < 2; ++bj) { const f32x4 v0 = gelu4(acc[ai][bj][m][0]), v1 = gelu4(acc[ai][bj][m][1]); *(u32x4_t*)(rowp + bj * HALF) = pack8(v0, v1);
                        s += sum4(v0) + sum4(v1); q += sum4(v0 * v0) + sum4(v1 * v1); }
                    if (pn >= 2) { s = red_fq(s); q = red_fq(q); if (fq == 0) { sumv[row * 8 + (pn - 2) * 4 + wc] = s; ssqv[row * 8 + (pn - 2) * 4 + wc] = q; } }
                } else if (pn < 12) {
#pragma unroll
                    for (int bj = 0; bj < 2; ++bj) *(u32x4_t*)(rowp + bj * HALF) = pack8(sig4(acc[ai][bj][m][0]), sig4(acc[ai][bj][m][1]));
                } else if (pn < 14) {
                    float q = 0.f;
#pragma unroll
                    for (int bj = 0; bj < 2; ++bj) { const f32x4 v0 = acc[ai][bj][m][0], v1 = acc[ai][bj][m][1]; *(u32x4_t*)(rowp + bj * HALF) = pack8(v0, v1); q += sum4(v0 * v0) + sum4(v1 * v1); }
                    q = red_fq(q); if (fq == 0) { if (pn == 12) ssqkv[row * 4 + wc] = q; else ssqq[row * 8 + wc] = q; }
                } else {
                    { const f32x4 v0 = acc[ai][0][m][0], v1 = acc[ai][0][m][1]; *(u32x4_t*)(rowp) = pack8(v0, v1); float q = sum4(v0 * v0) + sum4(v1 * v1); q = red_fq(q); if (fq == 0) ssqq[row * 8 + 4 + wc] = q; }
                    if (wc == 0) { const f32x4 v0 = acc[ai][1][m][0], v1 = acc[ai][1][m][1];
                        const f32x4 cs = *(const f32x4*)(cosT + (size_t)row * 16 + 4 * fq), sn = *(const f32x4*)(sinT + (size_t)row * 16 + 4 * fq);
                        const f32x4 o0 = (f32x4){v0[0] * cs[0] - v0[1] * sn[0], v0[1] * cs[0] + v0[0] * sn[0], v0[2] * cs[1] - v0[3] * sn[1], v0[3] * cs[1] + v0[2] * sn[1]};
                        const f32x4 o1 = (f32x4){v1[0] * cs[2] - v1[1] * sn[2], v1[1] * cs[2] + v1[0] * sn[2], v1[2] * cs[3] - v1[3] * sn[3], v1[3] * cs[3] + v1[2] * sn[3]};
                        *(u32x4_t*)(KPE + (size_t)row * 32 + 8 * fq) = pack8(o0, o1); }
                }
#ifndef DIAG_NOFENCE
                asm volatile("" ::: "memory");
#endif
            }
    }
};
struct EpiQ {
    static constexpr bool PERM = true, AFTER_DRAIN = false;
    bf16_t* Q; const float* ssqq; const float* cosT; const float* sinT; float c2;
    __device__ __forceinline__ void operator()(const f32x4 (&acc)[2][2][4][2], const Unit& u, int wr, int wc, int fr, int fq) const {
        const int row0 = u.pm * BM + wr * 64 + fr, col0 = u.pn * BM + wc * 32 + 8 * fq;
#pragma unroll
        for (int ai = 0; ai < 2; ++ai)
#pragma unroll
            for (int m = 0; m < 4; ++m) {
                const int row = row0 + ai * HALF + m * 16; const f32x4 qa = *(const f32x4*)(ssqq + row * 8), qb = *(const f32x4*)(ssqq + row * 8 + 4);
                const float sc = c2 * __builtin_amdgcn_rsqf((((qa[0] + qa[1]) + (qa[2] + qa[3])) + ((qb[0] + qb[1]) + (qb[2] + qb[3]))) * (1.0f / 384.0f) + 1e-6f);
#pragma unroll
                for (int bj = 0; bj < 2; ++bj) { const int c = col0 + bj * HALF, off = c % 96; f32x4 v0 = acc[ai][bj][m][0] * sc, v1 = acc[ai][bj][m][1] * sc;
                    if (off >= 64) { const int j0 = (off - 64) >> 1; const f32x4 cs = *(const f32x4*)(cosT + (size_t)row * 16 + j0), sn = *(const f32x4*)(sinT + (size_t)row * 16 + j0);
                        const f32x4 o0 = (f32x4){v0[0] * cs[0] - v0[1] * sn[0], v0[1] * cs[0] + v0[0] * sn[0], v0[2] * cs[1] - v0[3] * sn[1], v0[3] * cs[1] + v0[2] * sn[1]};
                        const f32x4 o1 = (f32x4){v1[0] * cs[2] - v1[1] * sn[2], v1[1] * cs[2] + v1[0] * sn[2], v1[2] * cs[3] - v1[3] * sn[3], v1[3] * cs[3] + v1[2] * sn[3]};
                        v0 = o0; v1 = o1; }
                    *(u32x4_t*)(Q + (size_t)row * 768 + c) = pack8(v0, v1); }
                asm volatile("" ::: "memory");
            }
    }
};
struct EpiKV {
    static constexpr bool PERM = true, AFTER_DRAIN = false;
    bf16_t* KN; bf16_t* VV; const float* ssqkv; float* kmaxs;
    __device__ __forceinline__ void operator()(const f32x4 (&acc)[2][2][4][2], const Unit& u, int wr, int wc, int fr, int fq) const {
        const int row0 = u.pm * BM + wr * 64 + fr, col0 = (u.pn & 1) * BM + wc * 32 + 8 * fq; bf16_t* base = (u.pn < 2) ? KN : VV;
        float mx0 = 0.f, mx1 = 0.f;
#pragma unroll
        for (int ai = 0; ai < 2; ++ai)
#pragma unroll
            for (int m = 0; m < 4; ++m) {
                const int row = row0 + ai * HALF + m * 16; const f32x4 qa = *(const f32x4*)(ssqkv + row * 4); const float sc = __builtin_amdgcn_rsqf(((qa[0] + qa[1]) + (qa[2] + qa[3])) * (1.0f / 256.0f) + 1e-6f);
                const f32x4 a0 = acc[ai][0][m][0] * sc, a1 = acc[ai][0][m][1] * sc, b0 = acc[ai][1][m][0] * sc, b1 = acc[ai][1][m][1] * sc;
                *(u32x4_t*)(base + (size_t)row * 512 + col0) = pack8(a0, a1); *(u32x4_t*)(base + (size_t)row * 512 + col0 + HALF) = pack8(b0, b1);
                if (u.pn < 2) { mx0 = fmaxf(mx0, red_fq(sum4(a0 * a0) + sum4(a1 * a1))); mx1 = fmaxf(mx1, red_fq(sum4(b0 * b0) + sum4(b1 * b1))); }
                asm volatile("" ::: "memory");
            }
        if (u.pn < 2) { mx0 = wave_max_nn(mx0); mx1 = wave_max_nn(mx1);
            if ((fr | fq) == 0) { float* kp = kmaxs + ((2 * (4 * u.pn + (wc >> 1)) + (wc & 1)) * 64 + u.pm) * 2 + wr; kp[0] = mx0; kp[4 * 128] = mx1; } }
    }
};
template <int MODE> struct EpiGate {
    static constexpr bool PERM = true, AFTER_DRAIN = false;
    bf16_t* O; const bf16_t* G;
    __device__ __forceinline__ void operator()(const f32x4 (&acc)[2][2][4][2], const Unit& u, int wr, int wc, int fr, int fq) const {
        const int row0 = u.pm * BM + wr * 64 + fr, col0 = u.pn * BM + wc * 32 + 8 * fq;
#pragma unroll
        for (int ai = 0; ai < 2; ++ai)
#pragma unroll
            for (int m = 0; m < 4; ++m) {
                const int row = row0 + ai * HALF + m * 16;
#pragma unroll
                for (int bj = 0; bj < 2; ++bj) { const int c = col0 + bj * HALF; f32x4 g0, g1; unpack8(*(const u32x4_t*)(G + (size_t)row * 3840 + c), g0, g1);
                    f32x4 v0 = acc[ai][bj][m][0] * g0, v1 = acc[ai][bj][m][1] * g1;
                    if (MODE == 1) { f32x4 t0, t1; unpack8(*(const u32x4_t*)(O + (size_t)row * 1024 + c), t0, t1); v0 += t0; v1 += t1; }
                    *(u32x4_t*)(O + (size_t)row * 1024 + c) = pack8(v0, v1); }
                asm volatile("" ::: "memory");
            }
    }
};
struct EpiPlain {
    static constexpr bool PERM = true, AFTER_DRAIN = false;
    bf16_t* O; int ldc;
    __device__ __forceinline__ void operator()(const f32x4 (&acc)[2][2][4][2], const Unit& u, int wr, int wc, int fr, int fq) const {
        const int row0 = u.pm * BM + wr * 64 + fr, col0 = u.pn * BM + wc * 32 + 8 * fq;
#pragma unroll
        for (int ai = 0; ai < 2; ++ai)
#pragma unroll
            for (int m = 0; m < 4; ++m) {
                const int row = row0 + ai * HALF + m * 16;
#pragma unroll
                for (int bj = 0; bj < 2; ++bj) *(u32x4_t*)(O + (size_t)row * ldc + col0 + bj * HALF) = pack8(acc[ai][bj][m][0], acc[ai][bj][m][1]);
            }
    }
};
struct EpiSwiGLU {
    static constexpr bool PERM = true, AFTER_DRAIN = false;
    bf16_t* O; int ldc;
    __device__ __forceinline__ void operator()(const f32x4 (&acc)[2][2][4][2], const Unit& u, int wr, int wc, int fr, int fq) const {
        const int row0 = u.pm * BM + wr * 64 + fr, col0 = u.pn * HALF + wc * 32 + 8 * fq;
#pragma unroll
        for (int ai = 0; ai < 2; ++ai)
#pragma unroll
            for (int m = 0; m < 4; ++m) {
                const int row = row0 + ai * HALF + m * 16;
                const f32x4 g0 = acc[ai][0][m][0], g1 = acc[ai][0][m][1];
#ifdef DIAG_NOSIG
#if DIAG_NOSIG == 2
                const f32x4 v0 = g0, v1 = g1;
#elif DIAG_NOSIG == 3
                const f32x4 v0 = acc[ai][1][m][0], v1 = acc[ai][1][m][1];
#else
                const f32x4 v0 = g0 * acc[ai][1][m][0], v1 = g1 * acc[ai][1][m][1];
#endif
#else
                const f32x4 v0 = g0 * sig4(g0) * acc[ai][1][m][0], v1 = g1 * sig4(g1) * acc[ai][1][m][1];
#endif
#ifdef DIAG_SWIGLU_WIDE
#ifndef DIAG_WIDE_SHIFT
#define DIAG_WIDE_SHIFT 0
#endif
                *(u32x4_t*)(O + (size_t)row * (2 * ldc) + u.pn * BM + DIAG_WIDE_SHIFT + wc * 32 + 8 * fq) = pack8(v0, v1);
#ifndef DIAG_WIDE_8
                *(u32x4_t*)(O + (size_t)row * (2 * ldc) + u.pn * BM + wc * 32 + 8 * fq + HALF) = pack8(acc[ai][1][m][0], acc[ai][1][m][1]);
#endif
#else
                *(u32x4_t*)(O + (size_t)row * ldc + col0) = pack8(v0, v1);
#endif
#ifdef DIAG_STORE_NOP
                asm volatile("s_nop 7\n\ts_nop 7" ::: "memory");
#endif
            }
    }
};
struct EpiSwiGLU8 {
    static constexpr bool PERM = true, AFTER_DRAIN = false;
    unsigned char* O; int ldc; const float* lhs; const __attribute__((address_space(3))) int* tab; int mrows;
    __device__ __forceinline__ void operator()(const f32x4 (&acc)[2][2][4][2], const Unit& u, int wr, int wc, int fr, int fq) const {
        int e = 0;
#pragma unroll
        for (int q = 1; q < 8; ++q) e += (u.aux >= tab[q]) ? 1 : 0;
        e = __builtin_amdgcn_readfirstlane(e);
        const int rl0 = wr * 64 + fr, pos0 = (u.aux - tab[e]) * BM, cnt = tab[16 + e], row0 = u.pm * BM + rl0, col0 = u.pn * HALF + wc * 32 + 8 * fq;
        float inv[2][4];
#pragma unroll
        for (int ai = 0; ai < 2; ++ai)
#pragma unroll
            for (int m = 0; m < 4; ++m) { const int i = pos0 + rl0 + ai * HALF + m * 16; const float sc = (i < cnt) ? lhs[e * mrows + i] : 0.f; inv[ai][m] = sc > 0.f ? __builtin_amdgcn_rcpf(sc) : 0.f; }
#pragma unroll
        for (int ai = 0; ai < 2; ++ai)
#pragma unroll
            for (int m = 0; m < 4; ++m) {
                const int row = row0 + ai * HALF + m * 16; const f32x4 g0 = acc[ai][0][m][0], g1 = acc[ai][0][m][1];
                const f32x4 v0 = g0 * sig4(g0) * acc[ai][1][m][0], v1 = g1 * sig4(g1) * acc[ai][1][m][1]; const float iv = inv[ai][m];
                *(unsigned long long*)(O + (size_t)row * ldc + col0) = (unsigned long long)q8x4(v0[0], v0[1], v0[2], v0[3], iv) | ((unsigned long long)q8x4(v1[0], v1[1], v1[2], v1[3], iv) << 32);
                asm volatile("" ::: "memory");
            }
    }
};
struct EpiMoeDown {
    static constexpr bool PERM = true, AFTER_DRAIN = false;
    bf16_t* Y2; const int* list; const float* topg; const __attribute__((address_space(3))) int* tab; int mrows;
    __device__ __forceinline__ void operator()(const f32x4 (&acc)[2][2][4][2], const Unit& u, int wr, int wc, int fr, int fq) const {
        int e = 0;
#pragma unroll
        for (int q = 1; q < 8; ++q) e += (u.aux >= tab[q]) ? 1 : 0;
        e = __builtin_amdgcn_readfirstlane(e);
        const int base = (u.aux - tab[e]) * BM + wr * 64 + fr, cnt = tab[16 + e], col0 = u.pn * BM + wc * 32 + 8 * fq;
#pragma unroll
        for (int ai = 0; ai < 2; ++ai)
#pragma unroll
            for (int m = 0; m < 4; ++m) {
                const int i = base + ai * HALF + m * 16;
                if (i < cnt) { const int d = list[e * mrows + i]; const float g = topg[d];
#pragma unroll
                    for (int bj = 0; bj < 2; ++bj) *(u32x4_t*)(Y2 + (size_t)d * 1024 + col0 + bj * HALF) = pack8(acc[ai][bj][m][0] * g, acc[ai][bj][m][1] * g); }
                asm volatile("" ::: "memory");
            }
    }
};
struct EpiF32Tile {
    static constexpr bool PERM = true, AFTER_DRAIN = false;
    float* T;
    __device__ __forceinline__ void operator()(const f32x4 (&acc)[2][2][4][2], const Unit& u, int wr, int wc, int fr, int fq) const {
        const int row0 = wr * 64 + fr, col0 = wc * 32 + 8 * fq;
#pragma unroll
        for (int ai = 0; ai < 2; ++ai)
#pragma unroll
            for (int m = 0; m < 4; ++m) { float* rp = T + (size_t)(row0 + ai * HALF + m * 16) * BM + col0;
#pragma unroll
                for (int bj = 0; bj < 2; ++bj) { *(f32x4*)(rp + bj * HALF) = acc[ai][bj][m][0]; *(f32x4*)(rp + bj * HALF + 4) = acc[ai][bj][m][1]; } }
    }
};
}
namespace attn1 {
using bf16x8 = __attribute__((ext_vector_type(8))) short;
using s16x4 = __attribute__((ext_vector_type(4))) short;
using f32x16 = __attribute__((ext_vector_type(16))) float;
using u32x4 = __attribute__((ext_vector_type(4))) unsigned;
typedef short v4i16_t __attribute__((ext_vector_type(4)));
typedef __attribute__((address_space(3))) unsigned char* lptr;
constexpr int KSLOT = 12288, VSLOT = 8192;
constexpr int L_K = 0, L_V = 2 * KSLOT, L_WS = L_V + 2 * VSLOT, L_OST = L_WS + 8 * 256, L_BYTES = L_OST + 8 * 4096;
__device__ __forceinline__ int crow(int r, int hi) { return (r & 3) + 8 * (r >> 2) + 4 * hi; }
__device__ __forceinline__ unsigned cvtpk(float lo, float hi) { return pg8::cvt_pk_bf16(lo, hi); }
#define ATT_MFMA(a, b, c) __builtin_amdgcn_mfma_f32_32x32x16_bf16(a, b, c, 0, 0, 0)
__device__ __forceinline__ void attn_unit(int h, int qb, const unsigned short* Q, const unsigned short* KN, const unsigned short* KPE, const unsigned short* VV, unsigned short* O, lptr L, const int wave_id) {
    int ln_; asm volatile("v_mbcnt_lo_u32_b32 %0, -1, 0\n\tv_mbcnt_hi_u32_b32 %0, -1, %0" : "=v"(ln_)); const int tid_ = wave_id * 64 + ln_;
    const int tid = tid_, lane = tid & 63, r32 = lane & 31, hi = lane >> 5; const int wid = __builtin_amdgcn_readfirstlane(tid >> 6);
    const int q0 = qb * 256, qrow = q0 + wid * 32 + r32;
    bf16x8 qr[6];
#pragma unroll
    for (int s = 0; s < 6; ++s) qr[s] = *(const bf16x8*)(Q + (size_t)qrow * 768 + h * 96 + s * 16 + hi * 8);
    const int NT = 4 * qb + 4;
    const unsigned short* kn_src = KN + (size_t)lane * 512 + h * 64 + wid * 8;
    const unsigned short* kp_src = KPE + (size_t)lane * 32 + (wid & 3) * 8;
    const unsigned short* v_src = VV + (size_t)(16 * (wid & 3) + (lane >> 2)) * 512 + h * 64 + (wid >> 2) * 32 + (lane & 3) * 8;
    const int kn_dst = L_K + wid * 1024 + lane * 16, kp_dst = L_K + (8 + (wid & 3)) * 1024 + lane * 16, v_dst = L_V + wid * 1024 + lane * 16;
    u32x4 rk = *(const u32x4*)kn_src, rp = *(const u32x4*)kp_src, rv = *(const u32x4*)v_src;
    float mrun = -INFINITY, lrun = 0.f; f32x16 o0 = {}, o1 = {};
    __attribute__((address_space(3))) float* wsf = (__attribute__((address_space(3))) float*)(L + L_WS) + wid * 64;
    const int vrd = ((lane >> 4) & 1) * 32 + (lane & 3) * 8 + (4 * hi + ((lane & 15) >> 2)) * 64;
    for (int t = 0; t < NT; ++t) {
        const int kb = (t & 1) * KSLOT, vb = (t & 1) * VSLOT;
        *(__attribute__((address_space(3))) u32x4*)(L + kb + kn_dst) = rk;
        if (wid < 4) *(__attribute__((address_space(3))) u32x4*)(L + kb + kp_dst) = rp;
        *(__attribute__((address_space(3))) u32x4*)(L + vb + v_dst) = rv;
        __syncthreads();
        if (t + 1 < NT) { const size_t adv = (size_t)(t + 1) * 64; rk = *(const u32x4*)(kn_src + adv * 512); rp = *(const u32x4*)(kp_src + adv * 32); rv = *(const u32x4*)(v_src + adv * 512); }
        if (64 * t > q0 + wid * 32 + 31) continue;
        f32x16 p0 = {}, p1 = {};
#pragma unroll
        for (int s = 0; s < 6; ++s) {
            const bf16x8 k0 = *(const __attribute__((address_space(3))) bf16x8*)(L + kb + L_K + (2 * s + hi) * 1024 + r32 * 16);
            const bf16x8 k1 = *(const __attribute__((address_space(3))) bf16x8*)(L + kb + L_K + (2 * s + hi) * 1024 + 512 + r32 * 16);
            p0 = ATT_MFMA(k0, qr[s], p0); p1 = ATT_MFMA(k1, qr[s], p1);
        }
        if (64 * t + 63 > q0 + wid * 32) {
#pragma unroll
            for (int r = 0; r < 16; ++r) { const int kv = 64 * t + crow(r, hi); if (kv > qrow) p0[r] = -INFINITY; if (kv + 32 > qrow) p1[r] = -INFINITY; }
        }
        float rm = fmaxf(p0[0], p1[0]);
#pragma unroll
        for (int r = 1; r < 16; ++r) rm = fmaxf(rm, fmaxf(p0[r], p1[r]));
        rm = xmax32(rm);
        const float mnew = fmaxf(mrun, rm), alpha = __builtin_amdgcn_exp2f(mrun - mnew);
        float rs = 0.f;
#pragma unroll
        for (int r = 0; r < 16; ++r) { p0[r] = __builtin_amdgcn_exp2f(p0[r] - mnew); p1[r] = __builtin_amdgcn_exp2f(p1[r] - mnew); rs += p0[r] + p1[r]; }
        rs = xsum32(rs);
        lrun = lrun * alpha + rs; mrun = mnew;
        if (hi == 0) wsf[r32] = alpha;
        u32x4 pw0, pw1, pw2, pw3;
        pw0 = (u32x4){cvtpk(p0[0], p0[1]), cvtpk(p0[2], p0[3]), cvtpk(p0[4], p0[5]), cvtpk(p0[6], p0[7])};
        pw1 = (u32x4){cvtpk(p0[8], p0[9]), cvtpk(p0[10], p0[11]), cvtpk(p0[12], p0[13]), cvtpk(p0[14], p0[15])};
        pw2 = (u32x4){cvtpk(p1[0], p1[1]), cvtpk(p1[2], p1[3]), cvtpk(p1[4], p1[5]), cvtpk(p1[6], p1[7])};
        pw3 = (u32x4){cvtpk(p1[8], p1[9]), cvtpk(p1[10], p1[11]), cvtpk(p1[12], p1[13]), cvtpk(p1[14], p1[15])};
        __builtin_amdgcn_fence(__ATOMIC_RELEASE, "wavefront"); __builtin_amdgcn_wave_barrier(); __builtin_amdgcn_fence(__ATOMIC_ACQUIRE, "wavefront");
#pragma unroll
        for (int r = 0; r < 16; ++r) { const float a = wsf[crow(r, hi)]; o0[r] *= a; o1[r] *= a; }
        const bf16x8 pa[4] = {__builtin_bit_cast(bf16x8, pw0), __builtin_bit_cast(bf16x8, pw1), __builtin_bit_cast(bf16x8, pw2), __builtin_bit_cast(bf16x8, pw3)};
#pragma unroll
        for (int ks = 0; ks < 4; ++ks) {
#pragma unroll
            for (int d0 = 0; d0 < 2; ++d0) {
                const s16x4 lo = __builtin_bit_cast(s16x4, __builtin_amdgcn_ds_read_tr16_b64_v4i16((__attribute__((address_space(3))) v4i16_t*)(L + vb + L_V + vrd + d0 * 4096 + ks * 1024)));
                const s16x4 hh = __builtin_bit_cast(s16x4, __builtin_amdgcn_ds_read_tr16_b64_v4i16((__attribute__((address_space(3))) v4i16_t*)(L + vb + L_V + vrd + d0 * 4096 + ks * 1024 + 512)));
                const bf16x8 vf = (bf16x8){lo[0], lo[1], lo[2], lo[3], hh[0], hh[1], hh[2], hh[3]};
                if (d0 == 0) o0 = ATT_MFMA(pa[ks], vf, o0); else o1 = ATT_MFMA(pa[ks], vf, o1);
            }
        }
        __builtin_amdgcn_wave_barrier();
    }
    __syncthreads();
    if (hi == 0) wsf[r32] = 1.0f / lrun;
    __builtin_amdgcn_fence(__ATOMIC_RELEASE, "wavefront"); __builtin_amdgcn_wave_barrier(); __builtin_amdgcn_fence(__ATOMIC_ACQUIRE, "wavefront");
    __attribute__((address_space(3))) unsigned short* stg = (__attribute__((address_space(3))) unsigned short*)(L + L_OST) + wid * 2048;
#pragma unroll
    for (int r = 0; r < 16; ++r) { const int orow = crow(r, hi); const float a = wsf[orow];
        stg[orow * 64 + r32] = (unsigned short)(cvtpk(o0[r] * a, 0.f) & 0xffffu); stg[orow * 64 + 32 + r32] = (unsigned short)(cvtpk(o1[r] * a, 0.f) & 0xffffu); }
    __builtin_amdgcn_fence(__ATOMIC_RELEASE, "wavefront"); __builtin_amdgcn_wave_barrier(); __builtin_amdgcn_fence(__ATOMIC_ACQUIRE, "wavefront");
    unsigned short* Ow = O + (size_t)(q0 + wid * 32) * 512 + h * 64;
#pragma unroll
    for (int i = 0; i < 4; ++i) { const int row = i * 8 + (lane >> 3), ch = lane & 7; const u32x4 v = *(const __attribute__((address_space(3))) u32x4*)(stg + row * 64 + ch * 8); *(u32x4*)(Ow + (size_t)row * 512 + ch * 8) = v; }
    __syncthreads();
}
#undef ATT_MFMA
}
namespace attn3 {
using bf16=__hip_bfloat16;
using bf16x8=__attribute__((ext_vector_type(8)))short;
using s16x4=__attribute__((ext_vector_type(4)))short;
using f32x16=__attribute__((ext_vector_type(16)))float;
using u32x4=__attribute__((ext_vector_type(4)))unsigned;
constexpr int NHEAD=8,D=64,DQK=96,PQ=NHEAD*DQK,PK=NHEAD*D,PR=32;
constexpr int NW=8,QBLK=32,QB=QBLK*NW,KVBLK=64;
__device__ __forceinline__ int crow(int r,int hi){return (r&3)+8*(r>>2)+4*hi;}
#define SBAR() __builtin_amdgcn_sched_barrier(0)
__device__ __forceinline__ void cmask(f32x16&p0,f32x16&p1,int jb,int qrel,int hi){
  const float NEG=-INFINITY; int kb=64*jb+4*hi;
  #pragma unroll
  for(int r=0;r<16;++r){int kv=kb+(r&3)+8*(r>>2); if(kv>qrel)p0[r]=NEG; if(kv+32>qrel)p1[r]=NEG;}
}
__device__ __forceinline__ void cmask1(f32x16&p,int jb,int qrel,int hi,int koff){
  const float NEG=-INFINITY; int kb=64*jb+4*hi+koff;
  #pragma unroll
  for(int r=0;r<16;++r){int kv=kb+(r&3)+8*(r>>2); if(kv>qrel)p[r]=NEG;}
}

constexpr int NSLOT=3, SLOTB=8192, KSLOTB=12288;
#define KOFF(x) (((x)*3)>>1)
constexpr int LDS_K=0, LDS_V=NSLOT*KSLOTB, LDS_WS=LDS_V+NSLOT*SLOTB, LDS_OST=LDS_WS+NW*64*4, LDS_BYTES=LDS_OST+NW*4096;
constexpr float C2=0.10206207261596577f*1.4426950408889634f;
__device__ __forceinline__ void glds16(const void*gsrc,unsigned lds_dst){unsigned keep;
  asm volatile("s_mov_b32 %0, m0\n\ts_mov_b32 m0, %2\n\ts_nop 0\n\tglobal_load_lds_dwordx4 %1, off\n\ts_mov_b32 m0, %0":"=&s"(keep):"v"(gsrc),"s"(lds_dst):"memory");}
__device__ __forceinline__ float max3f(float a,float b,float c){float r;asm("v_max3_f32 %0, %1, %2, %3":"=v"(r):"v"(a),"v"(b),"v"(c));return r;}
__device__ __forceinline__ float max2f(float a,float b){float r;asm("v_max_f32_e32 %0, %1, %2":"=v"(r):"v"(a),"v"(b));return r;}
__device__ __forceinline__ float fadd_s(float a,float b){float r;asm("v_add_f32_e32 %0, %1, %2":"=v"(r):"v"(a),"v"(b));return r;}
__device__ __forceinline__ float fsub_s(float a,float b){float r;asm("v_sub_f32_e32 %0, %1, %2":"=v"(r):"v"(a),"v"(b));return r;}
typedef float f32x2_t __attribute__((ext_vector_type(2))); typedef __bf16 bf16x2_t __attribute__((ext_vector_type(2)));
__device__ __forceinline__ unsigned cvtpk_s(float lo,float hi){f32x2_t v={lo,hi};bf16x2_t b=__builtin_convertvector(v,bf16x2_t);return __builtin_bit_cast(unsigned,b);}
#define WAIT_BAR(N) asm volatile("s_waitcnt vmcnt(" #N ") lgkmcnt(0)\n\ts_barrier":::"memory")
#define WB(A,B) do{ if(wid<4){WAIT_BAR(A);}else{WAIT_BAR(B);} }while(0)

__device__ __forceinline__ void qkt(f32x16&p0,f32x16&p1,const char*Kslot,const bf16x8*qr,const f32x16&negm,int r32,int hi){
  const char*kb=Kslot+hi*1024+r32*16;
  #pragma unroll
  for(int d0=0;d0<6;++d0){
    const bf16x8 b0=*reinterpret_cast<const bf16x8*>(kb+d0*2048);
    const bf16x8 b1=*reinterpret_cast<const bf16x8*>(kb+d0*2048+512);
    if(d0==0){p0=__builtin_amdgcn_mfma_f32_32x32x16_bf16(b0,qr[0],negm,0,0,0);p1=__builtin_amdgcn_mfma_f32_32x32x16_bf16(b1,qr[0],negm,0,0,0);}
    else{p0=__builtin_amdgcn_mfma_f32_32x32x16_bf16(b0,qr[d0],p0,0,0,0);p1=__builtin_amdgcn_mfma_f32_32x32x16_bf16(b1,qr[d0],p1,0,0,0);}}
}
typedef __attribute__((address_space(3))) const char* lds_cptr;
typedef short v4i16_t __attribute__((ext_vector_type(4)));
__device__ __forceinline__ void kload8(bf16x8*kf,lds_cptr kp){
  kf[0]=*(const __attribute__((address_space(3))) bf16x8*)(kp);      kf[1]=*(const __attribute__((address_space(3))) bf16x8*)(kp+512);
  kf[2]=*(const __attribute__((address_space(3))) bf16x8*)(kp+2048); kf[3]=*(const __attribute__((address_space(3))) bf16x8*)(kp+2560);
  kf[4]=*(const __attribute__((address_space(3))) bf16x8*)(kp+4096); kf[5]=*(const __attribute__((address_space(3))) bf16x8*)(kp+4608);
  kf[6]=*(const __attribute__((address_space(3))) bf16x8*)(kp+6144); kf[7]=*(const __attribute__((address_space(3))) bf16x8*)(kp+6656);
  kf[8]=*(const __attribute__((address_space(3))) bf16x8*)(kp+8192); kf[9]=*(const __attribute__((address_space(3))) bf16x8*)(kp+8704);
  kf[10]=*(const __attribute__((address_space(3))) bf16x8*)(kp+10240); kf[11]=*(const __attribute__((address_space(3))) bf16x8*)(kp+10752);
}
__device__ __forceinline__ void kload2(bf16x8*kf,lds_cptr kp,int j){ kf[2*j]=*(const __attribute__((address_space(3))) bf16x8*)(kp+j*2048); kf[2*j+1]=*(const __attribute__((address_space(3))) bf16x8*)(kp+j*2048+512); }
__device__ __forceinline__ s16x4 vtr(lds_cptr p){ return __builtin_bit_cast(s16x4,__builtin_amdgcn_ds_read_tr16_b64_v4i16((__attribute__((address_space(3))) v4i16_t*)p)); }
__device__ __forceinline__ float rowmax(const f32x16&p0,const f32x16&p1){
  float a=max3f(p0[0],p0[1],p1[0]),b=max3f(p0[2],p0[3],p1[1]);a=max3f(a,p1[2],p1[3]);
  #pragma unroll
  for(int r=4;r<16;r+=4){a=max3f(a,p0[r],p0[r+1]);b=max3f(b,p0[r+2],p0[r+3]);a=max3f(a,p1[r],p1[r+1]);b=max3f(b,p1[r+2],p1[r+3]);}
  const float m=max2f(a,b);
  return xmax32(m);
}
__device__ __forceinline__ void pv(f32x16*o,int vb,bf16x8 pa0,bf16x8 pa1,bf16x8 pa2,bf16x8 pa3){
  #pragma unroll
  for(int d0=0;d0<2;++d0){s16x4 lo[4],hi[4];
    #pragma unroll
    for(int ks=0;ks<4;++ks){
      asm volatile("ds_read_b64_tr_b16 %0,%1 offset:%c2":"=&v"(lo[ks]):"v"(vb),"i"(d0*4096+ks*1024):"memory");
      asm volatile("ds_read_b64_tr_b16 %0,%1 offset:%c2":"=&v"(hi[ks]):"v"(vb),"i"(d0*4096+ks*1024+512):"memory");}
    asm volatile("s_waitcnt lgkmcnt(0)":::"memory");SBAR();
    #define PK(k) (bf16x8){lo[k][0],lo[k][1],lo[k][2],lo[k][3],hi[k][0],hi[k][1],hi[k][2],hi[k][3]}
    o[d0]=__builtin_amdgcn_mfma_f32_32x32x16_bf16(pa0,PK(0),o[d0],0,0,0);
    o[d0]=__builtin_amdgcn_mfma_f32_32x32x16_bf16(pa1,PK(1),o[d0],0,0,0);
    o[d0]=__builtin_amdgcn_mfma_f32_32x32x16_bf16(pa2,PK(2),o[d0],0,0,0);
    o[d0]=__builtin_amdgcn_mfma_f32_32x32x16_bf16(pa3,PK(3),o[d0],0,0,0);
    #undef PK
  }
}

#ifndef ATTN_STORE16
#define ATTN_STORE16(p,v) (*(u32x4*)(p)=(v))
#endif
template<int THRL,bool FAST> __device__ __forceinline__ void attn_unit(int h,int qb,const bf16*Q,const bf16*__restrict__ K,const bf16*__restrict__ KP,const bf16*__restrict__ V,bf16*O,char*shm,const int wave_id){
  int ln_; asm volatile("v_mbcnt_lo_u32_b32 %0, -1, 0\n\tv_mbcnt_hi_u32_b32 %0, -1, %0" : "=v"(ln_));
  const int lane=ln_,r32=lane&31,hi=lane>>5; const int wid=wave_id;
  const int q0=qb*QB;
  const bf16*Qw=Q+(long)(q0+wid*QBLK)*PQ+h*DQK;
  const bf16*Kh=K+h*D,*Vh=V+h*D;
  const unsigned lds0=(unsigned)(uintptr_t)shm;
  float*wsf=(float*)(shm+LDS_WS)+wid*64;
  const bf16*ksrc=Kh+(long)lane*PK+wid*8; const bf16*kpsrc=KP+(long)lane*PR+(wid&3)*8;
  const bf16*vsrc=Vh+(long)(16*(wid&3)+(lane>>2))*PK+(wid>>2)*32+(lane&3)*8;
  const unsigned kdst=lds0+LDS_K+wid*1024, kpdst=lds0+LDS_K+(8+(wid&3))*1024, vdst=lds0+LDS_V+wid*1024;
  #define DMA_K(t,slot) do{ glds16(ksrc+(long)(t)*KVBLK*PK,(unsigned)__builtin_amdgcn_readfirstlane(kdst+KOFF(slot))); if(wid<4) glds16(kpsrc+(long)(t)*KVBLK*PR,(unsigned)__builtin_amdgcn_readfirstlane(kpdst+KOFF(slot))); }while(0)
  #define DMA_V(t,slot) glds16(vsrc+(long)(t)*KVBLK*PK,(unsigned)__builtin_amdgcn_readfirstlane(vdst+(slot)))
  const int vb0=(int)(lds0+LDS_V)+((lane>>4)&1)*32+(lane&3)*8+(4*hi+((lane&15)>>2))*64;
  const char*Kbase=shm+LDS_K; bf16x8 kf[12];
  const lds_cptr shm3=(lds_cptr)shm; const lds_cptr kp0=shm3+LDS_K+hi*1024+r32*16; const lds_cptr vp0=shm3+LDS_V+((lane>>4)&1)*32+(lane&3)*8+(4*hi+((lane&15)>>2))*64;
  const int NT=(q0+QB)/KVBLK;
  DMA_K(0,0);DMA_V(0,0);DMA_K(1,SLOTB);
  bf16x8 qr[6];
  #pragma unroll
  for(int d0=0;d0<6;++d0)qr[d0]=*reinterpret_cast<const bf16x8*>(&Qw[(long)r32*PQ+d0*16+hi*8]);
  float mhat=0.f,l_reg=0.f;f32x16 o[2];o[0]=f32x16{};o[1]=f32x16{};const f32x16 negm=f32x16{};
  const int qrel=wid*QBLK+r32;
  #define CMASK(P0,P1,t) do{int jb_=(t)-(NT-4); if(jb_>=0)cmask(P0,P1,jb_,qrel,hi);}while(0)
  #define CMASKH(P,t,ko) do{int jb_=(t)-(NT-4); if(jb_>=0)cmask1(P,jb_,qrel,hi,ko);}while(0)
  bool resc=false;
  #define START(P0,P1) do{ resc=false; if(!FAST){ const float rm=rowmax(P0,P1); \
    { const float dl=rm; mhat=fadd_s(mhat,dl); \
      _Pragma("unroll") for(int r=0;r<16;++r){P0[r]=fsub_s(P0[r],dl);P1[r]=fsub_s(P1[r],dl);} \
      } } \
    _Pragma("unroll") for(int r=0;r<16;++r)P0[r]=__builtin_amdgcn_exp2f(P0[r]); }while(0)
  #define RESC() do{ if(!FAST&&resc){ asm volatile("s_waitcnt lgkmcnt(0)":::"memory"); \
      _Pragma("unroll") for(int d_=0;d_<2;++d_) _Pragma("unroll") for(int r=0;r<16;++r)o[d_][r]*=wsf[crow(r,hi)]; } }while(0)
  f32x16 pA0,pA1,pB0,pB1;
  int sl_prev=0,sl_cur=0,sl_next=SLOTB;
  #define ROT() do{sl_prev=sl_cur;sl_cur=sl_next;sl_next=(sl_next==(NSLOT-1)*SLOTB)?0:sl_next+SLOTB;}while(0)
  DMA_K(2,2*SLOTB);
  WB(5,3);
  qkt(pA0,pA1,Kbase,qr,negm,r32,hi);asm volatile("s_nop 15\n\ts_nop 7":"+v"(pA0),"+v"(pA1));CMASK(pA0,pA1,0);
  START(pA0,pA1);
  _Pragma("unroll") for(int r=0;r<16;++r)pA1[r]=__builtin_amdgcn_exp2f(pA1[r]);
  WAIT_BAR(0);
  DMA_K(3,0);DMA_V(1,SLOTB);
  ROT();
  kload8(kf,kp0+KOFF(sl_cur));
  WB(3,2);
  s16x4 vlo[2],vhi[2]; u32x4 pw0,pw1,pw2,pw3;
  #define PKW(P,B) cvtpk_s(P[B],P[B+1])
  #define PAF(k) __builtin_bit_cast(bf16x8,pw##k)
  #define VFR(i) (bf16x8){vlo[(i)&1][0],vlo[(i)&1][1],vlo[(i)&1][2],vlo[(i)&1][3],vhi[(i)&1][0],vhi[(i)&1][1],vhi[(i)&1][2],vhi[(i)&1][3]}
  #define PIN(x) asm volatile("":"+v"(x))
  #define MX3(a,b,c) __builtin_fmaxf(__builtin_fmaxf((a),(b)),(c))
  #define GAPA(MF,A0,A1,A2,A3,W0,W1,PW) do{ MF; sacc+=A0; sacc+=A1; sacc+=A2; sacc+=A3; PIN(sacc); W0; W1; PIN(PW); SBAR(); }while(0)
  #define EX(v) __builtin_amdgcn_exp2f(v)
  #define GAPB(MF,X,B) do{ MF; X[B]=EX(X[B]); X[B+1]=EX(X[B+1]); X[B+2]=EX(X[B+2]); X[B+3]=EX(X[B+3]); PIN(X); SBAR(); }while(0)
  #define VRD(i) do{}while(0)
  #define VFS(sl) (bf16x8){vlo[sl][0],vlo[sl][1],vlo[sl][2],vlo[sl][3],vhi[sl][0],vhi[sl][1],vhi[sl][2],vhi[sl][3]}
  #define VRDS(sl,i) do{ vlo[sl]=vtr(vp_+(((i)>>2)*4096+((i)&3)*1024)); vhi[sl]=vtr(vp_+(((i)>>2)*4096+((i)&3)*1024+512)); SBAR(); }while(0)
  #define KRD(G,j) do{ if(G){ kload2(kf,kp0+KOFF(sl_next),j); SBAR(); } }while(0)
  #define STEP(C0,C1,P0,P1,t,GK,GV,GL) do{ SBAR(); \
    const lds_cptr vp_=vp0+sl_prev; \
    VRD(0); SBAR(); float sacc=(P0[0]+P0[1]); \
    GAPA(C0=__builtin_amdgcn_mfma_f32_32x32x16_bf16(kf[0],qr[0],negm,0,0,0), P0[2],P0[3],P0[4],P0[5],     pw0[0]=PKW(P0,0), pw0[1]=PKW(P0,2), pw0); \
    VRD(4); SBAR(); GAPA(C1=__builtin_amdgcn_mfma_f32_32x32x16_bf16(kf[1],qr[0],negm,0,0,0), P0[6],P0[7],P0[8],P0[9],     pw0[2]=PKW(P0,4), pw0[3]=PKW(P0,6), pw0); \
    VRD(1); SBAR(); GAPA(C0=__builtin_amdgcn_mfma_f32_32x32x16_bf16(kf[2],qr[1],C0,0,0,0),   P0[10],P0[11],P0[12],P0[13], pw1[0]=PKW(P0,8), pw1[1]=PKW(P0,10), pw1); \
    VRD(5); SBAR(); GAPA(C1=__builtin_amdgcn_mfma_f32_32x32x16_bf16(kf[3],qr[1],C1,0,0,0),   P0[14],P0[15],P1[0],P1[1],   pw1[2]=PKW(P0,12),pw1[3]=PKW(P0,14), pw1); \
    VRD(2); SBAR(); GAPA(C0=__builtin_amdgcn_mfma_f32_32x32x16_bf16(kf[4],qr[2],C0,0,0,0),   P1[2],P1[3],P1[4],P1[5],     pw2[0]=PKW(P1,0), pw2[1]=PKW(P1,2), pw2); \
    VRD(6); SBAR(); GAPA(C1=__builtin_amdgcn_mfma_f32_32x32x16_bf16(kf[5],qr[2],C1,0,0,0),   P1[6],P1[7],P1[8],P1[9],     pw2[2]=PKW(P1,4), pw2[3]=PKW(P1,6), pw2); \
    VRD(3); SBAR(); GAPA(C0=__builtin_amdgcn_mfma_f32_32x32x16_bf16(kf[6],qr[3],C0,0,0,0),   P1[10],P1[11],P1[12],P1[13], pw3[0]=PKW(P1,8), pw3[1]=PKW(P1,10), pw3); \
    VRD(7); SBAR(); GAPA(C1=__builtin_amdgcn_mfma_f32_32x32x16_bf16(kf[7],qr[3],C1,0,0,0),   P1[14],P1[15],0.f,0.f,       pw3[2]=PKW(P1,12),pw3[3]=PKW(P1,14), pw3); \
    C0=__builtin_amdgcn_mfma_f32_32x32x16_bf16(kf[8],qr[4],C0,0,0,0); SBAR(); C1=__builtin_amdgcn_mfma_f32_32x32x16_bf16(kf[9],qr[4],C1,0,0,0); SBAR(); \
    C0=__builtin_amdgcn_mfma_f32_32x32x16_bf16(kf[10],qr[5],C0,0,0,0); SBAR(); C1=__builtin_amdgcn_mfma_f32_32x32x16_bf16(kf[11],qr[5],C1,0,0,0); SBAR(); \
    l_reg+=sacc; \
    if(GK){DMA_K((t)+3,sl_cur);} if(GV){DMA_V((t)+1,sl_next);} \
    if(!FAST){ _Pragma("unroll") for(int r=0;r<16;++r){C0[r]-=mhat;C1[r]-=mhat;} } \
    CMASK(C0,C1,t); \
    if(!FAST){ float a=MX3(C0[0],C0[1],C1[0]),b=MX3(C0[2],C0[3],C1[1]); a=MX3(a,C1[2],C1[3]); \
      _Pragma("unroll") for(int r=4;r<16;r+=4){a=MX3(a,C0[r],C0[r+1]);b=MX3(b,C0[r+2],C0[r+3]);a=MX3(a,C1[r],C1[r+1]);b=MX3(b,C1[r+2],C1[r+3]);} \
      float rm=xmax32(__builtin_fmaxf(a,b)); \
      resc=false; \
      if(__builtin_expect(__any(rm>(float)THRL),0)){ const float dl=__builtin_fmaxf(rm,0.f); mhat+=dl; \
        _Pragma("unroll") for(int r=0;r<16;++r){C0[r]-=dl;C1[r]-=dl;} \
        const float f=__builtin_amdgcn_exp2f(-dl); l_reg*=f; if(hi==0)wsf[r32]=f; resc=true; } } \
    SBAR(); \
    VRDS(0,0); \
    VRDS(1,4); KRD(GL,4); GAPB(o[0]=__builtin_amdgcn_mfma_f32_32x32x16_bf16(PAF(0),VFS(0),o[0],0,0,0), C0,0); \
    VRDS(0,1); KRD(GL,5); GAPB(o[1]=__builtin_amdgcn_mfma_f32_32x32x16_bf16(PAF(0),VFS(1),o[1],0,0,0), C0,4); \
    VRDS(1,5); KRD(GL,0); GAPB(o[0]=__builtin_amdgcn_mfma_f32_32x32x16_bf16(PAF(1),VFS(0),o[0],0,0,0), C0,8); \
    VRDS(0,2); KRD(GL,1); GAPB(o[1]=__builtin_amdgcn_mfma_f32_32x32x16_bf16(PAF(1),VFS(1),o[1],0,0,0), C0,12); \
    VRDS(1,6); KRD(GL,2); GAPB(o[0]=__builtin_amdgcn_mfma_f32_32x32x16_bf16(PAF(2),VFS(0),o[0],0,0,0), C1,0); \
    VRDS(0,3); KRD(GL,3); GAPB(o[1]=__builtin_amdgcn_mfma_f32_32x32x16_bf16(PAF(2),VFS(1),o[1],0,0,0), C1,4); \
    VRDS(1,7); GAPB(o[0]=__builtin_amdgcn_mfma_f32_32x32x16_bf16(PAF(3),VFS(0),o[0],0,0,0), C1,8); \
    GAPB(o[1]=__builtin_amdgcn_mfma_f32_32x32x16_bf16(PAF(3),VFS(1),o[1],0,0,0), C1,12); \
    }while(0)
  #define GAPB2(MF,X,B) do{ MF; X[B]=EX(X[B]); X[B+1]=EX(X[B+1]); PIN(X); SBAR(); }while(0)
  #define STEPF(C0,C1,P0,P1,t,GK,GV,GL) do{ SBAR(); \
    const lds_cptr vp_=vp0+sl_prev; \
    float sacc=(P0[0]+P0[1]); \
    GAPA(C0=__builtin_amdgcn_mfma_f32_32x32x16_bf16(kf[0],qr[0],negm,0,0,0),  P0[2],P0[3],P0[4],P0[5],     pw0[0]=PKW(P0,0), pw0[1]=PKW(P0,2), pw0); \
    GAPA(C0=__builtin_amdgcn_mfma_f32_32x32x16_bf16(kf[2],qr[1],C0,0,0,0),    P0[6],P0[7],P0[8],P0[9],     pw0[2]=PKW(P0,4), pw0[3]=PKW(P0,6), pw0); \
    GAPA(C0=__builtin_amdgcn_mfma_f32_32x32x16_bf16(kf[4],qr[2],C0,0,0,0),    P0[10],P0[11],P0[12],P0[13], pw1[0]=PKW(P0,8), pw1[1]=PKW(P0,10), pw1); \
    GAPA(C0=__builtin_amdgcn_mfma_f32_32x32x16_bf16(kf[6],qr[3],C0,0,0,0),    P0[14],P0[15],P1[0],P1[1],   pw1[2]=PKW(P0,12),pw1[3]=PKW(P0,14), pw1); \
    GAPA(C0=__builtin_amdgcn_mfma_f32_32x32x16_bf16(kf[8],qr[4],C0,0,0,0),    P1[2],P1[3],P1[4],P1[5],     pw2[0]=PKW(P1,0), pw2[1]=PKW(P1,2), pw2); \
    GAPA(C0=__builtin_amdgcn_mfma_f32_32x32x16_bf16(kf[10],qr[5],C0,0,0,0),   P1[6],P1[7],P1[8],P1[9],     pw2[2]=PKW(P1,4), pw2[3]=PKW(P1,6), pw2); \
    GAPA(C1=__builtin_amdgcn_mfma_f32_32x32x16_bf16(kf[1],qr[0],negm,0,0,0),  P1[10],P1[11],P1[12],P1[13], pw3[0]=PKW(P1,8), pw3[1]=PKW(P1,10), pw3); \
    GAPA(C1=__builtin_amdgcn_mfma_f32_32x32x16_bf16(kf[3],qr[1],C1,0,0,0),    P1[14],P1[15],0.f,0.f,       pw3[2]=PKW(P1,12),pw3[3]=PKW(P1,14), pw3); \
    l_reg+=sacc; \
    CMASKH(C0,t,0); \
    GAPB(C1=__builtin_amdgcn_mfma_f32_32x32x16_bf16(kf[5],qr[2],C1,0,0,0), C0,0); \
    GAPB(C1=__builtin_amdgcn_mfma_f32_32x32x16_bf16(kf[7],qr[3],C1,0,0,0), C0,4); \
    GAPB(C1=__builtin_amdgcn_mfma_f32_32x32x16_bf16(kf[9],qr[4],C1,0,0,0), C0,8); \
    GAPB(C1=__builtin_amdgcn_mfma_f32_32x32x16_bf16(kf[11],qr[5],C1,0,0,0), C0,12); \
    if(GK){DMA_K((t)+3,sl_cur);} if(GV){DMA_V((t)+1,sl_next);} \
    CMASKH(C1,t,32); \
    SBAR(); \
    VRDS(0,0); \
    VRDS(1,4); KRD(GL,4); GAPB2(o[0]=__builtin_amdgcn_mfma_f32_32x32x16_bf16(PAF(0),VFS(0),o[0],0,0,0), C1,0); \
    VRDS(0,1); KRD(GL,5); GAPB2(o[1]=__builtin_amdgcn_mfma_f32_32x32x16_bf16(PAF(0),VFS(1),o[1],0,0,0), C1,2); \
    VRDS(1,5); KRD(GL,0); GAPB2(o[0]=__builtin_amdgcn_mfma_f32_32x32x16_bf16(PAF(1),VFS(0),o[0],0,0,0), C1,4); \
    VRDS(0,2); KRD(GL,1); GAPB2(o[1]=__builtin_amdgcn_mfma_f32_32x32x16_bf16(PAF(1),VFS(1),o[1],0,0,0), C1,6); \
    VRDS(1,6); KRD(GL,2); GAPB2(o[0]=__builtin_amdgcn_mfma_f32_32x32x16_bf16(PAF(2),VFS(0),o[0],0,0,0), C1,8); \
    VRDS(0,3); KRD(GL,3); GAPB2(o[1]=__builtin_amdgcn_mfma_f32_32x32x16_bf16(PAF(2),VFS(1),o[1],0,0,0), C1,10); \
    VRDS(1,7); GAPB2(o[0]=__builtin_amdgcn_mfma_f32_32x32x16_bf16(PAF(3),VFS(0),o[0],0,0,0), C1,12); \
    GAPB2(o[1]=__builtin_amdgcn_mfma_f32_32x32x16_bf16(PAF(3),VFS(1),o[1],0,0,0), C1,14); \
    }while(0)
  #define STEPX(C0,C1,P0,P1,t,GK,GV,GL) do{ if(FAST) STEPF(C0,C1,P0,P1,t,GK,GV,GL); else STEP(C0,C1,P0,P1,t,GK,GV,GL); }while(0)
  int t=1;
  #undef CMASK
  #undef CMASKH
  #define CMASK(P0,P1,t) do{}while(0)
  #define CMASKH(P,t,ko) do{}while(0)
  for(;t+5<NT;t+=2){
    STEPX(pB0,pB1,pA0,pA1,t,true,true,true);     WB(3,2); RESC(); ROT();
    STEPX(pA0,pA1,pB0,pB1,t+1,true,true,true);   WB(3,2); RESC(); ROT();
  }
  #undef CMASK
  #undef CMASKH
  #define CMASK(P0,P1,t) do{int jb_=(t)-(NT-4); if(jb_>=0)cmask(P0,P1,jb_,qrel,hi);}while(0)
  #define CMASKH(P,t,ko) do{int jb_=(t)-(NT-4); if(jb_>=0)cmask1(P,jb_,qrel,hi,ko);}while(0)
  #define ENDW(tt) do{ if((tt)+3<NT){WB(3,2);} else if((tt)+2<NT){WAIT_BAR(1);} else {WAIT_BAR(0);} }while(0)
  for(;t+1<NT;t+=2){
    STEPX(pB0,pB1,pA0,pA1,t,(t+3<NT),(t+1<NT),(t+1<NT));       ENDW(t);   RESC(); ROT();
    STEPX(pA0,pA1,pB0,pB1,t+1,(t+4<NT),(t+2<NT),(t+2<NT));     ENDW(t+1); RESC(); ROT();
  }
  STEPX(pB0,pB1,pA0,pA1,NT-1,false,false,false); RESC();
  { float sacc=pB0[0]+pB0[1]; _Pragma("unroll") for(int r=2;r<16;++r)sacc+=pB0[r]; _Pragma("unroll") for(int r=0;r<16;++r)sacc+=pB1[r]; l_reg+=sacc;
    pw0=(u32x4){PKW(pB0,0),PKW(pB0,2),PKW(pB0,4),PKW(pB0,6)};pw1=(u32x4){PKW(pB0,8),PKW(pB0,10),PKW(pB0,12),PKW(pB0,14)};pw2=(u32x4){PKW(pB1,0),PKW(pB1,2),PKW(pB1,4),PKW(pB1,6)};pw3=(u32x4){PKW(pB1,8),PKW(pB1,10),PKW(pB1,12),PKW(pB1,14)};
    SBAR(); pv(o,vb0+sl_cur,PAF(0),PAF(1),PAF(2),PAF(3)); }
  #undef PKW
  #undef PAF
  #undef VFR
  #undef PIN
  #undef MX3
  #undef GAPA
  #undef GAPB
  #undef EX
  #undef VRD
  #undef VRDS
  #undef VFS
  #undef KRD
  #undef STEP
  #undef STEPF
  #undef STEPX
  #undef GAPB2
  #undef ENDW
  l_reg=xsum32(l_reg);
  if(hi==0)wsf[32+r32]=l_reg;asm volatile("s_waitcnt lgkmcnt(0)":::"memory");
  float rli[16];
  #pragma unroll
  for(int r=0;r<16;++r)rli[r]=__builtin_amdgcn_rcpf(wsf[32+crow(r,hi)]);
  bf16*Ow=O+(long)(q0+wid*QBLK)*PK+h*D;
  { bf16*stg=(bf16*)(shm+LDS_OST)+wid*2048;
    #pragma unroll
    for(int r=0;r<16;++r){const int orow=crow(r,hi);
      #pragma unroll
      for(int d0=0;d0<2;++d0)stg[orow*64+d0*32+r32]=__float2bfloat16(o[d0][r]*rli[r]);}
    asm volatile("s_waitcnt lgkmcnt(0)":::"memory");
    #pragma unroll
    for(int i=0;i<4;++i){const int row=i*8+(lane>>3),ch=lane&7; const u32x4 v=*(const u32x4*)(stg+row*64+ch*8); ATTN_STORE16(Ow+(long)row*PK+ch*8,v);} }
  asm volatile("s_waitcnt lgkmcnt(0)\n\ts_barrier":::"memory");
  #undef DMA_K
  #undef DMA_V
  #undef CMASK
  #undef CMASKH
  #undef START
  #undef RESC
  #undef ROT
}
__device__ __forceinline__ float qnorm2_max(int h,int qb,const bf16*Q,const int wave_id){
  int ln_; asm volatile("v_mbcnt_lo_u32_b32 %0, -1, 0\n\tv_mbcnt_hi_u32_b32 %0, -1, %0" : "=v"(ln_));
  const int r32=ln_&31,hi=ln_>>5; const unsigned*qp=reinterpret_cast<const unsigned*>(Q+(long)(qb*QB+wave_id*QBLK+r32)*PQ+h*DQK+hi*8);
  float s=0.f;
  #pragma unroll
  for(int d0=0;d0<6;++d0){ const u32x4 w=*reinterpret_cast<const u32x4*>(qp+d0*8);
    #pragma unroll
    for(int j=0;j<4;++j){ const float a=__builtin_bit_cast(float,w[j]<<16),b=__builtin_bit_cast(float,w[j]&0xffff0000u); s+=a*a; s+=b*b; } }
  return wave_max_nn(xsum32(s)); }
constexpr int ATTN_LDS_BYTES=LDS_BYTES;
#undef SBAR
#undef WB
#undef WAIT_BAR
#undef KOFF
}
#define GAS __attribute__((address_space(1)))
#define LAS __attribute__((address_space(3)))
typedef unsigned short bf16;
typedef unsigned v4u __attribute__((ext_vector_type(4)));
typedef float f32x4 __attribute__((ext_vector_type(4)));
typedef short bf16x8 __attribute__((ext_vector_type(8)));
typedef GAS unsigned gu32;
typedef GAS unsigned long long gu64;
#define RLX_AGENT __ATOMIC_RELAXED, __HIP_MEMORY_SCOPE_AGENT
#define LDS_WAIT() asm volatile("s_waitcnt lgkmcnt(0)" ::: "memory")
#define VM_WAIT() asm volatile("s_waitcnt vmcnt(0)" ::: "memory")
__device__ __forceinline__ unsigned long long rt() { return __builtin_amdgcn_s_memrealtime(); }
__device__ __forceinline__ unsigned f2bf(float f) { unsigned u = __builtin_bit_cast(unsigned, f); return (u + 0x7fffu + ((u >> 16) & 1u)) >> 16; }
__device__ __forceinline__ unsigned pk2(float lo, float hi) { return f2bf(lo) | (f2bf(hi) << 16); }

#define XB_TMO      128
#define XB_XCNT(j)  (256  + 64 * (j))
#define XB_XSUB(j)  (1280 + 64 * (j))
#define XB_XGEN(j)  (2304 + 64 * (j))
#define XB_TOP      3328
#define XB_TOPGEN   3392
#define XCD_BAR_WORDS 3456
#define XB_SPIN_CAP (1u << 18)

__device__ __forceinline__ unsigned xb_ld(unsigned* p)              { return __hip_atomic_load(p, __ATOMIC_RELAXED, __HIP_MEMORY_SCOPE_AGENT); }
__device__ __forceinline__ unsigned xb_add(unsigned* p, unsigned v) { return __hip_atomic_fetch_add(p, v, __ATOMIC_RELAXED, __HIP_MEMORY_SCOPE_AGENT); }
__device__ __forceinline__ unsigned xb_xcc_id() { return (unsigned)__builtin_amdgcn_s_getreg((3 << 11) | 20) & 0xFu; }
#define XB_SPIN(cond, bar) do { unsigned _sp = 0; while (cond) { __builtin_amdgcn_s_sleep(1); \
    if ((++_sp & 255u) == 0u) { if (xb_ld(&(bar)[XB_TMO])) break; if (_sp > XB_SPIN_CAP) { atomicAdd(&(bar)[XB_TMO], 1u); break; } } } } while (0)

struct XcdBarrier {
    unsigned* bar; unsigned x;
    volatile LAS unsigned* st;
};

__device__ __forceinline__ XcdBarrier xcd_barrier_post(unsigned* bar, volatile LAS unsigned* st) {
    XcdBarrier b; b.bar = bar; b.x = xb_xcc_id(); b.st = st;
    if (threadIdx.x == 0) (void)xb_add(&bar[XB_XCNT(b.x)], 1u);
    return b;
}
__device__ __forceinline__ void xcd_barrier_complete(unsigned* bar, unsigned x, unsigned& nloc, unsigned& nx) {
    const unsigned G = gridDim.x * gridDim.y * gridDim.z;
    unsigned sum, cnt, mine, sp = 0u;
    for (;;) {
        sum = 0u; cnt = 0u; mine = 0u;
#pragma unroll
        for (unsigned j = 0; j < 16; ++j) { const unsigned c = xb_ld(&bar[XB_XCNT(j)]); sum += c; cnt += (c > 0u) ? 1u : 0u; mine = (j == x) ? c : mine; }
        if (sum == G) break;
        __builtin_amdgcn_s_sleep(1);
        if ((++sp & 255u) == 0u) { if (xb_ld(&bar[XB_TMO])) break; if (sp > XB_SPIN_CAP) { atomicAdd(&bar[XB_TMO], 1u); break; } }
    }
    nloc = mine > 0u ? mine : 1u; nx = cnt > 0u ? cnt : 1u;
}

__device__ __forceinline__ void xcd_barrier(const XcdBarrier& b, const bool leader  ) {
    asm volatile("s_waitcnt vmcnt(0)" ::: "memory");
    __syncthreads();
    if (leader) {
        unsigned* bar = b.bar;
        __builtin_amdgcn_s_waitcnt(0);
        unsigned nloc = b.st[0], nx = b.st[1];
        if (nloc == 0u) { xcd_barrier_complete(bar, b.x, nloc, nx); b.st[0] = nloc; b.st[1] = nx; }
        const unsigned old = xb_add(&bar[XB_XSUB(b.x)], 1u);
        const unsigned gen = old / nloc;
        if (old + 1u == (gen + 1u) * nloc) {
            __builtin_amdgcn_fence(__ATOMIC_RELEASE, "agent");
            asm volatile("s_waitcnt vmcnt(0)" ::: "memory");
            const unsigned og = xb_add(&bar[XB_TOP], 1u);
            const unsigned tg = og / nx;
            if (og + 1u == (tg + 1u) * nx) xb_add(&bar[XB_TOPGEN], 1u);
            else XB_SPIN(xb_ld(&bar[XB_TOPGEN]) == tg, bar);
            __builtin_amdgcn_fence(__ATOMIC_ACQUIRE, "agent");
            xb_add(&bar[XB_XGEN(b.x)], 1u);
            asm volatile("s_waitcnt vmcnt(0)" ::: "memory");
        } else {
            XB_SPIN(xb_ld(&bar[XB_XGEN(b.x)]) == gen, bar);
            __builtin_amdgcn_fence(__ATOMIC_ACQUIRE, "agent");
            asm volatile("s_waitcnt vmcnt(0)" ::: "memory");
        }
    }
    __syncthreads();
}
constexpr int NWAVES = 8;
constexpr int M = 16384, D = 1024, NL = 2;
constexpr int GW = 512, CHUNK = 128, NGRP = 8;
constexpr int NH = 8, DQK = 96, DNOPE = 64, DROPE = 32, DV = 64, QLORA = 384, KVLORA = 256;
constexpr int IN_TOTAL = 3744, NPROJ = 3840;
constexpr int FF = 2752, FFP = 2816;
#ifndef ACT_LD_DEF
#define ACT_LD_DEF 2816
#endif
constexpr int ACT_LD = ACT_LD_DEF;
constexpr int NE = 8, EFF = 3584;
constexpr float EPS = 1e-6f;
constexpr int PC_U = 0, PC_V = 512, PC_GA = 1024, PC_GB = 2048, PC_CKV = 3072, PC_CQ = 3328, PC_KR = 3712;
constexpr int MOE_ROWS = 2 * M + NE * 256;
constexpr int MOE_PANELS = MOE_ROWS / 256, MOE_PASS_PANELS = 64, MOE_PASS_MAX = MOE_PANELS - MOE_PASS_PANELS;

constexpr size_t MiB = 1u << 20;
constexpr size_t WS_CTL = 0, CTL_ZERO_BYTES = 64 * 1024;
constexpr size_t WS_STATS = 1 * MiB;
constexpr size_t WS_MOD = 2 * MiB;
constexpr size_t WS_KMAXS = 2 * MiB + 512 * 1024;
constexpr size_t WS_SA = 2 * MiB + 640 * 1024;
constexpr size_t WS_AMAX = 2 * MiB + 896 * 1024;
constexpr size_t WS_COS = 3 * MiB, WS_SIN = 4 * MiB;
constexpr size_t WS_TOPI = 5 * MiB, WS_TOPG = 5 * MiB + 128 * 1024, WS_LIST = 5 * MiB + 256 * 1024;
constexpr size_t WS_LSA = 6 * MiB;
constexpr size_t WS_LHS = 6 * MiB + 512 * 1024;
constexpr size_t WS_ROWDEST = 6 * MiB + 512 * 1024, WS_ROWGATE = 6 * MiB + 768 * 1024;
constexpr size_t WS_WST = 7 * MiB;
constexpr size_t WS_WIN = 8 * MiB, WS_WUQ = 23 * MiB, WS_WUKV = 25 * MiB, WS_WA = 26 * MiB, WS_WB = 28 * MiB, WS_WO = 30 * MiB;
constexpr size_t WS_WGU = 34 * MiB, WS_WD = 45 * MiB, WS_W13 = 51 * MiB, WS_W2 = 163 * MiB;
constexpr size_t WS_SP = 8 * MiB;
constexpr size_t WS_H = 220 * MiB;
constexpr size_t WS_PROJ = 252 * MiB;
constexpr size_t WS_Q = 372 * MiB, WS_KN = 396 * MiB, WS_VV = 412 * MiB, WS_KPE = 428 * MiB, WS_GM = 429 * MiB, WS_ATT = 445 * MiB, WS_Y = 461 * MiB;
constexpr size_t WS_ACT = WS_PROJ;
constexpr size_t WS_ACTM = 252 * MiB, WS_Y2 = WS_W13;
constexpr size_t WS_XB = 493 * MiB;
constexpr size_t WS_PST = 525 * MiB;
constexpr size_t WS_END = 529 * MiB;
static_assert(WS_ACTM + (size_t)MOE_ROWS * EFF * 2 <= WS_XB && WS_Y + (size_t)M * D * 2 <= WS_XB && WS_XB + (size_t)M * D * 2 <= WS_PST && WS_PST + 4 * MiB <= WS_END && (size_t)M * 2 * D * 2 <= (size_t)NE * 2 * EFF * D * 2, "moe map");
static_assert(WS_W13 + (size_t)NE * 2 * EFF * D * 2 <= WS_W2 && WS_W2 + (size_t)NE * D * EFF * 2 <= WS_H, "weights map");
constexpr int CW_TMO = 0, CW_CODE = 1;
constexpr int CW_BAR = 4096;
constexpr int CW_XRANK = 12288;
constexpr int CW_KMAX = 1024;
constexpr int CW_MOE = 8192;
constexpr int CW_DIAG = 16384;
constexpr int RING_OFF = 0, RING_BYTES = 131072;
constexpr int LDSCTL_OFF = RING_BYTES, MISC_OFF = LDSCTL_OFF + 320;
constexpr int LDS_BYTES = 147456;
struct Args { const void* in[29]; float* out; unsigned char* ws; int ph_lo, ph_hi; };
__device__ __forceinline__ float sum4f(const f32x4& v) { return (v[0] + v[1]) + (v[2] + v[3]); }
__device__ __forceinline__ int fresh_lane() { int ln_; asm volatile("v_mbcnt_lo_u32_b32 %0, -1, 0\n\tv_mbcnt_hi_u32_b32 %0, -1, %0" : "=v"(ln_)); return ln_; }
__device__ __forceinline__ const float* inptr(const LAS unsigned long long* ptab, int i) { const unsigned long long v = ptab[i]; const unsigned lo = __builtin_amdgcn_readfirstlane((unsigned)v), hi = __builtin_amdgcn_readfirstlane((unsigned)(v >> 32)); const GAS float* gp = (const GAS float*)(((unsigned long long)hi << 32) | lo); return (const float*)gp; }
struct Ctx { LAS unsigned char* lds; gu32* ctl; unsigned char* ws; int tid, lane, wave, vcu, G, gw, NGW; };
__device__ __forceinline__ float wave_sum(float v) {
    float s = v + dpp_f(v, 0x111, 0xf, 0xf); s += dpp_f(v, 0x112, 0xf, 0xf); s += dpp_f(v, 0x113, 0xf, 0xf);
    s += dpp_f(s, 0x114, 0xf, 0xe); s += dpp_f(s, 0x118, 0xf, 0xc); s += dpp_f(s, 0x142, 0xa, 0xf); s += dpp_f(s, 0x143, 0xc, 0xf);
    return __builtin_bit_cast(float, __builtin_amdgcn_readlane(__builtin_bit_cast(int, s), 63)); }
__device__ __forceinline__ float siluf_(float x) { return x / (1.0f + __expf(-x)); }
template <class Map>
__device__ __forceinline__ void p0_item(const Map& mp, int Ksrc, const float* gain, bf16* WT, int ldt, int nblk, LAS float* scr, int item, int lane) {
    const int kb = item / nblk, nb = item % nblk, k0 = 64 * kb, n0 = 32 * nb;
    const float* src; int ldw; const int sc = mp(n0 + (lane & 31), src, ldw);
    float vv[32];
#pragma unroll
    for (int i = 0; i < 32; ++i) { const int k = k0 + 2 * i + (lane >> 5); vv[i] = (sc >= 0 && k < Ksrc) ? src[(size_t)k * ldw + sc] : 0.f; }
    if (gain) {
#pragma unroll
        for (int i = 0; i < 32; ++i) { const int k = k0 + 2 * i + (lane >> 5); vv[i] *= (k < Ksrc) ? gain[k] : 0.f; } }
#pragma unroll
    for (int i = 0; i < 32; ++i) scr[(2 * i + (lane >> 5)) * 33 + (lane & 31)] = vv[i];
    LDS_WAIT(); asm volatile("" ::: "memory");
    const int c = lane & 7;
#pragma unroll
    for (int j = 0; j < 4; ++j) { const int n = (lane >> 3) + 8 * j; const LAS float* s = scr + (8 * c) * 33 + n;
        v4u o; o.x = pk2(s[0 * 33], s[1 * 33]); o.y = pk2(s[2 * 33], s[3 * 33]); o.z = pk2(s[4 * 33], s[5 * 33]); o.w = pk2(s[6 * 33], s[7 * 33]);
        *(GAS v4u*)(WT + (size_t)(n0 + n) * ldt + k0 + 8 * c) = o; }
    LDS_WAIT(); asm volatile("" ::: "memory");
}
template <class Map>
__device__ __forceinline__ void p0_item8(const Map& mp, int Ksrc, float inv, unsigned char* WT, int ldt, int nblk, LAS float* scr, int item, int lane) {
    const int kb = item / nblk, nb = item % nblk, k0 = 64 * kb, n0 = 32 * nb;
    const float* src; int ldw; const int sc = mp(n0 + (lane & 31), src, ldw);
    float vv[32];
#pragma unroll
    for (int i = 0; i < 32; ++i) { const int k = k0 + 2 * i + (lane >> 5); vv[i] = (sc >= 0 && k < Ksrc) ? src[(size_t)k * ldw + sc] : 0.f; }
#pragma unroll
    for (int i = 0; i < 32; ++i) scr[(2 * i + (lane >> 5)) * 33 + (lane & 31)] = vv[i];
    LDS_WAIT(); asm volatile("" ::: "memory");
    const int c = lane & 7;
#pragma unroll
    for (int j = 0; j < 4; ++j) { const int n = (lane >> 3) + 8 * j; const LAS float* s = scr + (8 * c) * 33 + n;
        const unsigned long long o = (unsigned long long)q8x4(s[0 * 33], s[1 * 33], s[2 * 33], s[3 * 33], inv) | ((unsigned long long)q8x4(s[4 * 33], s[5 * 33], s[6 * 33], s[7 * 33], inv) << 32);
        *(unsigned long long*)(WT + (size_t)(n0 + n) * ldt + k0 + 8 * c) = o; }
    LDS_WAIT(); asm volatile("" ::: "memory");
}
__device__ __forceinline__ void tensor_absmax(const Ctx& C, const float* w0, const float* w1, int n4, float* slots, int step = 1, float* sqslots = nullptr) {
    float am = 0.f, sq = 0.f;
    for (int i = C.gw * 64 * step + C.lane; i < n4; i += C.NGW * 64 * step) {     const f32x4 a = ((const f32x4*)w0)[i], b = ((const f32x4*)w1)[i];
        am = fmaxf(am, fmaxf(fmaxf(fmaxf(fabsf(a.x), fabsf(a.y)), fmaxf(fabsf(a.z), fabsf(a.w))), fmaxf(fmaxf(fabsf(b.x), fabsf(b.y)), fmaxf(fabsf(b.z), fabsf(b.w)))));
        sq += (sum4f(a * a) + sum4f(b * b)); }
    am = wave_max_nn(am); if (sqslots) sq = wave_sum(sq);
    LAS float* st = (LAS float*)(C.lds + 14336);
    __syncthreads(); if (C.lane == 0) { st[C.wave] = am; st[8 + C.wave] = sq; } __syncthreads();
    if (C.tid == 0) { float t = st[0], u2 = st[8];
#pragma unroll
        for (int q = 1; q < 8; ++q) { t = fmaxf(t, st[q]); u2 += st[8 + q]; } slots[C.vcu] = t; if (sqslots) sqslots[C.vcu] = u2; }
    __syncthreads();
}
__device__ __forceinline__ float slots_sum(const float* slots, int G, int lane) { float t = 0.f; for (int i = lane; i < G; i += 64) t += slots[i]; return wave_sum(t); }
__device__ __forceinline__ float slots_max(const float* slots, int G, int lane) { float am = 0.f; for (int i = lane; i < G; i += 64) am = fmaxf(am, slots[i]); return wave_max_nn(am); }
struct MapIdent { const float* W; int ld; __device__ __forceinline__ int operator()(int n, const float*& s, int& l) const { s = W; l = ld; return n; } };
struct MapWin { const float* W; __device__ __forceinline__ int operator()(int n, const float*& s, int& l) const { s = W; l = IN_TOTAL;
    if (n < 1024) return n; if (n < 2048) return 1696 + (n - 1024); if (n < 3072) return 2720 + (n - 2048); if (n < 3328) return 1408 + (n - 3072); if (n < 3712) return 1024 + (n - 3328);
    if (n < 3744) { const int j = (n - 3712) >> 1, p = (n - 3712) & 1; return 1664 + j + 16 * p; } return -1; } };
struct MapWuq { const float* W; __device__ __forceinline__ int operator()(int n, const float*& s, int& l) const { s = W; l = 768; const int h = n / 96, o = n % 96;
    if (o < 64) return 96 * h + o; const int j = (o - 64) >> 1, p = (o - 64) & 1; return 96 * h + 64 + j + 16 * p; } };
struct MapWukv { const float* W; __device__ __forceinline__ int operator()(int n, const float*& s, int& l) const { s = W; l = 1024; if (n < 512) return 128 * (n >> 6) + (n & 63); const int m = n - 512; return 128 * (m >> 6) + 64 + (m & 63); } };
struct MapGU { const float* Wg; const float* Wu; int ld, nch; __device__ __forceinline__ int operator()(int n, const float*& s, int& l) const { const int r = n & 255, ch = 128 * (n >> 8) + (r & 127); s = Wg + ((r < 128) ? (ptrdiff_t)0 : (Wu - Wg)); l = ld; return ch < nch ? ch : -1; } };

constexpr float HID_KAPPA = 8.0f;
constexpr int W13_SAMPLES = NE * D * EFF / 16 * 2;
constexpr float W13_RANGE = 1.25f;
constexpr int P0_I13 = 16 * (2 * EFF / 32), P0_I2 = (EFF / 64) * 32, P0_MOE_ITEMS = NE * (P0_I13 + P0_I2);
#ifndef TAIL_G1
#define TAIL_G1 4
#endif
#ifndef TAIL_Q
#define TAIL_Q 2
#endif
#ifndef TAIL_FFN
#define TAIL_FFN 4
#endif
constexpr int TW64 = 64 * NWAVES, TW128 = 128 * NWAVES;
constexpr int TB_G1_0 = 0, TB_Q_0 = TB_G1_0 + TAIL_G1 * TW64, TB_FFN = TB_Q_0 + TAIL_Q * TW64, TB_G1_1 = TB_FFN + TAIL_FFN * TW128, TB_Q_1 = TB_G1_1 + TAIL_G1 * TW64, TB_END = TB_Q_1 + TAIL_Q * TW64;
static_assert(TB_END <= P0_MOE_ITEMS, "tail slices exceed the MoE items");
__device__ __forceinline__ void moe_item(const Ctx& C, const LAS unsigned long long* ptab, LAS float* scr, int m, int lane, float inv13, float inv2) {
    unsigned char* ws = C.ws; const int e = m / (P0_I13 + P0_I2); int r = m - e * (P0_I13 + P0_I2);
    if (r < P0_I13) { p0_item8(MapGU{inptr(ptab, 26) + (size_t)e * D * EFF, inptr(ptab, 27) + (size_t)e * D * EFF, EFF, EFF}, D, inv13, ws + WS_W13 + (size_t)e * 2 * EFF * D, D, 2 * EFF / 32, scr, r, lane); return; }
    r -= P0_I13;
    p0_item8(MapIdent{inptr(ptab, 28) + (size_t)e * EFF * D, D}, EFF, inv2, ws + WS_W2 + (size_t)e * D * EFF, EFF, D / 32, scr, r, lane);
}
__device__ __forceinline__ void moe_tail(const Ctx& C, const LAS unsigned long long* ptab, int cid, int first_cid, int base, int per_wave) {
    if (C.G != 256 || cid < first_cid) return;
    LAS float* scr = (LAS float*)(C.lds + C.wave * 16384); const int lane = fresh_lane(), widx = (cid - first_cid) * NWAVES + C.wave, nw = (256 - first_cid) * NWAVES;
    const float a13 = slots_max((const float*)(C.ws + WS_AMAX) + 256, C.G, lane) * W13_RANGE, inv13 = a13 > 0.f ? 127.0f / a13 : 0.f;
    const float a2 = slots_max((const float*)(C.ws + WS_AMAX) + 1024, C.G, lane) * W13_RANGE, inv2 = a2 > 0.f ? 127.0f / a2 : 0.f;
    for (int i = 0; i < per_wave; ++i) moe_item(C, ptab, scr, base + i * nw + widx, lane, inv13, inv2);
    __syncthreads();
}
template <int PART>
__device__ __forceinline__ void phase_prologue(const Ctx& C, const LAS unsigned long long* ptab) {
    LAS float* scr = (LAS float*)(C.lds + C.wave * 16384);
    unsigned char* ws = C.ws;
    constexpr int I_WIN = 16 * (NPROJ / 32), I_UQ = 6 * (768 / 32), I_UKV = 4 * (1024 / 32), I_AB = 8 * 32, I_WO = 16 * 32, I_GU = 16 * (2 * FFP / 32), I_WD = (FFP / 64) * 32, I_13 = 16 * (2 * EFF / 32), I_2 = (EFF / 64) * 32;
    constexpr int I_L = I_WIN + I_UQ + I_UKV + 2 * I_AB + I_WO;
    constexpr int NONMOE = NL * I_L + I_GU + I_WD; static_assert(I_13 == P0_I13 && I_2 == P0_I2, "item counts");
    const int m_first = (C.G == 256) ? TB_END : 0, NT_ITEMS = NONMOE + P0_MOE_ITEMS - m_first;
    if (PART == 1) { const float a13 = slots_max((const float*)(ws + WS_AMAX) + 256, C.G, C.lane) * W13_RANGE, inv13 = a13 > 0.f ? 127.0f / a13 : 0.f;
    const float a2 = slots_max((const float*)(ws + WS_AMAX) + 1024, C.G, C.lane) * W13_RANGE, inv2 = a2 > 0.f ? 127.0f / a2 : 0.f;
    for (int it = C.gw; it < NT_ITEMS; it += C.NGW) {
        int r = it;
        if (r < NL * I_L) { const int l = r / I_L; r -= l * I_L;
            if (r < I_WIN) { const float aw = slots_max((const float*)(ws + WS_AMAX) + 512 + 256 * l, C.G, C.lane); p0_item8(MapWin{inptr(ptab, 9) + (size_t)l * D * IN_TOTAL}, D, aw > 0.f ? 127.0f / aw : 0.f, ws + WS_WIN + (size_t)l * NPROJ * D, D, NPROJ / 32, scr, r, C.lane); continue; } r -= I_WIN;
            if (r < I_UQ) { p0_item(MapWuq{inptr(ptab, 15) + (size_t)l * QLORA * 768}, QLORA, inptr(ptab, 14) + l * QLORA, (bf16*)(ws + WS_WUQ) + (size_t)l * 768 * QLORA, QLORA, 768 / 32, scr, r, C.lane); continue; } r -= I_UQ;
            if (r < I_UKV) { p0_item(MapWukv{inptr(ptab, 17) + (size_t)l * KVLORA * 1024}, KVLORA, inptr(ptab, 16) + l * KVLORA, (bf16*)(ws + WS_WUKV) + (size_t)l * 1024 * KVLORA, KVLORA, 1024 / 32, scr, r, C.lane); continue; } r -= I_UKV;
            if (r < I_AB) { p0_item(MapIdent{inptr(ptab, 18) + (size_t)l * GW * D, D}, GW, nullptr, (bf16*)(ws + WS_WA) + (size_t)l * D * GW, GW, D / 32, scr, r, C.lane); continue; } r -= I_AB;
            if (r < I_AB) { p0_item(MapIdent{inptr(ptab, 19) + (size_t)l * GW * D, D}, GW, nullptr, (bf16*)(ws + WS_WB) + (size_t)l * D * GW, GW, D / 32, scr, r, C.lane); continue; } r -= I_AB;
            p0_item(MapIdent{inptr(ptab, 20) + (size_t)l * D * D, D}, D, nullptr, (bf16*)(ws + WS_WO) + (size_t)l * D * D, D, D / 32, scr, r, C.lane); continue; }
        r -= NL * I_L;
        if (r < I_GU) { const float ag = slots_max((const float*)(ws + WS_AMAX), C.G, C.lane); p0_item8(MapGU{inptr(ptab, 21), inptr(ptab, 22), FF, FF}, D, ag > 0.f ? 127.0f / ag : 0.f, ws + WS_WGU, D, 2 * FFP / 32, scr, r, C.lane); continue; } r -= I_GU;
        if (r < I_WD) { p0_item(MapIdent{inptr(ptab, 23), D}, FF, nullptr, (bf16*)(ws + WS_WD), FFP, D / 32, scr, r, C.lane); continue; } r -= I_WD;
        moe_item(C, ptab, scr, r + m_first, C.lane, inv13, inv2);
    }
    return; }
    tensor_absmax(C, inptr(ptab, 21), inptr(ptab, 22), D * FF / 4, (float*)(ws + WS_AMAX));
    tensor_absmax(C, inptr(ptab, 26), inptr(ptab, 27), NE * D * EFF / 4, (float*)(ws + WS_AMAX) + 256, 16, (float*)(ws + WS_AMAX) + 1280);
    tensor_absmax(C, inptr(ptab, 28), inptr(ptab, 28) + (size_t)NE * D * EFF / 2, NE * D * EFF / 8, (float*)(ws + WS_AMAX) + 1024, 16);
    tensor_absmax(C, inptr(ptab, 9), inptr(ptab, 9) + D * IN_TOTAL / 2, D * IN_TOTAL / 8, (float*)(ws + WS_AMAX) + 512);
    tensor_absmax(C, inptr(ptab, 9) + D * IN_TOTAL, inptr(ptab, 9) + D * IN_TOTAL + D * IN_TOTAL / 2, D * IN_TOTAL / 8, (float*)(ws + WS_AMAX) + 768);
    { float* MOD = (float*)(ws + WS_MOD); const float* cc = inptr(ptab, 1); const float* aw = inptr(ptab, 3); const float* ab = inptr(ptab, 4);
      for (int it = C.vcu; it < NL * 96; it += C.G) { const int l = it / 96, jb = it % 96, ds = C.wave, g = C.lane >> 4;
          f32x4 s = {0.f, 0.f, 0.f, 0.f}; const float* w = aw + ((size_t)l * D + ds * 128 + g) * (6 * D) + jb * 64 + (C.lane & 15) * 4; const float* cw = cc + ds * 128 + g;
#pragma unroll 16
          for (int i = 0; i < 32; ++i) { const f32x4 wv = *(const f32x4*)(w + (size_t)(4 * i) * 6 * D); s += wv * siluf_(cw[4 * i]); }
          *((LAS f32x4*)(C.lds + C.wave * 16384 + 12288) + C.lane) = s;
          __syncthreads();
          if (C.wave == 0) { const int j = jb * 64 + C.lane; float t = ab[l * 6 * D + j];
#pragma unroll
              for (int q = 0; q < 8; ++q) { const LAS float* pq = (const LAS float*)(C.lds + q * 16384 + 12288) + C.lane; t += pq[0]; t += pq[64]; t += pq[128]; t += pq[192]; }
              MOD[l * 6 * D + j] = t; }
          __syncthreads(); } }
    { const float invf[16] = {1.000000000e+00f, 5.623413324e-01f, 3.162277639e-01f, 1.778279394e-01f, 1.000000015e-01f, 5.623412877e-02f, 3.162277862e-02f, 1.778279431e-02f, 9.999999776e-03f, 5.623413250e-03f, 3.162277862e-03f, 1.778279431e-03f, 1.000000047e-03f, 5.623413017e-04f, 3.162277862e-04f, 1.778279402e-04f};
      const int* pos = (const int*)inptr(ptab, 2); float* ct = (float*)(ws + WS_COS); float* st = (float*)(ws + WS_SIN);
      const int j = C.lane & 15; float f = invf[0];
#pragma unroll
      for (int q = 1; q < 16; ++q) f = (j == q) ? invf[q] : f;
      for (int it = C.gw; it < M / 4; it += C.NGW) { const int row = it * 4 + (C.lane >> 4); const float ang = (float)pos[row] * f;
          const double rev = (double)ang * 0.15915494309189533577; const float fr = (float)(rev - floor(rev));
          ct[row * 16 + j] = __builtin_amdgcn_cosf(fr); st[row * 16 + j] = __builtin_amdgcn_sinf(fr); } }
    { const float* wsrc = inptr(ptab, 12); bf16* wst = (bf16*)(ws + WS_WST);
      for (int it = C.gw; it < NL * NGRP * CHUNK * CHUNK / 256; it += C.NGW) { const int e0 = it * 256 + C.lane * 4; const int t = (e0 >> 7) & 127, s0 = e0 & 127;
          const f32x4 v = *(const f32x4*)(wsrc + e0); unsigned long long o = (unsigned long long)pk2(s0 <= t ? v.x : 0.f, s0 + 1 <= t ? v.y : 0.f) | ((unsigned long long)pk2(s0 + 2 <= t ? v.z : 0.f, s0 + 3 <= t ? v.w : 0.f) << 32);
          *(unsigned long long*)(wst + e0) = o; } }
}
template <bool HQ>
__device__ __forceinline__ void phase_prenorm(const Ctx& C, const float* x, const float* w, const float* sc, const float* sh, bf16* H, float* sa) {
    f32x4 ca[4], cb[4];
#pragma unroll
    for (int j = 0; j < 4; ++j) { const int c = 4 * C.lane + 256 * j; const f32x4 ww = *(const f32x4*)(w + c), s1 = *(const f32x4*)(sc + c); ca[j] = ww * (s1 + 1.0f); cb[j] = *(const f32x4*)(sh + c); }
    for (int blk = C.vcu; blk < M / 64; blk += C.G) {
    const int m0 = blk * 64 + C.wave * 8; f32x4 nx[4];
#pragma unroll
    for (int j = 0; j < 4; ++j) nx[j] = *((const f32x4*)(x + (size_t)m0 * D) + C.lane + 64 * j);
    for (int m = m0; m < m0 + 8; ++m) {
        f32x4 v[4]; float s2 = 0.f;
#pragma unroll
        for (int j = 0; j < 4; ++j) v[j] = nx[j];
        if (m + 1 < m0 + 8) {
#pragma unroll
            for (int j = 0; j < 4; ++j) nx[j] = *((const f32x4*)(x + (size_t)(m + 1) * D) + C.lane + 64 * j); }
#pragma unroll
        for (int j = 0; j < 4; ++j) s2 += sum4f(v[j] * v[j]);
        const float rstd = 1.0f / sqrtf(wave_sum(s2) * (1.0f / D) + EPS);
        unsigned long long* o8 = (unsigned long long*)(H + (size_t)m * D) + C.lane;
#pragma unroll
        for (int j = 0; j < 4; ++j) { const f32x4 hv = v[j] * rstd * ca[j] + cb[j]; if (HQ) v[j] = hv; else o8[64 * j] = (unsigned long long)pk2(hv.x, hv.y) | ((unsigned long long)pk2(hv.z, hv.w) << 32); }
        if (HQ) { float am = 0.f;
#pragma unroll
            for (int j = 0; j < 4; ++j) am = fmaxf(am, fmaxf(fmaxf(fabsf(v[j].x), fabsf(v[j].y)), fmaxf(fabsf(v[j].z), fabsf(v[j].w))));
            am = wave_max_nn(am); const float inv = am > 0.f ? 127.0f / am : 0.f; unsigned* q4 = (unsigned*)((unsigned char*)H + (size_t)m * D) + C.lane;
#pragma unroll
            for (int j = 0; j < 4; ++j) q4[64 * j] = q8x4(v[j].x, v[j].y, v[j].z, v[j].w, inv);
            if (C.lane == 0) sa[m] = am * (1.0f / 127.0f); }
    }
    }
}
__device__ __forceinline__ void ld_bf4(const bf16* p, f32x4& v) { const unsigned long long w = *(const unsigned long long*)p; const unsigned lo = (unsigned)w, hi = (unsigned)(w >> 32);
    v = (f32x4){__uint_as_float(lo << 16), __uint_as_float(lo & 0xffff0000u), __uint_as_float(hi << 16), __uint_as_float(hi & 0xffff0000u)}; }
template <int MODE, bool XIB, bool XOB, bool HQ = false>
__device__ __forceinline__ void phase_resid(const Ctx& C, const void* xin_, void* xout_, const bf16* Y, const bf16* Ysecond, int ypitch, const float* g, const float* wpost,
                                            const float* wpre, const float* sc, const float* sh, bf16* H, const float* wr, const float* br, int* topi, float* topg, int* list, gu32* cnt, float* sa = nullptr) {
    f32x4 cg[4], ca[4], cb[4];
#pragma unroll
    for (int j = 0; j < 4; ++j) { const int c = 4 * C.lane + 256 * j; cg[j] = *(const f32x4*)(g + c) * *(const f32x4*)(wpost + c);
        if (MODE >= 1) { ca[j] = *(const f32x4*)(wpre + c) * (*(const f32x4*)(sc + c) + 1.0f); cb[j] = *(const f32x4*)(sh + c); } }
    LAS float* WR = (LAS float*)C.lds;
    LAS int* lcnt = (LAS int*)(C.lds + 32768);
    LAS int* lsel = (LAS int*)(C.lds + 32768 + 64);
    LAS float* rsc = (LAS float*)(C.lds + 36864) + C.wave * 1024;
    if (MODE == 2) { for (int i = C.tid; i < D * NE / 4; i += NWAVES * 64) ((LAS f32x4*)WR)[i] = ((const f32x4*)wr)[i]; if (C.tid < 16) lcnt[C.tid] = 0; __syncthreads(); }
    for (int blk = C.vcu; blk < M / 64; blk += C.G) {
        const int m_begin = blk * 64 + C.wave * 8, m_end = m_begin + 8;
        unsigned long long yr[4], yr2[4], xb[4]; f32x4 xr[4]; const float* xin = (const float*)xin_; const bf16* xinb = (const bf16*)xin_; float* xout = (float*)xout_; bf16* xoutb = (bf16*)xout_;
#define RES_LOAD(mm) do { _Pragma("unroll") for (int j = 0; j < 4; ++j) { yr[j] = *(const unsigned long long*)(Y + (size_t)(mm) * ypitch + 4 * C.lane + 256 * j); if (Ysecond) yr2[j] = *(const unsigned long long*)(Ysecond + (size_t)(mm) * ypitch + 4 * C.lane + 256 * j); \
            if (XIB) xb[j] = *((const unsigned long long*)(xinb + (size_t)(mm) * D) + C.lane + 64 * j); else xr[j] = *((const f32x4*)(xin + (size_t)(mm) * D) + C.lane + 64 * j); } } while (0)
#define RES_CVT(w, v) do { const unsigned lo_ = (unsigned)(w), hi_ = (unsigned)((w) >> 32); v = (f32x4){__uint_as_float(lo_ << 16), __uint_as_float(lo_ & 0xffff0000u), __uint_as_float(hi_ << 16), __uint_as_float(hi_ & 0xffff0000u)}; } while (0)
        RES_LOAD(m_begin);
        for (int m = m_begin; m < m_end; ++m) {
            f32x4 y[4], xv[4]; float s2 = 0.f;
#pragma unroll
            for (int j = 0; j < 4; ++j) { RES_CVT(yr[j], y[j]); if (Ysecond) { f32x4 t; RES_CVT(yr2[j], t); y[j] += t; } if (XIB) RES_CVT(xb[j], xv[j]); else xv[j] = xr[j]; }
            if (m + 1 < m_end) RES_LOAD(m + 1);
#pragma unroll
            for (int j = 0; j < 4; ++j) s2 += sum4f(y[j] * y[j]);
            const float rstd = 1.0f / sqrtf(wave_sum(s2) * (1.0f / D) + EPS); float s3 = 0.f;
#pragma unroll
            for (int j = 0; j < 4; ++j) { xv[j] += cg[j] * (y[j] * rstd);
                if (XOB) { const unsigned long long w = (unsigned long long)pk2(xv[j].x, xv[j].y) | ((unsigned long long)pk2(xv[j].z, xv[j].w) << 32); *((unsigned long long*)(xoutb + (size_t)m * D) + C.lane + 64 * j) = w; RES_CVT(w, xv[j]); }
                else *((f32x4*)(xout + (size_t)m * D) + C.lane + 64 * j) = xv[j];
                s3 += sum4f(xv[j] * xv[j]); }
            if (MODE >= 1) {
                const float rstd2 = 1.0f / sqrtf(wave_sum(s3) * (1.0f / D) + EPS);
                unsigned long long* o8 = (unsigned long long*)(H + (size_t)m * D) + C.lane; float lg[8];
                if (MODE == 2) {
#pragma unroll
                    for (int e = 0; e < 8; ++e) lg[e] = 0.f; }
                if (HQ) { float am = 0.f;
#pragma unroll
                    for (int j = 0; j < 4; ++j) { xv[j] = xv[j] * rstd2 * ca[j] + cb[j]; am = fmaxf(am, fmaxf(fmaxf(fabsf(xv[j].x), fabsf(xv[j].y)), fmaxf(fabsf(xv[j].z), fabsf(xv[j].w)))); }
                    am = wave_max_nn(am); const float inv = am > 0.f ? 127.0f / am : 0.f; unsigned* q4 = (unsigned*)((unsigned char*)H + (size_t)m * D) + C.lane;
#pragma unroll
                    for (int j = 0; j < 4; ++j) q4[64 * j] = q8x4(xv[j].x, xv[j].y, xv[j].z, xv[j].w, inv);
                    if (C.lane == 0) sa[m] = am * (1.0f / 127.0f);
                    if (MODE == 2) { float hs = 0.f;
#pragma unroll
                        for (int j = 0; j < 4; ++j) hs += sum4f(xv[j] * xv[j]);
                        hs = wave_sum(hs); if (C.lane == 0) sa[m + M] = hs; }
                    if (MODE == 2) {
#pragma unroll
                        for (int j = 0; j < 4; ++j)
#pragma unroll
                            for (int q = 0; q < 4; ++q) { const int c = 4 * C.lane + 256 * j + q; const f32x4 w0 = *(const LAS f32x4*)(WR + c * 8), w1 = *(const LAS f32x4*)(WR + c * 8 + 4); const float hq = xv[j][q];
                                lg[0] += hq * w0.x; lg[1] += hq * w0.y; lg[2] += hq * w0.z; lg[3] += hq * w0.w; lg[4] += hq * w1.x; lg[5] += hq * w1.y; lg[6] += hq * w1.z; lg[7] += hq * w1.w; } } }
                else
#pragma unroll
                for (int j = 0; j < 4; ++j) { const f32x4 hv = xv[j] * rstd2 * ca[j] + cb[j]; o8[64 * j] = (unsigned long long)pk2(hv.x, hv.y) | ((unsigned long long)pk2(hv.z, hv.w) << 32);
                    if (MODE == 2) {
#pragma unroll
                        for (int q = 0; q < 4; ++q) { const int c = 4 * C.lane + 256 * j + q; const f32x4 w0 = *(const LAS f32x4*)(WR + c * 8), w1 = *(const LAS f32x4*)(WR + c * 8 + 4); const float hq = hv[q];
                            lg[0] += hq * w0.x; lg[1] += hq * w0.y; lg[2] += hq * w0.z; lg[3] += hq * w0.w; lg[4] += hq * w1.x; lg[5] += hq * w1.y; lg[6] += hq * w1.z; lg[7] += hq * w1.w; } } }
                if (MODE == 2) {
#pragma unroll
                    for (int e = 0; e < 8; ++e) rsc[e * 64 + C.lane] = lg[e];
                    __builtin_amdgcn_fence(__ATOMIC_RELEASE, "wavefront"); __builtin_amdgcn_wave_barrier(); __builtin_amdgcn_fence(__ATOMIC_ACQUIRE, "wavefront");
                    if (C.lane < 8) { float t = br[C.lane];
                        for (int i = 0; i < 64; ++i) t += rsc[C.lane * 64 + i];
                        rsc[512 + C.lane] = t; }
                    __builtin_amdgcn_fence(__ATOMIC_RELEASE, "wavefront"); __builtin_amdgcn_wave_barrier(); __builtin_amdgcn_fence(__ATOMIC_ACQUIRE, "wavefront");
#pragma unroll
                    for (int e = 0; e < 8; ++e) lg[e] = rsc[512 + e];
                    __builtin_amdgcn_fence(__ATOMIC_RELEASE, "wavefront"); __builtin_amdgcn_wave_barrier(); __builtin_amdgcn_fence(__ATOMIC_ACQUIRE, "wavefront");
#ifdef DIAG_LOGITS
                    if (C.lane == 0) { float* LG = (float*)(C.ws + 514 * MiB) + (size_t)m * 8;
#pragma unroll
                        for (int e = 0; e < 8; ++e) LG[e] = lg[e]; }
#endif
                    int i0 = 0; float v0 = lg[0];
#pragma unroll
                    for (int e = 1; e < 8; ++e) if (lg[e] > v0) { v0 = lg[e]; i0 = e; }
                    int i1 = -1; float v1 = -INFINITY;
#pragma unroll
                    for (int e = 0; e < 8; ++e) if (e != i0 && lg[e] > v1) { v1 = lg[e]; i1 = e; }
                    const float e1 = __expf(v1 - v0), g0 = 1.0f / (1.0f + e1), g1 = e1 * g0;
                    if (C.lane == 0) { topi[2 * m] = i0; topi[2 * m + 1] = i1; topg[2 * m] = g0; topg[2 * m + 1] = g1;
                        const int lr = m - blk * 64; lsel[2 * lr] = i0; lsel[2 * lr + 1] = i1; }
                }
            }
        }
        if (MODE == 2) {
            __syncthreads();
            if (C.tid < 128) { const int e = lsel[C.tid]; int rk = 0; for (int t2 = 0; t2 < C.tid; ++t2) rk += (lsel[t2] == e) ? 1 : 0; ((int*)list)[(size_t)NE * M + blk * 128 + C.tid] = (e << 16) | rk; }
            if (C.tid >= 128 && C.tid < 136) { const int e = C.tid - 128; int c = 0; for (int t2 = 0; t2 < 128; ++t2) c += (lsel[t2] == e) ? 1 : 0; ((int*)list)[(size_t)NE * M + (M / 64) * 128 + blk * 8 + e] = c; }
            __syncthreads();
        }
    }
}
__device__ __forceinline__ void phase_moe_lists(const Ctx& C, int* list, const float* sa, float* lsa, float* lhs, float hidk) {
    const int* RANK = list + (size_t)NE * M; const int* CNTB = RANK + (M / 64) * 128; LAS int* base = (LAS int*)C.lds;
    for (int blk = C.vcu; blk < M / 64; blk += C.G) {
        __syncthreads();
        { float s = 0.f;
#pragma unroll
          for (int i = 0; i < 4; ++i) { const int b2 = C.lane + 64 * i; s += (b2 < blk) ? (float)CNTB[b2 * 8 + C.wave] : 0.f; }
          s = wave_sum(s); if (C.lane == 0) base[C.wave] = (int)s; }
        __syncthreads();
        if (C.tid < 128) { const int v = RANK[blk * 128 + C.tid], e = v >> 16, rk = v & 0xffff; list[e * M + base[e] + rk] = ((blk * 64 + (C.tid >> 1)) << 1) | (C.tid & 1); lsa[e * M + base[e] + rk] = sa[blk * 64 + (C.tid >> 1)]; lhs[e * M + base[e] + rk] = hidk * sa[M + blk * 64 + (C.tid >> 1)]; }
    }
}
__device__ __forceinline__ void phase_gmlp(const Ctx& C, const bf16* PROJ, const float* sumv, const float* ssqv, const float* lng, const float* lnb, const bf16* WST, const float* bs, bf16* GM) {
    typedef __attribute__((ext_vector_type(16))) float f32x16; typedef unsigned u32x4v __attribute__((ext_vector_type(4)));
    LAS bf16* VT = (LAS bf16*)C.lds;
    const int r32 = C.lane & 31, hi = C.lane >> 5;
    const int xg = C.G >> 3, xq = C.vcu / (xg > 0 ? xg : 1), xr = C.vcu - xq * xg;
    for (int uu = xr; uu < 128; uu += xg) {
        const int u = xq * 128 + uu;
        const int c = u >> 3, g = u & 7, t0 = c * CHUNK, ch0 = g * 64;
        { const int s = C.tid >> 2, dq = (C.tid & 3) * 16, row = t0 + s; const f32x4 sa = *(const f32x4*)(sumv + row * 8), sb = *(const f32x4*)(sumv + row * 8 + 4), qa = *(const f32x4*)(ssqv + row * 8), qb = *(const f32x4*)(ssqv + row * 8 + 4);
          const float mean = (((sa[0] + sa[1]) + (sa[2] + sa[3])) + ((sb[0] + sb[1]) + (sb[2] + sb[3]))) * (1.0f / GW), var = (((qa[0] + qa[1]) + (qa[2] + qa[3])) + ((qb[0] + qb[1]) + (qb[2] + qb[3]))) * (1.0f / GW) - mean * mean, rstd = 1.0f / sqrtf(var + EPS);
          const u32x4v w0 = *(const u32x4v*)(PROJ + (size_t)row * NPROJ + PC_V + ch0 + dq), w1 = *(const u32x4v*)(PROJ + (size_t)row * NPROJ + PC_V + ch0 + dq + 8);
#pragma unroll
          for (int i = 0; i < 8; ++i) { const unsigned wa = (i < 4) ? w0[i] : w1[i - 4]; const int d = dq + 2 * i;
              const float a = (__uint_as_float(wa << 16) - mean) * rstd * lng[ch0 + d] + lnb[ch0 + d], b = (__uint_as_float(wa & 0xffff0000u) - mean) * rstd * lng[ch0 + d + 1] + lnb[ch0 + d + 1];
              VT[d * 136 + s] = (bf16)f2bf(a); VT[(d + 1) * 136 + s] = (bf16)f2bf(b); } }
        __syncthreads();
        const int dblk = C.wave & 1, tblk = C.wave >> 1; f32x16 acc = {};
        const bf16* wrow = WST + ((size_t)g * CHUNK + 32 * tblk + r32) * CHUNK + 8 * hi;
        for (int ks = 0; ks <= 2 * tblk + 1; ++ks) {
            const bf16x8 af = *(const LAS bf16x8*)(VT + (32 * dblk + r32) * 136 + 16 * ks + 8 * hi);
            const bf16x8 bfr = *(const bf16x8*)(wrow + 16 * ks);
            acc = __builtin_amdgcn_mfma_f32_32x32x16_bf16(af, bfr, acc, 0, 0, 0);
        }
        const int tl = 32 * tblk + r32, row = t0 + tl; const float bias = bs[g * CHUNK + tl];
#pragma unroll
        for (int q = 0; q < 4; ++q) { const int ch = ch0 + 32 * dblk + 8 * q + 4 * hi; f32x4 uv; ld_bf4(PROJ + (size_t)row * NPROJ + PC_U + ch, uv);
            const f32x4 z = (f32x4){acc[4 * q] + bias, acc[4 * q + 1] + bias, acc[4 * q + 2] + bias, acc[4 * q + 3] + bias}, o = uv * z;
            *(unsigned long long*)(GM + (size_t)row * GW + ch) = (unsigned long long)pk2(o.x, o.y) | ((unsigned long long)pk2(o.z, o.w) << 32); }
        __syncthreads();
    }
}
__device__ __forceinline__ void moe_tab_build(const Ctx& C, const int* list, LAS int* tab) {
    const int* CNTB = list + (size_t)NE * M + (M / 64) * 128;
    __syncthreads();
    { float s = 0.f;
#pragma unroll
      for (int i = 0; i < 4; ++i) s += (float)CNTB[(C.lane + 64 * i) * 8 + C.wave];
      s = wave_sum(s); if (C.lane == 0) tab[16 + C.wave] = (int)s; }
    __syncthreads();
    if (C.tid == 0) { int acc = 0; for (int e = 0; e < 8; ++e) { tab[e] = acc; acc += (tab[16 + e] + 255) >> 8; } tab[8] = acc; }
    __syncthreads();
}
__device__ __forceinline__ int moe_expert_of(const LAS int* tab, int panel) { int e = 0;
#pragma unroll
    for (int q = 1; q < 8; ++q) e += (panel >= tab[q]) ? 1 : 0; return e; }
__device__ __forceinline__ void phase_gather(const Ctx& C, const LAS int* tab, const bf16* H, const int* list, const float* topg, bf16* XG, int* rowdest, float* rowgate) {
    typedef unsigned u32x4v __attribute__((ext_vector_type(4)));
    const int total = tab[8] * 256;
    for (int p = C.gw; p < total; p += C.NGW) {
        const int e = moe_expert_of(tab, p >> 8), i = p - tab[e] * 256; u32x4v v0 = {0u, 0u, 0u, 0u}, v1 = {0u, 0u, 0u, 0u}; int dest = -1; float gt = 0.f;
        if (i < tab[16 + e]) { dest = list[e * M + i]; gt = topg[dest]; const u32x4v* src = (const u32x4v*)(H + (size_t)(dest >> 1) * D); v0 = src[C.lane]; v1 = src[64 + C.lane]; }
        u32x4v* dst = (u32x4v*)(XG + (size_t)p * D); dst[C.lane] = v0; dst[64 + C.lane] = v1;
        if (C.lane == 0) { rowdest[p] = dest; rowgate[p] = gt; }
    }
}
struct MoeOrder {
    pg8::StaticOrder S; int p0; size_t estride; int absA; const LAS int* tab; const int* list; int rowbytes; const float* lsa;
    long limit;
    __device__ bool next(int i, pg8::Unit& u) const { const long L = (long)i * S.G + S.c; if (L >= limit) return false; return at(L, u); }
    __device__ bool at(long L, pg8::Unit& u) const { if (!S.at(L, u)) return false; const int P = p0 + u.pm; const int e = __builtin_amdgcn_readfirstlane(moe_expert_of(tab, P)); u.aux = P; u.aoff = (size_t)(absA ? P : u.pm) * S.astep; u.boff += (size_t)e * estride; return true; }
    __device__ __forceinline__ float rowscale_of(const pg8::Unit& u, int rl) const { const int P = u.aux, e = __builtin_amdgcn_readfirstlane(moe_expert_of(tab, P)), i = (P - tab[e]) * 256 + rl; return (i < tab[16 + e]) ? lsa[e * M + i] : 0.f; }
    __device__ __forceinline__ int rowtok(const pg8::Unit& u, int rl) const {
        const int P = u.aux, e = __builtin_amdgcn_readfirstlane(moe_expert_of(tab, P)), i = (P - tab[e]) * 256 + rl; return (i < tab[16 + e]) ? (list[e * M + i] >> 1) : 0; }
    __device__ __forceinline__ void avoff(const pg8::Unit& u, const int (&R)[2], const int (&C)[2], unsigned (&v)[2][2]) const {
        const int P = u.aux, e = __builtin_amdgcn_readfirstlane(moe_expert_of(tab, P)), base = (P - tab[e]) * 256, cnt = tab[16 + e];
#pragma unroll
        for (int h = 0; h < 2; ++h)
#pragma unroll
            for (int i = 0; i < 2; ++i) { const int r = base + h * 128 + R[i]; const int tk = (r < cnt) ? list[e * M + r] : 0; v[h][i] = (unsigned)(tk >> 1) * (unsigned)rowbytes + (unsigned)C[i] * 2u; }
    }
};
struct OneUnit { MoeOrder S; long L; __device__ bool next(int i, pg8::Unit& u) const { if (i != 0) return false; return S.at(L, u); }
    __device__ __forceinline__ float rowscale_of(const pg8::Unit& u, int rl) const { return S.rowscale_of(u, rl); } };
__device__ __forceinline__ void phase_moe_reduce(const Ctx& C, const MoeOrder& S, long nfull, int nleft, const float* SP, const int* list, const float* topg, const LAS int* tab, bf16* Y2) {
    for (int it = C.gw; it < nleft * 256; it += C.NGW) {
        const int j = it >> 8, r = it & 255; pg8::Unit u; if (!S.at(nfull + j, u)) continue;
        const int P = u.aux, e = __builtin_amdgcn_readfirstlane(moe_expert_of(tab, P)), i = (P - tab[e]) * 256 + r;
        if (i >= tab[16 + e]) continue;
        const int d = list[e * M + i]; const float gt = topg[d];
        const float* p = SP + ((size_t)(2 * j) * 256 + r) * 256 + 4 * C.lane; const size_t ts = (size_t)256 * 256;
        const f32x4 s = *(const f32x4*)p + *(const f32x4*)(p + ts);
        *(unsigned long long*)(Y2 + (size_t)d * D + u.pn * 256 + 4 * C.lane) = (unsigned long long)pk2(s.x * gt, s.y * gt) | ((unsigned long long)pk2(s.z * gt, s.w * gt) << 32);
    }
}
#ifndef EN_LEFT
#define EN_LEFT 1
#endif
#ifndef ATTN_BOUND2
#define ATTN_BOUND2 4096.0f
#endif
#ifndef ATTN_FASTSEL
#define ATTN_FASTSEL true
#endif
#ifndef PR_ATT
#define PR_ATT 1
#endif
#ifndef PR_G1
#define PR_G1 1
#endif
#ifndef PR_GMLP
#define PR_GMLP 1
#endif
#ifndef PR_QKV
#define PR_QKV 1
#endif
#ifndef PR_OUT
#define PR_OUT 1
#endif
#ifndef PR_FFN1
#define PR_FFN1 1
#endif
#ifndef PR_FFN2
#define PR_FFN2 1
#endif
#ifndef PR_MOE1
#define PR_MOE1 1
#endif
#ifndef PR_MOE2
#define PR_MOE2 1
#endif
#ifndef PR_P0
#define PR_P0 1
#endif
#ifndef EN_ALL
#define EN_ALL 1
#endif
#ifndef DIAG_TWIN_OFF
#define DIAG_TWIN_OFF WS_ACT
#endif
#ifndef EN_FFN2
#define EN_FFN2 1
#endif
#ifndef EN_BR2
#define EN_BR2 1
#endif
#ifndef EN_C1
#define EN_C1 1
#endif
#ifndef EN_C2
#define EN_C2 1
#endif
#ifndef EN_C3
#define EN_C3 1
#endif
#ifndef EN_P0
#define EN_P0 EN_ALL
#endif
#ifndef EN_P1
#define EN_P1 EN_ALL
#endif
#ifndef EN_G1
#define EN_G1 EN_ALL
#endif
#ifndef EN_C
#define EN_C EN_ALL
#endif
#ifndef EN_ATT
#define EN_ATT EN_ALL
#endif
#ifndef EN_BR
#define EN_BR EN_ALL
#endif
#ifndef EN_OUT
#define EN_OUT EN_ALL
#endif
#ifndef EN_T1
#define EN_T1 EN_ALL
#endif
#ifndef EN_FFN
#define EN_FFN EN_ALL
#endif
#ifndef EN_T2
#define EN_T2 EN_ALL
#endif
#ifndef EN_GA
#define EN_GA EN_ALL
#endif
#ifndef EN_MOE
#define EN_MOE EN_ALL
#endif
#ifndef EN_FIN
#define EN_FIN EN_ALL
#endif
constexpr int NPHASES = 23;
__global__ void __launch_bounds__(NWAVES * 64, 2) mega_fwd(Args args) {
    extern __shared__ __attribute__((aligned(16))) unsigned char lds[];
    Ctx C; C.lds = (LAS unsigned char*)lds; C.ws = args.ws; C.ctl = (gu32*)(args.ws + WS_CTL);
    C.tid = threadIdx.x; C.lane = C.tid & 63; C.wave = __builtin_amdgcn_readfirstlane(C.tid >> 6);
    for (int u = threadIdx.x; u < (LDS_BYTES - LDSCTL_OFF) / 4; u += NWAVES * 64) ((LAS unsigned*)(C.lds + LDSCTL_OFF))[u] = 0u;
    __syncthreads();
    C.G = gridDim.x;
    int cid = blockIdx.x;
    { volatile LAS unsigned* MI = (volatile LAS unsigned*)(C.lds + MISC_OFF);
      if (threadIdx.x == 0) { const unsigned xcc = xb_xcc_id(); const unsigned rk = __hip_atomic_fetch_add((gu32*)(args.ws + WS_CTL) + CW_XRANK + 64 * xcc, 1u, RLX_AGENT); MI[16] = xcc; MI[17] = rk; }
      __syncthreads();
      const int xcc = (int)MI[16], rk = (int)MI[17], per = C.G >> 3;
      if ((C.G & 7) == 0 && xcc < 8 && rk < per) { C.vcu = xcc * per + rk; cid = rk * 8 + xcc; } else { const int bx = blockIdx.x; C.vcu = (C.G % 8 == 0) ? (bx % 8) * (C.G / 8) + bx / 8 : bx; cid = bx; } }
    C.gw = C.vcu * NWAVES + C.wave; C.NGW = C.G * NWAVES;
    volatile LAS unsigned* MISC = (volatile LAS unsigned*)(C.lds + MISC_OFF);
    LAS int* moetab = (LAS int*)(C.lds + MISC_OFF + 256);
    LAS unsigned long long* ptab = (LAS unsigned long long*)(C.lds + MISC_OFF + 512);
    if (threadIdx.x < 29) ptab[threadIdx.x] = (unsigned long long)args.in[threadIdx.x];
    __syncthreads();
    XcdBarrier bar = xcd_barrier_post((unsigned*)(C.ctl + CW_BAR), MISC + 8);
    const int lo = args.ph_lo, hi = args.ph_hi;
    unsigned char* ws = args.ws;
#define IN(k) (lo <= (k) && (k) < hi)
#define FRESH() do { C.lane = fresh_lane(); C.tid = C.wave * 64 + C.lane; } while (0)
#define SEAM(k) do { if ((k) + 1 < hi) { XcdBarrier b_ = bar; { unsigned long long bp_ = (unsigned long long)b_.bar; asm volatile("" : "+s"(bp_)); b_.bar = (unsigned*)(GAS unsigned*)bp_; } xcd_barrier(b_, C.wave == 0 && fresh_lane() == 0); } } while (0)
#define INF(i) (inptr(ptab, (i)))
#define WSF(off) ([&]() { unsigned long long b_ = (unsigned long long)ws; asm volatile("" : "+s"(b_)); return (float*)(b_ + (off)); }())
    bf16* const Hb = (bf16*)(ws + WS_H); bf16* const PROJ = (bf16*)(ws + WS_PROJ); bf16* const Qb = (bf16*)(ws + WS_Q); bf16* const KNb = (bf16*)(ws + WS_KN); bf16* const VVb = (bf16*)(ws + WS_VV);
    bf16* const KPEb = (bf16*)(ws + WS_KPE); bf16* const GMb = (bf16*)(ws + WS_GM); bf16* const ATTb = (bf16*)(ws + WS_ATT); bf16* const Yb = (bf16*)(ws + WS_Y); bf16* const MRG = Hb; bf16* const H1b = (bf16*)(ws + WS_GM);
    const float* const MOD = (const float*)(ws + WS_MOD); const float* const cosT = (const float*)(ws + WS_COS); const float* const sinT = (const float*)(ws + WS_SIN);
    float* const xres = args.out; bf16* const xbf = (bf16*)(ws + WS_XB);

    if (IN(0)) { FRESH(); _Pragma("unroll") for (int rep_ = 0; rep_ < PR_P0; ++rep_) { phase_prologue<0>(C, ptab); { XcdBarrier b_ = bar; { unsigned long long bp_ = (unsigned long long)b_.bar; asm volatile("" : "+s"(bp_)); b_.bar = (unsigned*)(GAS unsigned*)bp_; } xcd_barrier(b_, C.wave == 0 && fresh_lane() == 0); } FRESH(); phase_prologue<1>(C, ptab); }
        if (EN_P1) phase_prenorm<true>(C, INF(0), INF(5), MOD + 1 * D, MOD + 0 * D, Hb, WSF(WS_SA));
        SEAM(0); }
#pragma unroll
    for (int l = 0; l < NL; ++l) {
        const int pb = (l == 0) ? 1 : 10;
        const float* mod = MOD + l * 6 * D;
        float* st_sumv = (float*)(ws + WS_PST + (size_t)l * 2 * MiB); float* st_ssqv = st_sumv + 8 * M; float* st_ssqq = st_sumv + 16 * M; float* st_ssqkv = st_sumv + 24 * M;
        if (EN_G1 && IN(pb + 1)) { FRESH();
#ifdef DIAG_L2FLUSH
            if (l == 1) { typedef unsigned u32x4f __attribute__((ext_vector_type(4))); const u32x4f* src = (const u32x4f*)(ws + WS_W13 + (size_t)C.vcu * (DIAG_L2FLUSH * 65536)); u32x4f acc_ = {0u, 0u, 0u, 0u};
                for (int i = 0; i < DIAG_L2FLUSH * 8; ++i) { const u32x4f v = src[i * 512 + C.tid]; acc_ ^= v; }
                if ((acc_.x ^ acc_.y ^ acc_.z ^ acc_.w) == 0x12345678u) ((unsigned*)(ws + WS_TOPI))[C.tid] = 1u; __syncthreads(); }
#endif
            pg8::Gemm g{l == 0 ? Hb : H1b, (const bf16*)(ws + WS_WIN + (size_t)l * NPROJ * D), D / 2, D / 2, D / 2, WSF(WS_SA), slots_max(WSF(WS_AMAX) + 512 + 256 * l, C.G, C.lane) * (1.0f / 127.0f)}; pg8::StaticOrder S; S.init(M, NPROJ, D / 2, D / 2, C.G, cid);
            pg8::EpiProj E{PROJ, KPEb, st_sumv, st_ssqv, st_ssqq, st_ssqkv, cosT, sinT};
#if 1
            _Pragma("unroll") for (int rep_ = 0; rep_ < PR_G1; ++rep_) pg8::gemm_phase<pg8::EpiProj, pg8::StaticOrder, true, PG8_SP2_DEFAULT, false, true>(C.lds + RING_OFF, g, S, E, C.wave);
            moe_tail(C, ptab, cid, 192, l ? TB_G1_1 : TB_G1_0, TAIL_G1);
#endif
            SEAM(pb + 1);
        }
        if (EN_C && IN(pb + 2)) { FRESH();
            _Pragma("unroll") for (int rep_ = 0; rep_ < PR_GMLP; ++rep_) phase_gmlp(C, PROJ, st_sumv, st_ssqv, INF(10) + l * GW, INF(11) + l * GW, (const bf16*)(ws + WS_WST) + (size_t)l * NGRP * CHUNK * CHUNK, INF(13) + l * NGRP * CHUNK, GMb);
            {
              const int first = C.G > 192 ? 192 : 0;
              if (cid >= first) for (int blk = cid - first; blk < M / 256; blk += C.G - first) { const int ln = fresh_lane();
                  const attn3::u32x4* kp = (const attn3::u32x4*)(KPEb + (size_t)(blk * 256 + C.wave * 32 + (ln & 31)) * 32) + 2 * (ln >> 5); float q = 0.f;
                  _Pragma("unroll") for (int i = 0; i < 2; ++i) { const attn3::u32x4 w = kp[i];
                      _Pragma("unroll") for (int j = 0; j < 4; ++j) { const float a = __builtin_bit_cast(float, w[j] << 16), b = __builtin_bit_cast(float, w[j] & 0xffff0000u); q += a * a; q += b * b; } }
                  q = wave_max_nn(xsum32(q));
                  if (ln == 0) __hip_atomic_fetch_max((unsigned*)(ws + WS_CTL) + CW_KMAX + 32 * l + 16, __builtin_bit_cast(unsigned, q), __ATOMIC_RELAXED, __HIP_MEMORY_SCOPE_AGENT); } }
            if (EN_C2) { pg8::Gemm g{PROJ + PC_CQ, (const bf16*)(ws + WS_WUQ) + (size_t)l * 768 * QLORA, NPROJ, QLORA, QLORA}; pg8::StaticOrder S; S.init(M, 768, NPROJ, QLORA, C.G, cid);
              pg8::EpiQ E{Qb, st_ssqq, cosT, sinT, 0.10206207261596577f * 1.4426950408889634f};
              _Pragma("unroll") for (int rep_ = 0; rep_ < PR_QKV; ++rep_) pg8::gemm_phase<pg8::EpiQ, pg8::StaticOrder>(C.lds + RING_OFF, g, S, E, C.wave);
              moe_tail(C, ptab, cid, 192, l ? TB_Q_1 : TB_Q_0, TAIL_Q); }
            if (EN_C3) { pg8::Gemm g{PROJ + PC_CKV, (const bf16*)(ws + WS_WUKV) + (size_t)l * 1024 * KVLORA, NPROJ, KVLORA, KVLORA}; pg8::StaticOrder S; S.init(M, 1024, NPROJ, KVLORA, C.G, cid);
              pg8::EpiKV E{KNb, VVb, st_ssqkv, (float*)(ws + WS_KMAXS) + l * 2048};
              _Pragma("unroll") for (int rep_ = 0; rep_ < PR_QKV; ++rep_) pg8::gemm_phase<pg8::EpiKV, pg8::StaticOrder>(C.lds + RING_OFF, g, S, E, C.wave); }
            SEAM(pb + 2);
        }
        if (EN_ATT && IN(pb + 3)) { FRESH();
_Pragma("unroll") for (int rep_ = 0; rep_ < PR_ATT; ++rep_)
            for (int ui = C.vcu; ui < 256; ui += C.G) { const int h = ui >> 5, s = ui & 31;
#ifdef ATTN_V1
                attn1::attn_unit(h, 63 - s, Qb, KNb, KPEb, VVb, ATTb, C.lds + RING_OFF, C.wave);
                attn1::attn_unit(h, s, Qb, KNb, KPEb, VVb, ATTb, C.lds + RING_OFF, C.wave); }
#else
                const unsigned* kmx = (const unsigned*)(ws + WS_CTL) + CW_KMAX + 32 * l;
#define KMXF(i) __builtin_bit_cast(float, __hip_atomic_load(kmx + (i), __ATOMIC_RELAXED, __HIP_MEMORY_SCOPE_AGENT))
                float kn2; { const float* km = (const float*)(ws + WS_KMAXS) + l * 2048 + h * 256 + 2 * fresh_lane(); const pg8::f32x2 a0 = *(const pg8::f32x2*)km, a1 = *(const pg8::f32x2*)(km + 128);
                    kn2 = wave_max_nn(fmaxf(a0.x + a1.x, a0.y + a1.y)); }
                const float kb2 = (kn2 + KMXF(16)) * 1.05f;
#undef KMXF
                const bool fast = ATTN_FASTSEL && fmaxf(attn3::qnorm2_max(h, 63 - s, (const attn3::bf16*)Qb, C.wave), attn3::qnorm2_max(h, s, (const attn3::bf16*)Qb, C.wave)) * kb2 < ATTN_BOUND2;
                if (fast) { _Pragma("nounroll") for (int k2 = 0; k2 < 2; ++k2)
                    attn3::attn_unit<8, true>(h, k2 ? s : 63 - s, (const attn3::bf16*)Qb, (const attn3::bf16*)KNb, (const attn3::bf16*)KPEb, (const attn3::bf16*)VVb, (attn3::bf16*)ATTb, (char*)lds + RING_OFF, C.wave); }
                else { _Pragma("nounroll") for (int k2 = 0; k2 < 2; ++k2)
                    attn3::attn_unit<8, false>(h, k2 ? s : 63 - s, (const attn3::bf16*)Qb, (const attn3::bf16*)KNb, (const attn3::bf16*)KPEb, (const attn3::bf16*)VVb, (attn3::bf16*)ATTb, (char*)lds + RING_OFF, C.wave); } }
#endif
            SEAM(pb + 3);
        }
        if (EN_BR && IN(pb + 4)) { FRESH();
            { pg8::Gemm g{GMb, (const bf16*)(ws + WS_WA) + (size_t)l * D * GW, GW, GW, GW}; pg8::StaticOrder S; S.init(M, D, GW, GW, C.G, cid);
#ifdef DIAG_BR_PLAIN
              pg8::EpiPlain E{MRG, D}; pg8::gemm_phase<pg8::EpiPlain, pg8::StaticOrder>(C.lds + RING_OFF, g, S, E, C.wave); }
#else
              pg8::EpiGate<0> E{MRG, PROJ + PC_GA}; pg8::gemm_phase<pg8::EpiGate<0>, pg8::StaticOrder>(C.lds + RING_OFF, g, S, E, C.wave); }
#endif
            if (EN_BR2) { pg8::Gemm g{ATTb, (const bf16*)(ws + WS_WB) + (size_t)l * D * GW, GW, GW, GW}; pg8::StaticOrder S; S.init(M, D, GW, GW, C.G, cid);
              pg8::EpiGate<1> E{MRG, PROJ + PC_GB}; pg8::gemm_phase<pg8::EpiGate<1>, pg8::StaticOrder>(C.lds + RING_OFF, g, S, E, C.wave); }
            SEAM(pb + 4);
        }
        if (EN_OUT && IN(pb + 5)) { FRESH();
            pg8::Gemm g{MRG, (const bf16*)(ws + WS_WO) + (size_t)l * D * D, D, D, D}; pg8::StaticOrder S; S.init(M, D, D, D, C.G, cid);
            pg8::EpiPlain E{Yb, D}; _Pragma("unroll") for (int rep_ = 0; rep_ < PR_OUT; ++rep_) pg8::gemm_phase<pg8::EpiPlain, pg8::StaticOrder>(C.lds + RING_OFF, g, S, E, C.wave);
            SEAM(pb + 5);
        }
        if (l == 0) {
            if (EN_T1 && IN(7)) { FRESH(); phase_resid<1, false, true, true>(C, INF(0), xbf, Yb, nullptr, D, mod + 2 * D, INF(6) + l * D, INF(7) + l * D, mod + 4 * D, mod + 3 * D, H1b, nullptr, nullptr, nullptr, nullptr, nullptr, nullptr, WSF(WS_SA) + M); SEAM(7); }
            if (EN_FFN && IN(8)) { FRESH();
                pg8::Gemm g{H1b, (const bf16*)(ws + WS_WGU), D / 2, D / 2, D / 2, WSF(WS_SA) + M, slots_max(WSF(WS_AMAX), C.G, C.lane) * (1.0f / 127.0f)}; pg8::StaticOrder S; S.init(M, 2 * FFP, D / 2, D / 2, C.G, cid);
#ifdef DIAG_FFN1_PLAIN
#ifndef DIAG_PLAIN_SHIFT
#define DIAG_PLAIN_SHIFT 0
#endif
                pg8::EpiPlain E{(bf16*)(ws + WS_ACT) + DIAG_PLAIN_SHIFT, 2 * FFP}; pg8::gemm_phase<pg8::EpiPlain, pg8::StaticOrder>(C.lds + RING_OFF, g, S, E, C.wave);
#else
#ifdef DIAG_FFN1_NOALIGN
                pg8::EpiSwiGLU E{(bf16*)(ws + WS_ACT), FFP}; pg8::gemm_phase<pg8::EpiSwiGLU, pg8::StaticOrder, false, true>(C.lds + RING_OFF, g, S, E, C.wave);
#else
                pg8::EpiSwiGLU E{(bf16*)(ws + WS_ACT), ACT_LD}; _Pragma("unroll") for (int rep_ = 0; rep_ < PR_FFN1; ++rep_) pg8::gemm_phase<pg8::EpiSwiGLU, pg8::StaticOrder, true, PG8_SP2_DEFAULT, false, true>(C.lds + RING_OFF, g, S, E, C.wave);
                moe_tail(C, ptab, cid, 128, TB_FFN, TAIL_FFN);
#endif
#ifdef DIAG_FFN1_TWICE
                { pg8::EpiSwiGLU E2{(bf16*)(ws + DIAG_TWIN_OFF), FFP}; pg8::gemm_phase<pg8::EpiSwiGLU, pg8::StaticOrder>(C.lds + RING_OFF, g, S, E2, C.wave); }
#endif
#endif
                SEAM(8);
            }
            if (EN_FFN && EN_FFN2 && IN(9)) { FRESH();
                pg8::Gemm g{(const bf16*)(ws + WS_ACT), (const bf16*)(ws + WS_WD), FFP, FFP, FFP}; pg8::StaticOrder S; S.init(M, D, FFP, FFP, C.G, cid);
                pg8::EpiPlain E{Yb, D}; _Pragma("unroll") for (int rep_ = 0; rep_ < PR_FFN2; ++rep_) pg8::gemm_phase<pg8::EpiPlain, pg8::StaticOrder>(C.lds + RING_OFF, g, S, E, C.wave);
                SEAM(9);
            }
            if (EN_T1 && IN(10)) { FRESH(); const float* mod1 = MOD + 6 * D;
                phase_resid<1, true, true, true>(C, xbf, xbf, Yb, nullptr, D, mod + 5 * D, INF(8) + l * D, INF(5) + D, mod1 + 1 * D, mod1 + 0 * D, H1b, nullptr, nullptr, nullptr, nullptr, nullptr, nullptr, WSF(WS_SA)); SEAM(10); }
        } else {
            int* topi = (int*)(ws + WS_TOPI); float* topg = (float*)(ws + WS_TOPG); int* list = (int*)(ws + WS_LIST);
            bf16* ACTM = (bf16*)(ws + WS_ACTM); bf16* Y2 = (bf16*)(ws + WS_Y2);
            if (EN_T2 && IN(16)) { FRESH(); phase_resid<2, true, true, true>(C, xbf, xbf, Yb, nullptr, D, mod + 2 * D, INF(6) + l * D, INF(7) + l * D, mod + 4 * D, mod + 3 * D, Hb, INF(24), INF(25), topi, topg, list, C.ctl + CW_MOE, WSF(WS_SA) + 2 * M); SEAM(16); }
            if (EN_T2 && IN(17)) { FRESH(); phase_moe_lists(C, list, WSF(WS_SA) + 2 * M, WSF(WS_LSA), WSF(WS_LHS), HID_KAPPA * slots_sum(WSF(WS_AMAX) + 1280, C.G, C.lane) * (1.0f / ((float)W13_SAMPLES * 127.0f))); SEAM(17); }
            if (EN_MOE && IN(18)) { FRESH();
                moe_tab_build(C, list, moetab);
                const int np = moetab[8];
                pg8::Gemm g{Hb, (const bf16*)(ws + WS_W13), D / 2, D / 2, D / 2, WSF(WS_SA) + 2 * M, slots_max(WSF(WS_AMAX) + 256, C.G, C.lane) * (W13_RANGE / 127.0f)};
                MoeOrder S; S.S.init(np * 256, 2 * EFF, D / 2, D / 2, C.G, cid); S.p0 = 0; S.estride = (size_t)2 * EFF * D; S.absA = 1; S.tab = moetab; S.list = list; S.rowbytes = D; S.lsa = WSF(WS_LSA); S.limit = (long)np * 2 * EFF / 256;
                pg8::EpiSwiGLU8 E{(unsigned char*)ACTM, EFF, WSF(WS_LHS), moetab, M}; _Pragma("unroll") for (int rep_ = 0; rep_ < PR_MOE1; ++rep_) pg8::gemm_phase<pg8::EpiSwiGLU8, MoeOrder, true, true, true, true>(C.lds + RING_OFF, g, S, E, C.wave);
                SEAM(19);
            }
            if (EN_MOE && IN(20)) { FRESH();
                moe_tab_build(C, list, moetab);
                const int np = moetab[8]; const long U = (long)np * 4, nfull = (U / C.G) * C.G; const int nleft = (int)(U - nfull);
                const float b2 = slots_max(WSF(WS_AMAX) + 1024, C.G, C.lane) * (W13_RANGE / 127.0f);
                MoeOrder S; S.S.init(np * 256, D, EFF / 2, EFF / 2, C.G, cid); S.p0 = 0; S.estride = (size_t)D * EFF; S.absA = 1; S.tab = moetab; S.list = list; S.rowbytes = 0; S.lsa = WSF(WS_LHS); S.limit = (2 * nleft <= C.G) ? nfull : U;
                { pg8::Gemm g{ACTM, (const bf16*)(ws + WS_W2), EFF / 2, EFF / 2, EFF / 2, nullptr, b2};
                  pg8::EpiMoeDown E{Y2, list, topg, moetab, M}; _Pragma("unroll") for (int rep_ = 0; rep_ < PR_MOE2; ++rep_) pg8::gemm_phase<pg8::EpiMoeDown, MoeOrder, true, PG8_SP2_DEFAULT, false, true, true>(C.lds + RING_OFF, g, S, E, C.wave); }
                if (EN_LEFT && 2 * nleft <= C.G && cid < 2 * nleft) { const int j = cid >> 1, kq = cid & 1; OneUnit O1; O1.S = S; O1.L = nfull + j; {
                    pg8::Gemm g{(const bf16*)((const unsigned char*)ACTM + kq * (EFF / 2)), (const bf16*)(ws + WS_W2 + kq * (EFF / 2)), EFF / 2, EFF / 2, EFF / 4, nullptr, b2};
                    pg8::EpiF32Tile E{(float*)(ws + WS_SP) + (size_t)cid * 256 * 256}; pg8::gemm_phase<pg8::EpiF32Tile, OneUnit, true, PG8_SP2_DEFAULT, false, true, true>(C.lds + RING_OFF, g, O1, E, C.wave); } }
                SEAM(20);
            }
            if (EN_MOE && IN(21)) { FRESH();
                moe_tab_build(C, list, moetab);
                const int np = moetab[8]; const long U = (long)np * 4, nfull = (U / C.G) * C.G; const int nleft = (int)(U - nfull);
                if (2 * nleft <= C.G && nleft > 0) { MoeOrder S; S.S.init(np * 256, D, EFF / 2, EFF / 2, C.G, cid); S.p0 = 0; S.estride = (size_t)D * EFF; S.absA = 1; S.tab = moetab; S.list = list; S.rowbytes = 0; S.limit = nfull;
                    phase_moe_reduce(C, S, nfull, nleft, (const float*)(ws + WS_SP), list, topg, moetab, Y2); }
                SEAM(21);
            }
            if (EN_FIN && IN(22)) { FRESH(); phase_resid<0, true, false>(C, xbf, xres, Y2, Y2 + D, 2 * D, mod + 5 * D, INF(8) + l * D, nullptr, nullptr, nullptr, nullptr, nullptr, nullptr, nullptr, nullptr, nullptr, nullptr); }
        }
    }
#undef IN
#undef SEAM
#undef INF
}
#ifndef MK_DIAG
#define MK_DIAG 0
#endif
extern "C" void kernel_launch(void* const* d_in, const int* in_sizes, int n_in, void* d_out, int out_size, void* d_ws, size_t ws_size, hipStream_t stream) {
    static int grid = 0;
    if (grid == 0) {
        if (n_in != 29 || in_sizes[0] != M * D || out_size != M * D || ws_size < WS_END) { fprintf(stderr, "kernel_launch: unexpected sizes n_in %d in0 %d out %d ws %zu\n", n_in, n_in > 0 ? in_sizes[0] : -1, out_size, ws_size); grid = -1; return; }
        int dev = 0, cus = 0, per_cu = 0;
        if (hipGetDevice(&dev) != hipSuccess || hipDeviceGetAttribute(&cus, hipDeviceAttributeMultiprocessorCount, dev) != hipSuccess) { grid = -1; return; }
        if (hipFuncSetAttribute((const void*)mega_fwd, hipFuncAttributeMaxDynamicSharedMemorySize, LDS_BYTES) != hipSuccess) { fprintf(stderr, "hipFuncSetAttribute failed\n"); grid = -1; return; }
        if (hipOccupancyMaxActiveBlocksPerMultiprocessor(&per_cu, (const void*)mega_fwd, NWAVES * 64, LDS_BYTES) != hipSuccess || per_cu < 1) fprintf(stderr, "occupancy query reports %d\n", per_cu);
        (void)hipGetLastError();
        grid = cus;
    }
    if (grid < 0) return;
    if (hipMemsetAsync((char*)d_ws + WS_CTL, 0, CTL_ZERO_BYTES, stream) != hipSuccess) return;
    Args a{};
    for (int i = 0; i < 29; ++i) a.in[i] = d_in[i];
    a.out = (float*)d_out; a.ws = (unsigned char*)d_ws;
#if MK_DIAG
    diag_run(a, grid, stream);
#else
    a.ph_lo = 0; a.ph_hi = NPHASES;
    hipLaunchKernelGGL(mega_fwd, dim3(grid), dim3(NWAVES * 64), LDS_BYTES, stream, a);
#endif
}
```

```cpp
#include <hip/hip_runtime.h>
#include <hip/hip_bf16.h>
#include <cstdio>
#include <cstdint>
#include <cmath>
__device__ __forceinline__ int xor_idx16() { int i_; asm volatile("v_mbcnt_lo_u32_b32 %0, -1, 0\n\tv_mbcnt_hi_u32_b32 %0, -1, %0\n\tv_xor_b32 %0, 16, %0\n\tv_lshlrev_b32 %0, 2, %0" : "=v"(i_)); return i_; }
__device__ __forceinline__ int xor_idx32() { int i_; asm volatile("v_mbcnt_lo_u32_b32 %0, -1, 0\n\tv_mbcnt_hi_u32_b32 %0, -1, %0\n\tv_xor_b32 %0, 32, %0\n\tv_lshlrev_b32 %0, 2, %0" : "=v"(i_)); return i_; }
__device__ __forceinline__ float bperm_f(int idx, float v) { return __builtin_bit_cast(float, __builtin_amdgcn_ds_bpermute(idx, __builtin_bit_cast(int, v))); }
__device__ __forceinline__ float xsum32(float v) { return v + bperm_f(xor_idx32(), v); }
__device__ __forceinline__ float xmax32(float v) { return fmaxf(v, bperm_f(xor_idx32(), v)); }
#define dpp_f(v, ctrl, rmask, bmask) __builtin_bit_cast(float, __builtin_amdgcn_update_dpp(0, __builtin_bit_cast(int, (float)(v)), (ctrl), (rmask), (bmask), false))
__device__ __forceinline__ unsigned q8x4(float a, float b, float c, float d, float inv) {
    const int qa = __builtin_amdgcn_fmed3f(rintf(a * inv), -127.f, 127.f), qb = __builtin_amdgcn_fmed3f(rintf(b * inv), -127.f, 127.f), qc = __builtin_amdgcn_fmed3f(rintf(c * inv), -127.f, 127.f), qd = __builtin_amdgcn_fmed3f(rintf(d * inv), -127.f, 127.f);
    return (unsigned)(qa & 255) | ((unsigned)(qb & 255) << 8) | ((unsigned)(qc & 255) << 16) | ((unsigned)(qd & 255) << 24); }
__device__ __forceinline__ float wave_max_nn(float v) {
    float s = fmaxf(v, dpp_f(v, 0x111, 0xf, 0xf)); s = fmaxf(s, dpp_f(v, 0x112, 0xf, 0xf)); s = fmaxf(s, dpp_f(v, 0x113, 0xf, 0xf));
    s = fmaxf(s, dpp_f(s, 0x114, 0xf, 0xe)); s = fmaxf(s, dpp_f(s, 0x118, 0xf, 0xc)); s = fmaxf(s, dpp_f(s, 0x142, 0xa, 0xf)); s = fmaxf(s, dpp_f(s, 0x143, 0xc, 0xf));
    return __builtin_bit_cast(float, __builtin_amdgcn_readlane(__builtin_bit_cast(int, s), 63)); }
namespace pg8 {
#define PG8_LAS __attribute__((address_space(3)))
#ifndef PG8_SP2_DEFAULT
#define PG8_SP2_DEFAULT true
#endif
#ifndef PG8_AUX
#define PG8_AUX 0
#endif
typedef unsigned short bf16_t;
typedef short bf16x8 __attribute__((ext_vector_type(8)));
typedef float f32x4 __attribute__((ext_vector_type(4)));
typedef unsigned u32x4 __attribute__((ext_vector_type(4)));
typedef int i32x4 __attribute__((ext_vector_type(4)));
constexpr int BM = 256, BK = 64, HALF = 128, HTB = HALF * BK * 2  , STAGE_BYTES = 8 * HTB, NXCD = 8, WGM = 8;

__host__ __device__ __forceinline__ int lds_byte(int r, int c) { const int st = (r >> 4) * 2 + (c >> 5), rr = r & 15, cc = c & 31, ob = rr * 64 + cc * 2; return st * 1024 + (ob ^ (((ob >> 9) & 1) << 5)); }
__host__ __device__ __forceinline__ void stage_rc(int b, int& R, int& C) { const int st = b / 1024, sb = b % 1024, swz = sb ^ (((sb >> 9) & 1) << 5); R = (st >> 1) * 16 + swz / 64; C = (st & 1) * 32 + (swz % 64) / 2; }
__host__ __device__ __forceinline__ int perm32(int rho) { const int n = rho >> 4, i = rho & 15; return 8 * (i >> 2) + 4 * n + (i & 3); }


struct Unit { int pm, pn, aux; size_t aoff, boff; };
struct Gemm { const bf16_t* A; const bf16_t* Bt; int lda, ldb, K; const float* rowscale; float bscale; };
struct StaticOrder {
    int nM, nN, nwg, G, c; size_t astep, bstep;
    __device__ void init(int M, int N, int lda, int ldb, int G_, int c_) { nM = M / BM; nN = N / BM; nwg = nM * nN; G = G_; c = c_; astep = (size_t)BM * lda * 2; bstep = (size_t)BM * ldb * 2; }
    __device__ bool next(int i, Unit& u) const { return at((long)i * G + c, u); }
    __device__ bool at(long L, Unit& u) const {
        if (L >= nwg) return false;
        int wgid = (int)L; { const int q = nwg / NXCD, r = nwg % NXCD, xcd = wgid % NXCD, off = wgid / NXCD; wgid = (xcd < r ? xcd * (q + 1) : r * (q + 1) + (xcd - r) * q) + off; }
        const int nig = WGM * nN, gid = wgid / nig, fm = gid * WGM, gsz = (nM - fm) < WGM ? (nM - fm) : WGM;
        u.pm = fm + ((wgid % nig) % gsz); u.pn = (wgid % nig) / gsz; u.aux = 0; u.aoff = (size_t)u.pm * astep; u.boff = (size_t)u.pn * bstep; return true;
    }
};

typedef float f32x2cv_t __attribute__((ext_vector_type(2))); typedef __bf16 bf16x2cv_t __attribute__((ext_vector_type(2)));
__device__ __forceinline__ unsigned cvt_pk_bf16(float lo, float hi) { const f32x2cv_t v = {lo, hi}; const bf16x2cv_t b = __builtin_convertvector(v, bf16x2cv_t); return __builtin_bit_cast(unsigned, b); }
typedef float f32x2 __attribute__((ext_vector_type(2)));
__device__ __forceinline__ f32x2 gelu_pk(f32x2 v) {
    const f32x2 av = __builtin_elementwise_abs(v), d = av * 0.2316418882f + 1.0f;
    f32x2 t; t.x = __builtin_amdgcn_rcpf(d.x); t.y = __builtin_amdgcn_rcpf(d.y);
    f32x2 q = t * 0.5307027145f + (-0.7265760135f); q = q * t + 0.7107068705f; q = q * t + (-0.142248368f); q = q * t + 0.127414796f; q = q * t;
    const f32x2 s = (v * v) * (-0.72134752044f);
    f32x2 e; e.x = __builtin_amdgcn_exp2f(s.x); e.y = __builtin_amdgcn_exp2f(s.y);
    const f32x2 m = v * (q * e), r = v - m;
    f32x2 o; o.x = v.x < 0.f ? m.x : r.x; o.y = v.y < 0.f ? m.y : r.y; return o;
}
template <class Epi, class Sched, bool ALIGN_EPI = true, bool SP2 = PG8_SP2_DEFAULT, bool GATHER = false, bool I8 = false, bool PSC = false>
__device__ __forceinline__ void gemm_phase(PG8_LAS unsigned char* lds, const Gemm g, const Sched& S, const Epi& E, const int wave_id) {
    int ln_; asm volatile("v_mbcnt_lo_u32_b32 %0, -1, 0\n\tv_mbcnt_hi_u32_b32 %0, -1, %0" : "=v"(ln_)); const int tid_ = wave_id * 64 + ln_;
    const int tid = tid_, wid = __builtin_amdgcn_readfirstlane(tid >> 6), lane = tid & 63, wr = wid >> 2, wc = wid & 3, fr = lane & 15, fq = lane >> 4;
    const int K = g.K, nt = K / BK;
    unsigned voffA[2], voffB[2];
#pragma unroll
    for (int i = 0; i < 2; ++i) { int R, C; stage_rc(tid * 16 + i * 8192, R, C); const int Rb = Epi::PERM ? ((R & ~31) + perm32(R & 31)) : R;
        voffA[i] = (unsigned)(R * g.lda + C) * 2u; voffB[i] = (unsigned)(Rb * g.ldb + C) * 2u; }
    unsigned vg[2][2] = {{0u, 0u}, {0u, 0u}}, vn[2][2] = {{0u, 0u}, {0u, 0u}}; int gR[2], gC[2];
#pragma unroll
    for (int i = 0; i < 2; ++i) { stage_rc(tid * 16 + i * 8192, gR[i], gC[i]); }
    const size_t kstep = (size_t)(BK * 2);
    const size_t hstepA = (size_t)HALF * g.lda * 2, hstepB = (size_t)HALF * g.ldb * 2;
    const unsigned ldsw = (unsigned)wid * 1024u;
    const int aoff = lds_byte(wr * 64 + fr, fq * 8), boff = lds_byte(wc * 32 + fr, fq * 8);
#define PG8_SA(b, h) (((b) * 2 + (h)) * HTB)
#define PG8_SB(b, h) ((4 + (b) * 2 + (h)) * HTB)
#define PG8_STAGE(bufoff, gbase, voff) do { _Pragma("unroll") for (int _i = 0; _i < 2; ++_i) \
        __builtin_amdgcn_global_load_lds((const unsigned*)((const char*)(gbase) + (voff)[_i]), (PG8_LAS unsigned*)(lds + (bufoff) + ldsw + _i * 8192), 16, 0, PG8_AUX); } while (0)
#define PG8_LDA(dst, b, h) do { _Pragma("unroll") for (int m = 0; m < 4; ++m) _Pragma("unroll") for (int k = 0; k < 2; ++k) dst[m][k] = *(const PG8_LAS bf16x8*)(lds + PG8_SA(b, h) + aoff + m * 2048 + k * 1024); } while (0)
#define PG8_LDB(dst, b, h) do { _Pragma("unroll") for (int n = 0; n < 2; ++n) _Pragma("unroll") for (int k = 0; k < 2; ++k) dst[n][k] = *(const PG8_LAS bf16x8*)(lds + PG8_SB(b, h) + boff + n * 2048 + k * 1024); } while (0)
#define PG8_MMA(ai, bj, At, Bt) do { __builtin_amdgcn_s_setprio(1); _Pragma("unroll") for (int m = 0; m < 4; ++m) _Pragma("unroll") for (int n = 0; n < 2; ++n) _Pragma("unroll") for (int k = 0; k < 2; ++k) \
        { if constexpr (I8) acc[ai][bj][m][n] = __builtin_bit_cast(f32x4, __builtin_amdgcn_mfma_i32_16x16x64_i8(__builtin_bit_cast(i32x4, Bt[n][k]), __builtin_bit_cast(i32x4, At[m][k]), __builtin_bit_cast(i32x4, acc[ai][bj][m][n]), 0, 0, 0)); \
          else acc[ai][bj][m][n] = __builtin_amdgcn_mfma_f32_16x16x32_bf16(Bt[n][k], At[m][k], acc[ai][bj][m][n], 0, 0, 0); } __builtin_amdgcn_s_setprio(0); } while (0)
#define PG8_WAIT_V(n) asm volatile("s_waitcnt vmcnt(" #n ")" ::: "memory")
#define PG8_WAIT_L(n) asm volatile("s_waitcnt lgkmcnt(" #n ")" ::: "memory")
#define PG8_BAR __builtin_amdgcn_s_barrier()
#define PG8_SCHED __builtin_amdgcn_sched_barrier(0)
    static_assert(!GATHER || SP2, "GATHER is written for the SP2 loop");
    Unit cur, nxt; int ui = 0;
    if (!S.next(0, cur)) return;
    f32x4 acc[2][2][4][2];
#pragma unroll
    for (int a = 0; a < 2; ++a)
#pragma unroll
        for (int b = 0; b < 2; ++b)
#pragma unroll
            for (int m = 0; m < 4; ++m)
#pragma unroll
                for (int n = 0; n < 2; ++n) acc[a][b][m][n] = (f32x4){0.f, 0.f, 0.f, 0.f};
    bf16x8 At[4][2], B0[2][2], B1[2][2];
    const char* cA = (const char*)g.A + (GATHER ? (size_t)0 : cur.aoff); const char* cB = (const char*)g.Bt + cur.boff;
    if constexpr (GATHER) S.avoff(cur, gR, gC, vg);
#define PG8_STAGE_A(bufoff, ptr, h, useNext) do { if constexpr (GATHER) { if (useNext) PG8_STAGE(bufoff, ptr, vn[h]); else PG8_STAGE(bufoff, ptr, vg[h]); } else PG8_STAGE(bufoff, (ptr) + (h) * hstepA, voffA); } while (0)
    if constexpr (SP2) {
        PG8_STAGE(PG8_SB(0, 0), cB, voffB); PG8_STAGE(PG8_SB(0, 1), cB + hstepB, voffB); PG8_STAGE_A(PG8_SA(0, 0), cA, 0, false); PG8_STAGE_A(PG8_SA(0, 1), cA, 1, false);
        if (wr == 1) PG8_BAR;
        PG8_WAIT_V(2); PG8_BAR;
        PG8_STAGE(PG8_SB(1, 0), cB + kstep, voffB); PG8_STAGE_A(PG8_SA(1, 0), cA + kstep, 0, false); PG8_STAGE(PG8_SB(1, 1), cB + hstepB + kstep, voffB);
        PG8_WAIT_V(6); PG8_BAR;
    } else {
        PG8_STAGE(PG8_SB(0, 0), cB, voffB); PG8_STAGE(PG8_SA(0, 0), cA, voffA); PG8_STAGE(PG8_SB(0, 1), cB + hstepB, voffB); PG8_STAGE(PG8_SA(0, 1), cA + hstepA, voffA);
        if (wr == 1) PG8_BAR;
        PG8_WAIT_V(4); PG8_BAR;
        PG8_STAGE(PG8_SB(1, 0), cB + kstep, voffB); PG8_STAGE(PG8_SA(1, 0), cA + kstep, voffA); PG8_STAGE(PG8_SB(1, 1), cB + hstepB + kstep, voffB);
        PG8_WAIT_V(6); PG8_BAR;
    }
    for (;;) {
        const bool has_next = S.next(ui + 1, nxt);
        const char* nA = GATHER ? (const char*)g.A : (has_next ? (const char*)g.A + nxt.aoff : cA); const char* nB = has_next ? (const char*)g.Bt + nxt.boff : cB;
        if constexpr (GATHER) { if (has_next && nxt.aux != cur.aux) S.avoff(nxt, gR, gC, vn); else { vn[0][0] = vg[0][0]; vn[0][1] = vg[0][1]; vn[1][0] = vg[1][0]; vn[1][1] = vg[1][1]; } }
        for (int t = 0; t < nt; t += 2) {
            const bool last = (t == nt - 2);
            const char* a1 = cA + (size_t)(t + 1) * kstep;
            const char* a2 = last ? nA : cA + (size_t)(t + 2) * kstep; const char* b2 = last ? nB : cB + (size_t)(t + 2) * kstep;
            const char* a3 = a2 + kstep; const char* b3 = b2 + kstep;
            if constexpr (SP2) {
            PG8_LDB(B0, 0, 0); PG8_LDB(B1, 0, 1); PG8_SCHED; PG8_LDA(At, 0, 0); PG8_STAGE_A(PG8_SA(1, 1), a1, 1, false);
            PG8_WAIT_V(8); PG8_WAIT_L(0); PG8_BAR; PG8_MMA(0, 0, At, B0); PG8_MMA(0, 1, At, B1); PG8_BAR; PG8_SCHED;
            PG8_LDA(At, 0, 1); PG8_STAGE(PG8_SB(0, 0), b2, voffB); PG8_STAGE(PG8_SB(0, 1), b2 + hstepB, voffB); PG8_STAGE_A(PG8_SA(0, 0), a2, 0, last);
            PG8_WAIT_V(8); PG8_WAIT_L(0); PG8_BAR; PG8_MMA(1, 0, At, B0); PG8_MMA(1, 1, At, B1); PG8_BAR; PG8_SCHED;
            PG8_LDB(B0, 1, 0); PG8_LDB(B1, 1, 1); PG8_SCHED; PG8_LDA(At, 1, 0); PG8_STAGE_A(PG8_SA(0, 1), a2, 1, last);
            PG8_WAIT_V(8); PG8_WAIT_L(0); PG8_BAR; PG8_MMA(0, 0, At, B0); PG8_MMA(0, 1, At, B1); PG8_BAR; PG8_SCHED;
            PG8_LDA(At, 1, 1); PG8_STAGE(PG8_SB(1, 0), b3, voffB); PG8_STAGE(PG8_SB(1, 1), b3 + hstepB, voffB); PG8_STAGE_A(PG8_SA(1, 0), a3, 0, last);
            PG8_WAIT_V(8); PG8_WAIT_L(0); PG8_BAR; PG8_MMA(1, 0, At, B0); PG8_MMA(1, 1, At, B1); PG8_BAR; PG8_SCHED;
            } else {
            PG8_LDB(B0, 0, 0); PG8_SCHED; PG8_LDA(At, 0, 0); PG8_STAGE(PG8_SA(1, 1), a1 + hstepA, voffA);
            PG8_WAIT_L(8); PG8_BAR; PG8_WAIT_L(0); PG8_MMA(0, 0, At, B0); PG8_BAR; PG8_SCHED;
            PG8_LDB(B1, 0, 1); PG8_STAGE(PG8_SB(0, 0), b2, voffB);
            PG8_BAR; PG8_WAIT_L(0); PG8_MMA(0, 1, At, B1); PG8_BAR;
            PG8_LDA(At, 0, 1); PG8_STAGE(PG8_SA(0, 0), a2, voffA);
            PG8_BAR; PG8_WAIT_L(0); PG8_MMA(1, 0, At, B0); PG8_BAR; PG8_SCHED;
            PG8_STAGE(PG8_SB(0, 1), b2 + hstepB, voffB);
            PG8_WAIT_V(6); PG8_BAR; PG8_MMA(1, 1, At, B1); PG8_BAR;
            PG8_LDB(B0, 1, 0); PG8_SCHED; PG8_LDA(At, 1, 0); PG8_STAGE(PG8_SA(0, 1), a2 + hstepA, voffA);
            PG8_WAIT_L(8); PG8_BAR; PG8_WAIT_L(0); PG8_MMA(0, 0, At, B0); PG8_BAR; PG8_SCHED;
            PG8_LDB(B1, 1, 1); PG8_STAGE(PG8_SB(1, 0), b3, voffB);
            PG8_BAR; PG8_WAIT_L(0); PG8_MMA(0, 1, At, B1); PG8_BAR;
            PG8_LDA(At, 1, 1); PG8_STAGE(PG8_SA(1, 0), a3, voffA);
            PG8_BAR; PG8_WAIT_L(0); PG8_MMA(1, 0, At, B0); PG8_BAR; PG8_SCHED;
            PG8_STAGE(PG8_SB(1, 1), b3 + hstepB, voffB);
            PG8_WAIT_V(6); PG8_BAR; PG8_MMA(1, 1, At, B1); PG8_BAR;
            }
        }
        if constexpr (ALIGN_EPI) { if (wr == 0) PG8_BAR; }
        int lnE_; asm volatile("v_mbcnt_lo_u32_b32 %0, -1, 0\n\tv_mbcnt_hi_u32_b32 %0, -1, %0" : "=v"(lnE_)); const int frE = lnE_ & 15, fqE = lnE_ >> 4;
        if constexpr (I8) {
            float rsv[2][4];
            if constexpr (GATHER || PSC) {
#pragma unroll
                for (int a = 0; a < 2; ++a)
#pragma unroll
                    for (int m = 0; m < 4; ++m) rsv[a][m] = S.rowscale_of(cur, wr * 64 + frE + a * HALF + m * 16) * g.bscale;
            } else {
#pragma unroll
                for (int a = 0; a < 2; ++a)
#pragma unroll
                    for (int m = 0; m < 4; ++m) rsv[a][m] = g.rowscale[cur.pm * BM + wr * 64 + frE + a * HALF + m * 16] * g.bscale; }
#pragma unroll
            for (int a = 0; a < 2; ++a)
#pragma unroll
                for (int m = 0; m < 4; ++m)
#pragma unroll
                    for (int b = 0; b < 2; ++b)
#pragma unroll
                        for (int n = 0; n < 2; ++n) acc[a][b][m][n] = __builtin_convertvector(__builtin_bit_cast(i32x4, acc[a][b][m][n]), f32x4) * rsv[a][m]; }
        if constexpr (!Epi::AFTER_DRAIN) { E(acc, cur, wr, wc, frE, fqE); }
        if (!has_next) break;
#pragma unroll
        for (int a = 0; a < 2; ++a)
#pragma unroll
            for (int b = 0; b < 2; ++b)
#pragma unroll
                for (int m = 0; m < 4; ++m)
#pragma unroll
                    for (int n = 0; n < 2; ++n) acc[a][b][m][n] = (f32x4){0.f, 0.f, 0.f, 0.f};
        cur = nxt; cA = nA; cB = nB; ++ui;
        if constexpr (GATHER) { vg[0][0] = vn[0][0]; vg[0][1] = vn[0][1]; vg[1][0] = vn[1][0]; vg[1][1] = vn[1][1]; }
        if constexpr (ALIGN_EPI) { if (wr == 1) PG8_BAR; }
    }
    PG8_WAIT_V(0);
    if constexpr (!ALIGN_EPI) { if (wr == 0) PG8_BAR; }
    PG8_BAR;

#undef PG8_SA
#undef PG8_SB
#undef PG8_STAGE
#undef PG8_STAGE_A
#undef PG8_LDA
#undef PG8_LDB
#undef PG8_MMA
#undef PG8_WAIT_V
#undef PG8_WAIT_L
#undef PG8_BAR
#undef PG8_SCHED
}
typedef unsigned u32x4_t __attribute__((ext_vector_type(4)));
__device__ __forceinline__ u32x4_t pack8(const f32x4& v0, const f32x4& v1) { u32x4_t w; w.x = cvt_pk_bf16(v0[0], v0[1]); w.y = cvt_pk_bf16(v0[2], v0[3]); w.z = cvt_pk_bf16(v1[0], v1[1]); w.w = cvt_pk_bf16(v1[2], v1[3]); return w; }
__device__ __forceinline__ float bf_lo(unsigned w) { return __uint_as_float(w << 16); }
__device__ __forceinline__ float bf_hi(unsigned w) { return __uint_as_float(w & 0xffff0000u); }
__device__ __forceinline__ void unpack8(const u32x4_t& w, f32x4& v0, f32x4& v1) { v0 = (f32x4){bf_lo(w.x), bf_hi(w.x), bf_lo(w.y), bf_hi(w.y)}; v1 = (f32x4){bf_lo(w.z), bf_hi(w.z), bf_lo(w.w), bf_hi(w.w)}; }
__device__ __forceinline__ float sigmoidf_(float x) { return __builtin_amdgcn_rcpf(1.0f + __builtin_amdgcn_exp2f(-1.4426950408889634f * x)); }
__device__ __forceinline__ f32x4 gelu4(const f32x4& v) { const f32x2 a = gelu_pk((f32x2){v[0], v[1]}), b = gelu_pk((f32x2){v[2], v[3]}); return (f32x4){a.x, a.y, b.x, b.y}; }
__device__ __forceinline__ f32x4 sig4(const f32x4& v) { return (f32x4){sigmoidf_(v[0]), sigmoidf_(v[1]), sigmoidf_(v[2]), sigmoidf_(v[3])}; }
__device__ __forceinline__ float sum4(const f32x4& v) { return (v[0] + v[1]) + (v[2] + v[3]); }
__device__ __forceinline__ float red_fq(float s) { s += bperm_f(xor_idx16(), s); return xsum32(s); }

struct EpiProj {
    static constexpr bool PERM = true, AFTER_DRAIN = false;
    bf16_t* P; bf16_t* KPE; float* sumv; float* ssqv; float* ssqq; float* ssqkv; const float* cosT; const float* sinT;
    __device__ __forceinline__ void operator()(const f32x4 (&acc)[2][2][4][2], const Unit& u, int wr, int wc, int fr, int fq) const {
        const int row0 = u.pm * BM + wr * 64 + fr, col0 = u.pn * BM + wc * 32 + 8 * fq, pn = u.pn;
#pragma unroll
        for (int ai = 0; ai < 2; ++ai)
#pragma unroll
            for (int m = 0; m < 4; ++m) {
                const int row = row0 + ai * HALF + m * 16; bf16_t* rowp = P + (size_t)row * 3840 + col0;
                if (pn < 4) {
                    float s = 0.f, q = 0.f;
#pragma unroll
                    for (int bj = 0; bj < 2; ++bj) { const f32x4 v0 = gelu4(acc[ai][bj][m][0]), v1 = gelu4(acc[ai][bj][m][1]); *(u32x4_t*)(rowp + bj * HALF) = pack8(v0, v1);
                        s += sum4(v0) + sum4(v1); q += sum4(v0 * v0) + sum4(v1 * v1); }
                    if (pn >= 2) { s = red_fq(s); q = red_fq(q); if (fq == 0) { sumv[row * 8 + (pn - 2) * 4 + wc] = s; ssqv[row * 8 + (pn - 2) * 4 + wc] = q; } }
                } else if (pn < 12) {
#pragma unroll
                    for (int bj = 0; bj < 2; ++bj) *(u32x4_t*)(rowp + bj * HALF) = pack8(sig4(acc[ai][bj][m][0]), sig4(acc[ai][bj][m][1]));
                } else if (pn < 14) {
                    float q = 0.f;
#pragma unroll
                    for (int bj = 0; bj < 2; ++bj) { const f32x4 v0 = acc[ai][bj][m][0], v1 = acc[ai][bj][m][1]; *(u32x4_t*)(rowp + bj * HALF) = pack8(v0, v1); q += sum4(v0 * v0) + sum4(v1 * v1); }
                    q = red_fq(q); if (fq == 0) { if (pn == 12) ssqkv[row * 4 + wc] = q; else ssqq[row * 8 + wc] = q; }
                } else {
                    { const f32x4 v0 = acc[ai][0][m][0], v1 = acc[ai][0][m][1]; *(u32x4_t*)(rowp) = pack8(v0, v1); float q = sum4(v0 * v0) + sum4(v1 * v1); q = red_fq(q); if (fq == 0) ssqq[row * 8 + 4 + wc] = q; }
                    if (wc == 0) { const f32x4 v0 = acc[ai][1][m][0], v1 = acc[ai][1][m][1];
                        const f32x4 cs = *(const f32x4*)(cosT + (size_t)row * 16 + 4 * fq), sn = *(const f32x4*)(sinT + (size_t)row * 16 + 4 * fq);
                        const f32x4 o0 = (f32x4){v0[0] * cs[0] - v0[1] * sn[0], v0[1] * cs[0] + v0[0] * sn[0], v0[2] * cs[1] - v0[3] * sn[1], v0[3] * cs[1] + v0[2] * sn[1]};
                        const f32x4 o1 = (f32x4){v1[0] * cs[2] - v1[1] * sn[2], v1[1] * cs[2] + v1[0] * sn[2], v1[2] * cs[3] - v1[3] * sn[3], v1[3] * cs[3] + v1[2] * sn[3]};
                        *(u32x4_t*)(KPE + (size_t)row * 32 + 8 * fq) = pack8(o0, o1); }
                }
#ifndef DIAG_NOFENCE
                asm volatile("" ::: "memory");
#endif
            }
    }
};
struct EpiQ {
    static constexpr bool PERM = true, AFTER_DRAIN = false;
    bf16_t* Q; const float* ssqq; const float* cosT; const float* sinT; float c2;
    __device__ __forceinline__ void operator()(const f32x4 (&acc)[2][2][4][2], const Unit& u, int wr, int wc, int fr, int fq) const {
        const int row0 = u.pm * BM + wr * 64 + fr, col0 = u.pn * BM + wc * 32 + 8 * fq;
#pragma unroll
        for (int ai = 0; ai < 2; ++ai)
#pragma unroll
            for (int m = 0; m < 4; ++m) {
                const int row = row0 + ai * HALF + m * 16; const f32x4 qa = *(const f32x4*)(ssqq + row * 8), qb = *(const f32x4*)(ssqq + row * 8 + 4);
                const float sc = c2 * __builtin_amdgcn_rsqf((((qa[0] + qa[1]) + (qa[2] + qa[3])) + ((qb[0] + qb[1]) + (qb[2] + qb[3]))) * (1.0f / 384.0f) + 1e-6f);
#pragma unroll
                for (int bj = 0; bj < 2; ++bj) { const int c = col0 + bj * HALF, off = c % 96; f32x4 v0 = acc[ai][bj][m][0] * sc, v1 = acc[ai][bj][m][1] * sc;
                    if (off >= 64) { const int j0 = (off - 64) >> 1; const f32x4 cs = *(const f32x4*)(cosT + (size_t)row * 16 + j0), sn = *(const f32x4*)(sinT + (size_t)row * 16 + j0);
                        const f32x4 o0 = (f32x4){v0[0] * cs[0] - v0[1] * sn[0], v0[1] * cs[0] + v0[0] * sn[0], v0[2] * cs[1] - v0[3] * sn[1], v0[3] * cs[1] + v0[2] * sn[1]};
                        const f32x4 o1 = (f32x4){v1[0] * cs[2] - v1[1] * sn[2], v1[1] * cs[2] + v1[0] * sn[2], v1[2] * cs[3] - v1[3] * sn[3], v1[3] * cs[3] + v1[2] * sn[3]};
                        v0 = o0; v1 = o1; }
                    *(u32x4_t*)(Q + (size_t)row * 768 + c) = pack8(v0, v1); }
                asm volatile("" ::: "memory");
            }
    }
};
struct EpiKV {
    static constexpr bool PERM = true, AFTER_DRAIN = false;
    bf16_t* KN; bf16_t* VV; const float* ssqkv; float* kmaxs;
    __device__ __forceinline__ void operator()(const f32x4 (&acc)[2][2][4][2], const Unit& u, int wr, int wc, int fr, int fq) const {
        const int row0 = u.pm * BM + wr * 64 + fr, col0 = (u.pn & 1) * BM + wc * 32 + 8 * fq; bf16_t* base = (u.pn < 2) ? KN : VV;
        float mx0 = 0.f, mx1 = 0.f;
#pragma unroll
        for (int ai = 0; ai < 2; ++ai)
#pragma unroll
            for (int m = 0; m < 4; ++m) {
                const int row = row0 + ai * HALF + m * 16; const f32x4 qa = *(const f32x4*)(ssqkv + row * 4); const float sc = __builtin_amdgcn_rsqf(((qa[0] + qa[1]) + (qa[2] + qa[3])) * (1.0f / 256.0f) + 1e-6f);
                const f32x4 a0 = acc[ai][0][m][0] * sc, a1 = acc[ai][0][m][1] * sc, b0 = acc[ai][1][m][0] * sc, b1 = acc[ai][1][m][1] * sc;
                *(u32x4_t*)(base + (size_t)row * 512 + col0) = pack8(a0, a1); *(u32x4_t*)(base + (size_t)row * 512 + col0 + HALF) = pack8(b0, b1);
                if (u.pn < 2) { mx0 = fmaxf(mx0, red_fq(sum4(a0 * a0) + sum4(a1 * a1))); mx1 = fmaxf(mx1, red_fq(sum4(b0 * b0) + sum4(b1 * b1))); }
                asm volatile("" ::: "memory");
            }
        if (u.pn < 2) { mx0 = wave_max_nn(mx0); mx1 = wave_max_nn(mx1);
            if ((fr | fq) == 0) { float* kp = kmaxs + ((2 * (4 * u.pn + (wc >> 1)) + (wc & 1)) * 64 + u.pm) * 2 + wr; kp[0] = mx0; kp[4 * 128] = mx1; } }
    }
};
template <int MODE> struct EpiGate {
    static constexpr bool PERM = true, AFTER_DRAIN = false;
    bf16_t* O; const bf16_t* G;
    __device__ __forceinline__ void operator()(const f32x4 (&acc)[2][2][4][2], const Unit& u, int wr, int wc, int fr, int fq) const {
        const int row0 = u.pm * BM + wr * 64 + fr, col0 = u.pn * BM + wc * 32 + 8 * fq;
#pragma unroll
        for (int ai = 0; ai < 2; ++ai)
#pragma unroll
            for (int m = 0; m < 4; ++m) {
                const int row = row0 + ai * HALF + m * 16;
#pragma unroll
                for (int bj = 0; bj < 2; ++bj) { const int c = col0 + bj * HALF; f32x4 g0, g1; unpack8(*(const u32x4_t*)(G + (size_t)row * 3840 + c), g0, g1);
                    f32x4 v0 = acc[ai][bj][m][0] * g0, v1 = acc[ai][bj][m][1] * g1;
                    if (MODE == 1) { f32x4 t0, t1; unpack8(*(const u32x4_t*)(O + (size_t)row * 1024 + c), t0, t1); v0 += t0; v1 += t1; }
                    *(u32x4_t*)(O + (size_t)row * 1024 + c) = pack8(v0, v1); }
                asm volatile("" ::: "memory");
            }
    }
};
struct EpiPlain {
    static constexpr bool PERM = true, AFTER_DRAIN = false;
    bf16_t* O; int ldc;
    __device__ __forceinline__ void operator()(const f32x4 (&acc)[2][2][4][2], const Unit& u, int wr, int wc, int fr, int fq) const {
        const int row0 = u.pm * BM + wr * 64 + fr, col0 = u.pn * BM + wc * 32 + 8 * fq;
#pragma unroll
        for (int ai = 0; ai < 2; ++ai)
#pragma unroll
            for (int m = 0; m < 4; ++m) {
                const int row = row0 + ai * HALF + m * 16;
#pragma unroll
                for (int bj = 0; bj < 2; ++bj) *(u32x4_t*)(O + (size_t)row * ldc + col0 + bj * HALF) = pack8(acc[ai][bj][m][0], acc[ai][bj][m][1]);
            }
    }
};
struct EpiSwiGLU {
    static constexpr bool PERM = true, AFTER_DRAIN = false;
    bf16_t* O; int ldc;
    __device__ __forceinline__ void operator()(const f32x4 (&acc)[2][2][4][2], const Unit& u, int wr, int wc, int fr, int fq) const {
        const int row0 = u.pm * BM + wr * 64 + fr, col0 = u.pn * HALF + wc * 32 + 8 * fq;
#pragma unroll
        for (int ai = 0; ai < 2; ++ai)
#pragma unroll
            for (int m = 0; m < 4; ++m) {
                const int row = row0 + ai * HALF + m * 16;
                const f32x4 g0 = acc[ai][0][m][0], g1 = acc[ai][0][m][1];
#ifdef DIAG_NOSIG
#if DIAG_NOSIG == 2
                const f32x4 v0 = g0, v1 = g1;
#elif DIAG_NOSIG == 3
                const f32x4 v0 = acc[ai][1][m][0], v1 = acc[ai][1][m][1];
#else
                const f32x4 v0 = g0 * acc[ai][1][m][0], v1 = g1 * acc[ai][1][m][1];
#endif
#else
                const f32x4 v0 = g0 * sig4(g0) * acc[ai][1][m][0], v1 = g1 * sig4(g1) * acc[ai][1][m][1];
#endif
#ifdef DIAG_SWIGLU_WIDE
#ifndef DIAG_WIDE_SHIFT
#define DIAG_WIDE_SHIFT 0
#endif
                *(u32x4_t*)(O + (size_t)row * (2 * ldc) + u.pn * BM + DIAG_WIDE_SHIFT + wc * 32 + 8 * fq) = pack8(v0, v1);
#ifndef DIAG_WIDE_8
                *(u32x4_t*)(O + (size_t)row * (2 * ldc) + u.pn * BM + wc * 32 + 8 * fq + HALF) = pack8(acc[ai][1][m][0], acc[ai][1][m][1]);
#endif
#else
                *(u32x4_t*)(O + (size_t)row * ldc + col0) = pack8(v0, v1);
#endif
#ifdef DIAG_STORE_NOP
                asm volatile("s_nop 7\n\ts_nop 7" ::: "memory");
#endif
            }
    }
};
struct EpiSwiGLU8 {
    static constexpr bool PERM = true, AFTER_DRAIN = false;
    unsigned char* O; int ldc; const float* lhs; const __attribute__((address_space(3))) int* tab; int mrows;
    __device__ __forceinline__ void operator()(const f32x4 (&acc)[2][2][4][2], const Unit& u, int wr, int wc, int fr, int fq) const {
        int e = 0;
#pragma unroll
        for (int q = 1; q < 8; ++q) e += (u.aux >= tab[q]) ? 1 : 0;
        e = __builtin_amdgcn_readfirstlane(e);
        const int rl0 = wr * 64 + fr, pos0 = (u.aux - tab[e]) * BM, cnt = tab[16 + e], row0 = u.pm * BM + rl0, col0 = u.pn * HALF + wc * 32 + 8 * fq;
        float inv[2][4];
#pragma unroll
        for (int ai = 0; ai < 2; ++ai)
#pragma unroll
            for (int m = 0; m < 4; ++m) { const int i = pos0 + rl0 + ai * HALF + m * 16; const float sc = (i < cnt) ? lhs[e * mrows + i] : 0.f; inv[ai][m] = sc > 0.f ? __builtin_amdgcn_rcpf(sc) : 0.f; }
#pragma unroll
        for (int ai = 0; ai < 2; ++ai)
#pragma unroll
            for (int m = 0; m < 4; ++m) {
                const int row = row0 + ai * HALF + m * 16; const f32x4 g0 = acc[ai][0][m][0], g1 = acc[ai][0][m][1];
                const f32x4 v0 = g0 * sig4(g0) * acc[ai][1][m][0], v1 = g1 * sig4(g1) * acc[ai][1][m][1]; const float iv = inv[ai][m];
                *(unsigned long long*)(O + (size_t)row * ldc + col0) = (unsigned long long)q8x4(v0[0], v0[1], v0[2], v0[3], iv) | ((unsigned long long)q8x4(v1[0], v1[1], v1[2], v1[3], iv) << 32);
                asm volatile("" ::: "memory");
            }
    }
};
struct EpiMoeDown {
    static constexpr bool PERM = true, AFTER_DRAIN = false;
    bf16_t* Y2; const int* list; const float* topg; const __attribute__((address_space(3))) int* tab; int mrows;
    __device__ __forceinline__ void operator()(const f32x4 (&acc)[2][2][4][2], const Unit& u, int wr, int wc, int fr, int fq) const {
        int e = 0;
#pragma unroll
        for (int q = 1; q < 8; ++q) e += (u.aux >= tab[q]) ? 1 : 0;
        e = __builtin_amdgcn_readfirstlane(e);
        const int base = (u.aux - tab[e]) * BM + wr * 64 + fr, cnt = tab[16 + e], col0 = u.pn * BM + wc * 32 + 8 * fq;
#pragma unroll
        for (int ai = 0; ai < 2; ++ai)
#pragma unroll
            for (int m = 0; m < 4; ++m) {
                const int i = base + ai * HALF + m * 16;
                if (i < cnt) { const int d = list[e * mrows + i]; const float g = topg[d];
#pragma unroll
                    for (int bj = 0; bj < 2; ++bj) *(u32x4_t*)(Y2 + (size_t)d * 1024 + col0 + bj * HALF) = pack8(acc[ai][bj][m][0] * g, acc[ai][bj][m][1] * g); }
                asm volatile("" ::: "memory");
            }
    }
};
struct EpiF32Tile {
    static constexpr bool PERM = true, AFTER_DRAIN = false;
    float* T;
    __device__ __forceinline__ void operator()(const f32x4 (&acc)[2][2][4][2], const Unit& u, int wr, int wc, int fr, int fq) const {
        const int row0 = wr * 64 + fr, col0 = wc * 32 + 8 * fq;
#pragma unroll
        for (int ai = 0; ai < 2; ++ai)
#pragma unroll
            for (int m = 0; m < 4; ++m) { float* rp = T + (size_t)(row0 + ai * HALF + m * 16) * BM + col0;
#pragma unroll
                for (int bj = 0; bj < 2; ++bj) { *(f32x4*)(rp + bj * HALF) = acc[ai][bj][m][0]; *(f32x4*)(rp + bj * HALF + 4) = acc[ai][bj][m][1]; } }
    }
};
struct EpiBf16Tile {
    static constexpr bool PERM = true, AFTER_DRAIN = false;
    bf16_t* T;
    __device__ __forceinline__ void operator()(const f32x4 (&acc)[2][2][4][2], const Unit& u, int wr, int wc, int fr, int fq) const {
        const int row0 = wr * 64 + fr, col0 = wc * 32 + 8 * fq;
#pragma unroll
        for (int ai = 0; ai < 2; ++ai)
#pragma unroll
            for (int m = 0; m < 4; ++m) { bf16_t* rp = T + (size_t)(row0 + ai * HALF + m * 16) * BM + col0;
#pragma unroll
                for (int bj = 0; bj < 2; ++bj) *(u32x4_t*)(rp + bj * HALF) = pack8(acc[ai][bj][m][0], acc[ai][bj][m][1]); }
    }
};
}
namespace attn1 {
using bf16x8 = __attribute__((ext_vector_type(8))) short;
using s16x4 = __attribute__((ext_vector_type(4))) short;
using f32x16 = __attribute__((ext_vector_type(16))) float;
using u32x4 = __attribute__((ext_vector_type(4))) unsigned;
typedef short v4i16_t __attribute__((ext_vector_type(4)));
typedef __attribute__((address_space(3))) unsigned char* lptr;
constexpr int KSLOT = 12288, VSLOT = 8192;
constexpr int L_K = 0, L_V = 2 * KSLOT, L_WS = L_V + 2 * VSLOT, L_OST = L_WS + 8 * 256, L_BYTES = L_OST + 8 * 4096;
__device__ __forceinline__ int crow(int r, int hi) { return (r & 3) + 8 * (r >> 2) + 4 * hi; }
__device__ __forceinline__ unsigned cvtpk(float lo, float hi) { return pg8::cvt_pk_bf16(lo, hi); }
#define ATT_MFMA(a, b, c) __builtin_amdgcn_mfma_f32_32x32x16_bf16(a, b, c, 0, 0, 0)
__device__ __forceinline__ void attn_unit(int h, int qb, const unsigned short* Q, const unsigned short* KN, const unsigned short* KPE, const unsigned short* VV, unsigned short* O, lptr L, const int wave_id) {
    int ln_; asm volatile("v_mbcnt_lo_u32_b32 %0, -1, 0\n\tv_mbcnt_hi_u32_b32 %0, -1, %0" : "=v"(ln_)); const int tid_ = wave_id * 64 + ln_;
    const int tid = tid_, lane = tid & 63, r32 = lane & 31, hi = lane >> 5; const int wid = __builtin_amdgcn_readfirstlane(tid >> 6);
    const int q0 = qb * 256, qrow = q0 + wid * 32 + r32;
    bf16x8 qr[6];
#pragma unroll
    for (int s = 0; s < 6; ++s) qr[s] = *(const bf16x8*)(Q + (size_t)qrow * 768 + h * 96 + s * 16 + hi * 8);
    const int NT = 4 * qb + 4;
    const unsigned short* kn_src = KN + (size_t)lane * 512 + h * 64 + wid * 8;
    const unsigned short* kp_src = KPE + (size_t)lane * 32 + (wid & 3) * 8;
    const unsigned short* v_src = VV + (size_t)(16 * (wid & 3) + (lane >> 2)) * 512 + h * 64 + (wid >> 2) * 32 + (lane & 3) * 8;
    const int kn_dst = L_K + wid * 1024 + lane * 16, kp_dst = L_K + (8 + (wid & 3)) * 1024 + lane * 16, v_dst = L_V + wid * 1024 + lane * 16;
    u32x4 rk = *(const u32x4*)kn_src, rp = *(const u32x4*)kp_src, rv = *(const u32x4*)v_src;
    float mrun = -INFINITY, lrun = 0.f; f32x16 o0 = {}, o1 = {};
    __attribute__((address_space(3))) float* wsf = (__attribute__((address_space(3))) float*)(L + L_WS) + wid * 64;
    const int vrd = ((lane >> 4) & 1) * 32 + (lane & 3) * 8 + (4 * hi + ((lane & 15) >> 2)) * 64;
    for (int t = 0; t < NT; ++t) {
        const int kb = (t & 1) * KSLOT, vb = (t & 1) * VSLOT;
        *(__attribute__((address_space(3))) u32x4*)(L + kb + kn_dst) = rk;
        if (wid < 4) *(__attribute__((address_space(3))) u32x4*)(L + kb + kp_dst) = rp;
        *(__attribute__((address_space(3))) u32x4*)(L + vb + v_dst) = rv;
        __syncthreads();
        if (t + 1 < NT) { const size_t adv = (size_t)(t + 1) * 64; rk = *(const u32x4*)(kn_src + adv * 512); rp = *(const u32x4*)(kp_src + adv * 32); rv = *(const u32x4*)(v_src + adv * 512); }
        if (64 * t > q0 + wid * 32 + 31) continue;
        f32x16 p0 = {}, p1 = {};
#pragma unroll
        for (int s = 0; s < 6; ++s) {
            const bf16x8 k0 = *(const __attribute__((address_space(3))) bf16x8*)(L + kb + L_K + (2 * s + hi) * 1024 + r32 * 16);
            const bf16x8 k1 = *(const __attribute__((address_space(3))) bf16x8*)(L + kb + L_K + (2 * s + hi) * 1024 + 512 + r32 * 16);
            p0 = ATT_MFMA(k0, qr[s], p0); p1 = ATT_MFMA(k1, qr[s], p1);
        }
        if (64 * t + 63 > q0 + wid * 32) {
#pragma unroll
            for (int r = 0; r < 16; ++r) { const int kv = 64 * t + crow(r, hi); if (kv > qrow) p0[r] = -INFINITY; if (kv + 32 > qrow) p1[r] = -INFINITY; }
        }
        float rm = fmaxf(p0[0], p1[0]);
#pragma unroll
        for (int r = 1; r < 16; ++r) rm = fmaxf(rm, fmaxf(p0[r], p1[r]));
        rm = xmax32(rm);
        const float mnew = fmaxf(mrun, rm), alpha = __builtin_amdgcn_exp2f(mrun - mnew);
        float rs = 0.f;
#pragma unroll
        for (int r = 0; r < 16; ++r) { p0[r] = __builtin_amdgcn_exp2f(p0[r] - mnew); p1[r] = __builtin_amdgcn_exp2f(p1[r] - mnew); rs += p0[r] + p1[r]; }
        rs = xsum32(rs);
        lrun = lrun * alpha + rs; mrun = mnew;
        if (hi == 0) wsf[r32] = alpha;
        u32x4 pw0, pw1, pw2, pw3;
        pw0 = (u32x4){cvtpk(p0[0], p0[1]), cvtpk(p0[2], p0[3]), cvtpk(p0[4], p0[5]), cvtpk(p0[6], p0[7])};
        pw1 = (u32x4){cvtpk(p0[8], p0[9]), cvtpk(p0[10], p0[11]), cvtpk(p0[12], p0[13]), cvtpk(p0[14], p0[15])};
        pw2 = (u32x4){cvtpk(p1[0], p1[1]), cvtpk(p1[2], p1[3]), cvtpk(p1[4], p1[5]), cvtpk(p1[6], p1[7])};
        pw3 = (u32x4){cvtpk(p1[8], p1[9]), cvtpk(p1[10], p1[11]), cvtpk(p1[12], p1[13]), cvtpk(p1[14], p1[15])};
        __builtin_amdgcn_fence(__ATOMIC_RELEASE, "wavefront"); __builtin_amdgcn_wave_barrier(); __builtin_amdgcn_fence(__ATOMIC_ACQUIRE, "wavefront");
#pragma unroll
        for (int r = 0; r < 16; ++r) { const float a = wsf[crow(r, hi)]; o0[r] *= a; o1[r] *= a; }
        const bf16x8 pa[4] = {__builtin_bit_cast(bf16x8, pw0), __builtin_bit_cast(bf16x8, pw1), __builtin_bit_cast(bf16x8, pw2), __builtin_bit_cast(bf16x8, pw3)};
#pragma unroll
        for (int ks = 0; ks < 4; ++ks) {
#pragma unroll
            for (int d0 = 0; d0 < 2; ++d0) {
                const s16x4 lo = __builtin_bit_cast(s16x4, __builtin_amdgcn_ds_read_tr16_b64_v4i16((__attribute__((address_space(3))) v4i16_t*)(L + vb + L_V + vrd + d0 * 4096 + ks * 1024)));
                const s16x4 hh = __builtin_bit_cast(s16x4, __builtin_amdgcn_ds_read_tr16_b64_v4i16((__attribute__((address_space(3))) v4i16_t*)(L + vb + L_V + vrd + d0 * 4096 + ks * 1024 + 512)));
                const bf16x8 vf = (bf16x8){lo[0], lo[1], lo[2], lo[3], hh[0], hh[1], hh[2], hh[3]};
                if (d0 == 0) o0 = ATT_MFMA(pa[ks], vf, o0); else o1 = ATT_MFMA(pa[ks], vf, o1);
            }
        }
        __builtin_amdgcn_wave_barrier();
    }
    __syncthreads();
    if (hi == 0) wsf[r32] = 1.0f / lrun;
    __builtin_amdgcn_fence(__ATOMIC_RELEASE, "wavefront"); __builtin_amdgcn_wave_barrier(); __builtin_amdgcn_fence(__ATOMIC_ACQUIRE, "wavefront");
    __attribute__((address_space(3))) unsigned short* stg = (__attribute__((address_space(3))) unsigned short*)(L + L_OST) + wid * 2048;
#pragma unroll
    for (int r = 0; r < 16; ++r) { const int orow = crow(r, hi); const float a = wsf[orow];
        stg[orow * 64 + r32] = (unsigned short)(cvtpk(o0[r] * a, 0.f) & 0xffffu); stg[orow * 64 + 32 + r32] = (unsigned short)(cvtpk(o1[r] * a, 0.f) & 0xffffu); }
    __builtin_amdgcn_fence(__ATOMIC_RELEASE, "wavefront"); __builtin_amdgcn_wave_barrier(); __builtin_amdgcn_fence(__ATOMIC_ACQUIRE, "wavefront");
    unsigned short* Ow = O + (size_t)(q0 + wid * 32) * 512 + h * 64;
#pragma unroll
    for (int i = 0; i < 4; ++i) { const int row = i * 8 + (lane >> 3), ch = lane & 7; const u32x4 v = *(const __attribute__((address_space(3))) u32x4*)(stg + row * 64 + ch * 8); *(u32x4*)(Ow + (size_t)row * 512 + ch * 8) = v; }
    __syncthreads();
}
#undef ATT_MFMA
}
namespace attn3 {
using bf16=__hip_bfloat16;
using bf16x8=__attribute__((ext_vector_type(8)))short;
using s16x4=__attribute__((ext_vector_type(4)))short;
using f32x16=__attribute__((ext_vector_type(16)))float;
using u32x4=__attribute__((ext_vector_type(4)))unsigned;
constexpr int NHEAD=8,D=64,DQK=96,PQ=NHEAD*DQK,PK=NHEAD*D,PR=32;
constexpr int NW=8,QBLK=32,QB=QBLK*NW,KVBLK=64;
__device__ __forceinline__ int crow(int r,int hi){return (r&3)+8*(r>>2)+4*hi;}
#define SBAR() __builtin_amdgcn_sched_barrier(0)
__device__ __forceinline__ void cmask(f32x16&p0,f32x16&p1,int jb,int qrel,int hi){
  const float NEG=-INFINITY; int kb=64*jb+4*hi;
  #pragma unroll
  for(int r=0;r<16;++r){int kv=kb+(r&3)+8*(r>>2); if(kv>qrel)p0[r]=NEG; if(kv+32>qrel)p1[r]=NEG;}
}
__device__ __forceinline__ void cmask1(f32x16&p,int jb,int qrel,int hi,int koff){
  const float NEG=-INFINITY; int kb=64*jb+4*hi+koff;
  #pragma unroll
  for(int r=0;r<16;++r){int kv=kb+(r&3)+8*(r>>2); if(kv>qrel)p[r]=NEG;}
}

constexpr int NSLOT=3, SLOTB=8192, KSLOTB=12288;
#define KOFF(x) (((x)*3)>>1)
constexpr int LDS_K=0, LDS_V=NSLOT*KSLOTB, LDS_WS=LDS_V+NSLOT*SLOTB, LDS_OST=LDS_WS+NW*64*4, LDS_BYTES=LDS_OST+NW*4096;
constexpr float C2=0.10206207261596577f*1.4426950408889634f;
__device__ __forceinline__ void glds16(const void*gsrc,unsigned lds_dst){unsigned keep;
  asm volatile("s_mov_b32 %0, m0\n\ts_mov_b32 m0, %2\n\ts_nop 0\n\tglobal_load_lds_dwordx4 %1, off\n\ts_mov_b32 m0, %0":"=&s"(keep):"v"(gsrc),"s"(lds_dst):"memory");}
__device__ __forceinline__ float max3f(float a,float b,float c){float r;asm("v_max3_f32 %0, %1, %2, %3":"=v"(r):"v"(a),"v"(b),"v"(c));return r;}
__device__ __forceinline__ float max2f(float a,float b){float r;asm("v_max_f32_e32 %0, %1, %2":"=v"(r):"v"(a),"v"(b));return r;}
__device__ __forceinline__ float fadd_s(float a,float b){float r;asm("v_add_f32_e32 %0, %1, %2":"=v"(r):"v"(a),"v"(b));return r;}
__device__ __forceinline__ float fsub_s(float a,float b){float r;asm("v_sub_f32_e32 %0, %1, %2":"=v"(r):"v"(a),"v"(b));return r;}
typedef float f32x2_t __attribute__((ext_vector_type(2))); typedef __bf16 bf16x2_t __attribute__((ext_vector_type(2)));
__device__ __forceinline__ unsigned cvtpk_s(float lo,float hi){f32x2_t v={lo,hi};bf16x2_t b=__builtin_convertvector(v,bf16x2_t);return __builtin_bit_cast(unsigned,b);}
#define WAIT_BAR(N) asm volatile("s_waitcnt vmcnt(" #N ") lgkmcnt(0)\n\ts_barrier":::"memory")
#define WB(A,B) do{ if(wid<4){WAIT_BAR(A);}else{WAIT_BAR(B);} }while(0)

__device__ __forceinline__ void qkt(f32x16&p0,f32x16&p1,const char*Kslot,const bf16x8*qr,const f32x16&negm,int r32,int hi){
  const char*kb=Kslot+hi*1024+r32*16;
  #pragma unroll
  for(int d0=0;d0<6;++d0){
    const bf16x8 b0=*reinterpret_cast<const bf16x8*>(kb+d0*2048);
    const bf16x8 b1=*reinterpret_cast<const bf16x8*>(kb+d0*2048+512);
    if(d0==0){p0=__builtin_amdgcn_mfma_f32_32x32x16_bf16(b0,qr[0],negm,0,0,0);p1=__builtin_amdgcn_mfma_f32_32x32x16_bf16(b1,qr[0],negm,0,0,0);}
    else{p0=__builtin_amdgcn_mfma_f32_32x32x16_bf16(b0,qr[d0],p0,0,0,0);p1=__builtin_amdgcn_mfma_f32_32x32x16_bf16(b1,qr[d0],p1,0,0,0);}}
}
typedef __attribute__((address_space(3))) const char* lds_cptr;
typedef short v4i16_t __attribute__((ext_vector_type(4)));
__device__ __forceinline__ void kload8(bf16x8*kf,lds_cptr kp){
  kf[0]=*(const __attribute__((address_space(3))) bf16x8*)(kp);      kf[1]=*(const __attribute__((address_space(3))) bf16x8*)(kp+512);
  kf[2]=*(const __attribute__((address_space(3))) bf16x8*)(kp+2048); kf[3]=*(const __attribute__((address_space(3))) bf16x8*)(kp+2560);
  kf[4]=*(const __attribute__((address_space(3))) bf16x8*)(kp+4096); kf[5]=*(const __attribute__((address_space(3))) bf16x8*)(kp+4608);
  kf[6]=*(const __attribute__((address_space(3))) bf16x8*)(kp+6144); kf[7]=*(const __attribute__((address_space(3))) bf16x8*)(kp+6656);
  kf[8]=*(const __attribute__((address_space(3))) bf16x8*)(kp+8192); kf[9]=*(const __attribute__((address_space(3))) bf16x8*)(kp+8704);
  kf[10]=*(const __attribute__((address_space(3))) bf16x8*)(kp+10240); kf[11]=*(const __attribute__((address_space(3))) bf16x8*)(kp+10752);
}
__device__ __forceinline__ void kload2(bf16x8*kf,lds_cptr kp,int j){ kf[2*j]=*(const __attribute__((address_space(3))) bf16x8*)(kp+j*2048); kf[2*j+1]=*(const __attribute__((address_space(3))) bf16x8*)(kp+j*2048+512); }
__device__ __forceinline__ s16x4 vtr(lds_cptr p){ return __builtin_bit_cast(s16x4,__builtin_amdgcn_ds_read_tr16_b64_v4i16((__attribute__((address_space(3))) v4i16_t*)p)); }
__device__ __forceinline__ float rowmax(const f32x16&p0,const f32x16&p1){
  float a=max3f(p0[0],p0[1],p1[0]),b=max3f(p0[2],p0[3],p1[1]);a=max3f(a,p1[2],p1[3]);
  #pragma unroll
  for(int r=4;r<16;r+=4){a=max3f(a,p0[r],p0[r+1]);b=max3f(b,p0[r+2],p0[r+3]);a=max3f(a,p1[r],p1[r+1]);b=max3f(b,p1[r+2],p1[r+3]);}
  const float m=max2f(a,b);
  return xmax32(m);
}
__device__ __forceinline__ void pv(f32x16*o,int vb,bf16x8 pa0,bf16x8 pa1,bf16x8 pa2,bf16x8 pa3){
  #pragma unroll
  for(int d0=0;d0<2;++d0){s16x4 lo[4],hi[4];
    #pragma unroll
    for(int ks=0;ks<4;++ks){
      asm volatile("ds_read_b64_tr_b16 %0,%1 offset:%c2":"=&v"(lo[ks]):"v"(vb),"i"(d0*4096+ks*1024):"memory");
      asm volatile("ds_read_b64_tr_b16 %0,%1 offset:%c2":"=&v"(hi[ks]):"v"(vb),"i"(d0*4096+ks*1024+512):"memory");}
    asm volatile("s_waitcnt lgkmcnt(0)":::"memory");SBAR();
    #define PK(k) (bf16x8){lo[k][0],lo[k][1],lo[k][2],lo[k][3],hi[k][0],hi[k][1],hi[k][2],hi[k][3]}
    o[d0]=__builtin_amdgcn_mfma_f32_32x32x16_bf16(pa0,PK(0),o[d0],0,0,0);
    o[d0]=__builtin_amdgcn_mfma_f32_32x32x16_bf16(pa1,PK(1),o[d0],0,0,0);
    o[d0]=__builtin_amdgcn_mfma_f32_32x32x16_bf16(pa2,PK(2),o[d0],0,0,0);
    o[d0]=__builtin_amdgcn_mfma_f32_32x32x16_bf16(pa3,PK(3),o[d0],0,0,0);
    #undef PK
  }
}

#ifndef ATTN_STORE16
#define ATTN_STORE16(p,v) (*(u32x4*)(p)=(v))
#endif
template<int THRL,bool FAST> __device__ __forceinline__ void attn_unit(int h,int qb,const bf16*Q,const bf16*__restrict__ K,const bf16*__restrict__ KP,const bf16*__restrict__ V,bf16*O,char*shm,const int wave_id){
  int ln_; asm volatile("v_mbcnt_lo_u32_b32 %0, -1, 0\n\tv_mbcnt_hi_u32_b32 %0, -1, %0" : "=v"(ln_));
  const int lane=ln_,r32=lane&31,hi=lane>>5; const int wid=wave_id;
  const int q0=qb*QB;
  const bf16*Qw=Q+(long)(q0+wid*QBLK)*PQ+h*DQK;
  const bf16*Kh=K+h*D,*Vh=V+h*D;
  const unsigned lds0=(unsigned)(uintptr_t)shm;
  float*wsf=(float*)(shm+LDS_WS)+wid*64;
  const bf16*ksrc=Kh+(long)lane*PK+wid*8; const bf16*kpsrc=KP+(long)lane*PR+(wid&3)*8;
  const bf16*vsrc=Vh+(long)(16*(wid&3)+(lane>>2))*PK+(wid>>2)*32+(lane&3)*8;
  const unsigned kdst=lds0+LDS_K+wid*1024, kpdst=lds0+LDS_K+(8+(wid&3))*1024, vdst=lds0+LDS_V+wid*1024;
  #define DMA_K(t,slot) do{ glds16(ksrc+(long)(t)*KVBLK*PK,(unsigned)__builtin_amdgcn_readfirstlane(kdst+KOFF(slot))); if(wid<4) glds16(kpsrc+(long)(t)*KVBLK*PR,(unsigned)__builtin_amdgcn_readfirstlane(kpdst+KOFF(slot))); }while(0)
  #define DMA_V(t,slot) glds16(vsrc+(long)(t)*KVBLK*PK,(unsigned)__builtin_amdgcn_readfirstlane(vdst+(slot)))
  const int vb0=(int)(lds0+LDS_V)+((lane>>4)&1)*32+(lane&3)*8+(4*hi+((lane&15)>>2))*64;
  const char*Kbase=shm+LDS_K; bf16x8 kf[12];
  const lds_cptr shm3=(lds_cptr)shm; const lds_cptr kp0=shm3+LDS_K+hi*1024+r32*16; const lds_cptr vp0=shm3+LDS_V+((lane>>4)&1)*32+(lane&3)*8+(4*hi+((lane&15)>>2))*64;
  const int NT=(q0+QB)/KVBLK;
  DMA_K(0,0);DMA_V(0,0);DMA_K(1,SLOTB);
  bf16x8 qr[6];
  #pragma unroll
  for(int d0=0;d0<6;++d0)qr[d0]=*reinterpret_cast<const bf16x8*>(&Qw[(long)r32*PQ+d0*16+hi*8]);
  float mhat=0.f,l_reg=0.f;f32x16 o[2];o[0]=f32x16{};o[1]=f32x16{};const f32x16 negm=f32x16{};
  const int qrel=wid*QBLK+r32;
  #define CMASK(P0,P1,t) do{int jb_=(t)-(NT-4); if(jb_>=0)cmask(P0,P1,jb_,qrel,hi);}while(0)
  #define CMASKH(P,t,ko) do{int jb_=(t)-(NT-4); if(jb_>=0)cmask1(P,jb_,qrel,hi,ko);}while(0)
  bool resc=false;
  #define START(P0,P1) do{ resc=false; if(!FAST){ const float rm=rowmax(P0,P1); \
    { const float dl=rm; mhat=fadd_s(mhat,dl); \
      _Pragma("unroll") for(int r=0;r<16;++r){P0[r]=fsub_s(P0[r],dl);P1[r]=fsub_s(P1[r],dl);} \
      } } \
    _Pragma("unroll") for(int r=0;r<16;++r)P0[r]=__builtin_amdgcn_exp2f(P0[r]); }while(0)
  #define RESC() do{ if(!FAST&&resc){ asm volatile("s_waitcnt lgkmcnt(0)":::"memory"); \
      _Pragma("unroll") for(int d_=0;d_<2;++d_) _Pragma("unroll") for(int r=0;r<16;++r)o[d_][r]*=wsf[crow(r,hi)]; } }while(0)
  f32x16 pA0,pA1,pB0,pB1;
  int sl_prev=0,sl_cur=0,sl_next=SLOTB;
  #define ROT() do{sl_prev=sl_cur;sl_cur=sl_next;sl_next=(sl_next==(NSLOT-1)*SLOTB)?0:sl_next+SLOTB;}while(0)
  DMA_K(2,2*SLOTB);
  WB(5,3);
  qkt(pA0,pA1,Kbase,qr,negm,r32,hi);asm volatile("s_nop 15\n\ts_nop 7":"+v"(pA0),"+v"(pA1));CMASK(pA0,pA1,0);
  START(pA0,pA1);
  _Pragma("unroll") for(int r=0;r<16;++r)pA1[r]=__builtin_amdgcn_exp2f(pA1[r]);
  WAIT_BAR(0);
  DMA_K(3,0);DMA_V(1,SLOTB);
  ROT();
  kload8(kf,kp0+KOFF(sl_cur));
  WB(3,2);
  s16x4 vlo[2],vhi[2]; u32x4 pw0,pw1,pw2,pw3;
  #define PKW(P,B) cvtpk_s(P[B],P[B+1])
  #define PAF(k) __builtin_bit_cast(bf16x8,pw##k)
  #define VFR(i) (bf16x8){vlo[(i)&1][0],vlo[(i)&1][1],vlo[(i)&1][2],vlo[(i)&1][3],vhi[(i)&1][0],vhi[(i)&1][1],vhi[(i)&1][2],vhi[(i)&1][3]}
  #define PIN(x) asm volatile("":"+v"(x))
  #define MX3(a,b,c) __builtin_fmaxf(__builtin_fmaxf((a),(b)),(c))
  #define GAPA(MF,A0,A1,A2,A3,W0,W1,PW) do{ MF; sacc+=A0; sacc+=A1; sacc+=A2; sacc+=A3; PIN(sacc); W0; W1; PIN(PW); SBAR(); }while(0)
  #define EX(v) __builtin_amdgcn_exp2f(v)
  #define GAPB(MF,X,B) do{ MF; X[B]=EX(X[B]); X[B+1]=EX(X[B+1]); X[B+2]=EX(X[B+2]); X[B+3]=EX(X[B+3]); PIN(X); SBAR(); }while(0)
  #define VRD(i) do{}while(0)
  #define VFS(sl) (bf16x8){vlo[sl][0],vlo[sl][1],vlo[sl][2],vlo[sl][3],vhi[sl][0],vhi[sl][1],vhi[sl][2],vhi[sl][3]}
  #define VRDS(sl,i) do{ vlo[sl]=vtr(vp_+(((i)>>2)*4096+((i)&3)*1024)); vhi[sl]=vtr(vp_+(((i)>>2)*4096+((i)&3)*1024+512)); SBAR(); }while(0)
  #define KRD(G,j) do{ if(G){ kload2(kf,kp0+KOFF(sl_next),j); SBAR(); } }while(0)
  #define STEP(C0,C1,P0,P1,t,GK,GV,GL) do{ SBAR(); \
    const lds_cptr vp_=vp0+sl_prev; \
    VRD(0); SBAR(); float sacc=(P0[0]+P0[1]); \
    GAPA(C0=__builtin_amdgcn_mfma_f32_32x32x16_bf16(kf[0],qr[0],negm,0,0,0), P0[2],P0[3],P0[4],P0[5],     pw0[0]=PKW(P0,0), pw0[1]=PKW(P0,2), pw0); \
    VRD(4); SBAR(); GAPA(C1=__builtin_amdgcn_mfma_f32_32x32x16_bf16(kf[1],qr[0],negm,0,0,0), P0[6],P0[7],P0[8],P0[9],     pw0[2]=PKW(P0,4), pw0[3]=PKW(P0,6), pw0); \
    VRD(1); SBAR(); GAPA(C0=__builtin_amdgcn_mfma_f32_32x32x16_bf16(kf[2],qr[1],C0,0,0,0),   P0[10],P0[11],P0[12],P0[13], pw1[0]=PKW(P0,8), pw1[1]=PKW(P0,10), pw1); \
    VRD(5); SBAR(); GAPA(C1=__builtin_amdgcn_mfma_f32_32x32x16_bf16(kf[3],qr[1],C1,0,0,0),   P0[14],P0[15],P1[0],P1[1],   pw1[2]=PKW(P0,12),pw1[3]=PKW(P0,14), pw1); \
    VRD(2); SBAR(); GAPA(C0=__builtin_amdgcn_mfma_f32_32x32x16_bf16(kf[4],qr[2],C0,0,0,0),   P1[2],P1[3],P1[4],P1[5],     pw2[0]=PKW(P1,0), pw2[1]=PKW(P1,2), pw2); \
    VRD(6); SBAR(); GAPA(C1=__builtin_amdgcn_mfma_f32_32x32x16_bf16(kf[5],qr[2],C1,0,0,0),   P1[6],P1[7],P1[8],P1[9],     pw2[2]=PKW(P1,4), pw2[3]=PKW(P1,6), pw2); \
    VRD(3); SBAR(); GAPA(C0=__builtin_amdgcn_mfma_f32_32x32x16_bf16(kf[6],qr[3],C0,0,0,0),   P1[10],P1[11],P1[12],P1[13], pw3[0]=PKW(P1,8), pw3[1]=PKW(P1,10), pw3); \
    VRD(7); SBAR(); GAPA(C1=__builtin_amdgcn_mfma_f32_32x32x16_bf16(kf[7],qr[3],C1,0,0,0),   P1[14],P1[15],0.f,0.f,       pw3[2]=PKW(P1,12),pw3[3]=PKW(P1,14), pw3); \
    C0=__builtin_amdgcn_mfma_f32_32x32x16_bf16(kf[8],qr[4],C0,0,0,0); SBAR(); C1=__builtin_amdgcn_mfma_f32_32x32x16_bf16(kf[9],qr[4],C1,0,0,0); SBAR(); \
    C0=__builtin_amdgcn_mfma_f32_32x32x16_bf16(kf[10],qr[5],C0,0,0,0); SBAR(); C1=__builtin_amdgcn_mfma_f32_32x32x16_bf16(kf[11],qr[5],C1,0,0,0); SBAR(); \
    l_reg+=sacc; \
    if(GK){DMA_K((t)+3,sl_cur);} if(GV){DMA_V((t)+1,sl_next);} \
    if(!FAST){ _Pragma("unroll") for(int r=0;r<16;++r){C0[r]-=mhat;C1[r]-=mhat;} } \
    CMASK(C0,C1,t); \
    if(!FAST){ float a=MX3(C0[0],C0[1],C1[0]),b=MX3(C0[2],C0[3],C1[1]); a=MX3(a,C1[2],C1[3]); \
      _Pragma("unroll") for(int r=4;r<16;r+=4){a=MX3(a,C0[r],C0[r+1]);b=MX3(b,C0[r+2],C0[r+3]);a=MX3(a,C1[r],C1[r+1]);b=MX3(b,C1[r+2],C1[r+3]);} \
      float rm=xmax32(__builtin_fmaxf(a,b)); \
      resc=false; \
      if(__builtin_expect(__any(rm>(float)THRL),0)){ const float dl=__builtin_fmaxf(rm,0.f); mhat+=dl; \
        _Pragma("unroll") for(int r=0;r<16;++r){C0[r]-=dl;C1[r]-=dl;} \
        const float f=__builtin_amdgcn_exp2f(-dl); l_reg*=f; if(hi==0)wsf[r32]=f; resc=true; } } \
    SBAR(); \
    VRDS(0,0); \
    VRDS(1,4); KRD(GL,4); GAPB(o[0]=__builtin_amdgcn_mfma_f32_32x32x16_bf16(PAF(0),VFS(0),o[0],0,0,0), C0,0); \
    VRDS(0,1); KRD(GL,5); GAPB(o[1]=__builtin_amdgcn_mfma_f32_32x32x16_bf16(PAF(0),VFS(1),o[1],0,0,0), C0,4); \
    VRDS(1,5); KRD(GL,0); GAPB(o[0]=__builtin_amdgcn_mfma_f32_32x32x16_bf16(PAF(1),VFS(0),o[0],0,0,0), C0,8); \
    VRDS(0,2); KRD(GL,1); GAPB(o[1]=__builtin_amdgcn_mfma_f32_32x32x16_bf16(PAF(1),VFS(1),o[1],0,0,0), C0,12); \
    VRDS(1,6); KRD(GL,2); GAPB(o[0]=__builtin_amdgcn_mfma_f32_32x32x16_bf16(PAF(2),VFS(0),o[0],0,0,0), C1,0); \
    VRDS(0,3); KRD(GL,3); GAPB(o[1]=__builtin_amdgcn_mfma_f32_32x32x16_bf16(PAF(2),VFS(1),o[1],0,0,0), C1,4); \
    VRDS(1,7); GAPB(o[0]=__builtin_amdgcn_mfma_f32_32x32x16_bf16(PAF(3),VFS(0),o[0],0,0,0), C1,8); \
    GAPB(o[1]=__builtin_amdgcn_mfma_f32_32x32x16_bf16(PAF(3),VFS(1),o[1],0,0,0), C1,12); \
    }while(0)
  #define GAPB2(MF,X,B) do{ MF; X[B]=EX(X[B]); X[B+1]=EX(X[B+1]); PIN(X); SBAR(); }while(0)
  #define STEPF(C0,C1,P0,P1,t,GK,GV,GL) do{ SBAR(); \
    const lds_cptr vp_=vp0+sl_prev; \
    float sacc=(P0[0]+P0[1]); \
    GAPA(C0=__builtin_amdgcn_mfma_f32_32x32x16_bf16(kf[0],qr[0],negm,0,0,0),  P0[2],P0[3],P0[4],P0[5],     pw0[0]=PKW(P0,0), pw0[1]=PKW(P0,2), pw0); \
    GAPA(C0=__builtin_amdgcn_mfma_f32_32x32x16_bf16(kf[2],qr[1],C0,0,0,0),    P0[6],P0[7],P0[8],P0[9],     pw0[2]=PKW(P0,4), pw0[3]=PKW(P0,6), pw0); \
    GAPA(C0=__builtin_amdgcn_mfma_f32_32x32x16_bf16(kf[4],qr[2],C0,0,0,0),    P0[10],P0[11],P0[12],P0[13], pw1[0]=PKW(P0,8), pw1[1]=PKW(P0,10), pw1); \
    GAPA(C0=__builtin_amdgcn_mfma_f32_32x32x16_bf16(kf[6],qr[3],C0,0,0,0),    P0[14],P0[15],P1[0],P1[1],   pw1[2]=PKW(P0,12),pw1[3]=PKW(P0,14), pw1); \
    GAPA(C0=__builtin_amdgcn_mfma_f32_32x32x16_bf16(kf[8],qr[4],C0,0,0,0),    P1[2],P1[3],P1[4],P1[5],     pw2[0]=PKW(P1,0), pw2[1]=PKW(P1,2), pw2); \
    GAPA(C0=__builtin_amdgcn_mfma_f32_32x32x16_bf16(kf[10],qr[5],C0,0,0,0),   P1[6],P1[7],P1[8],P1[9],     pw2[2]=PKW(P1,4), pw2[3]=PKW(P1,6), pw2); \
    GAPA(C1=__builtin_amdgcn_mfma_f32_32x32x16_bf16(kf[1],qr[0],negm,0,0,0),  P1[10],P1[11],P1[12],P1[13], pw3[0]=PKW(P1,8), pw3[1]=PKW(P1,10), pw3); \
    GAPA(C1=__builtin_amdgcn_mfma_f32_32x32x16_bf16(kf[3],qr[1],C1,0,0,0),    P1[14],P1[15],0.f,0.f,       pw3[2]=PKW(P1,12),pw3[3]=PKW(P1,14), pw3); \
    l_reg+=sacc; \
    CMASKH(C0,t,0); \
    GAPB(C1=__builtin_amdgcn_mfma_f32_32x32x16_bf16(kf[5],qr[2],C1,0,0,0), C0,0); \
    GAPB(C1=__builtin_amdgcn_mfma_f32_32x32x16_bf16(kf[7],qr[3],C1,0,0,0), C0,4); \
    GAPB(C1=__builtin_amdgcn_mfma_f32_32x32x16_bf16(kf[9],qr[4],C1,0,0,0), C0,8); \
    GAPB(C1=__builtin_amdgcn_mfma_f32_32x32x16_bf16(kf[11],qr[5],C1,0,0,0), C0,12); \
    if(GK){DMA_K((t)+3,sl_cur);} if(GV){DMA_V((t)+1,sl_next);} \
    CMASKH(C1,t,32); \
    SBAR(); \
    VRDS(0,0); \
    VRDS(1,4); KRD(GL,4); GAPB2(o[0]=__builtin_amdgcn_mfma_f32_32x32x16_bf16(PAF(0),VFS(0),o[0],0,0,0), C1,0); \
    VRDS(0,1); KRD(GL,5); GAPB2(o[1]=__builtin_amdgcn_mfma_f32_32x32x16_bf16(PAF(0),VFS(1),o[1],0,0,0), C1,2); \
    VRDS(1,5); KRD(GL,0); GAPB2(o[0]=__builtin_amdgcn_mfma_f32_32x32x16_bf16(PAF(1),VFS(0),o[0],0,0,0), C1,4); \
    VRDS(0,2); KRD(GL,1); GAPB2(o[1]=__builtin_amdgcn_mfma_f32_32x32x16_bf16(PAF(1),VFS(1),o[1],0,0,0), C1,6); \
    VRDS(1,6); KRD(GL,2); GAPB2(o[0]=__builtin_amdgcn_mfma_f32_32x32x16_bf16(PAF(2),VFS(0),o[0],0,0,0), C1,8); \
    VRDS(0,3); KRD(GL,3); GAPB2(o[1]=__builtin_amdgcn_mfma_f32_32x32x16_bf16(PAF(2),VFS(1),o[1],0,0,0), C1,10); \
    VRDS(1,7); GAPB2(o[0]=__builtin_amdgcn_mfma_f32_32x32x16_bf16(PAF(3),VFS(0),o[0],0,0,0), C1,12); \
    GAPB2(o[1]=__builtin_amdgcn_mfma_f32_32x32x16_bf16(PAF(3),VFS(1),o[1],0,0,0), C1,14); \
    }while(0)
  #define STEPX(C0,C1,P0,P1,t,GK,GV,GL) do{ if(FAST) STEPF(C0,C1,P0,P1,t,GK,GV,GL); else STEP(C0,C1,P0,P1,t,GK,GV,GL); }while(0)
  int t=1;
  #undef CMASK
  #undef CMASKH
  #define CMASK(P0,P1,t) do{}while(0)
  #define CMASKH(P,t,ko) do{}while(0)
  for(;t+5<NT;t+=2){
    STEPX(pB0,pB1,pA0,pA1,t,true,true,true);     WB(3,2); RESC(); ROT();
    STEPX(pA0,pA1,pB0,pB1,t+1,true,true,true);   WB(3,2); RESC(); ROT();
  }
  #undef CMASK
  #undef CMASKH
  #define CMASK(P0,P1,t) do{int jb_=(t)-(NT-4); if(jb_>=0)cmask(P0,P1,jb_,qrel,hi);}while(0)
  #define CMASKH(P,t,ko) do{int jb_=(t)-(NT-4); if(jb_>=0)cmask1(P,jb_,qrel,hi,ko);}while(0)
  #define ENDW(tt) do{ if((tt)+3<NT){WB(3,2);} else if((tt)+2<NT){WAIT_BAR(1);} else {WAIT_BAR(0);} }while(0)
  for(;t+1<NT;t+=2){
    STEPX(pB0,pB1,pA0,pA1,t,(t+3<NT),(t+1<NT),(t+1<NT));       ENDW(t);   RESC(); ROT();
    STEPX(pA0,pA1,pB0,pB1,t+1,(t+4<NT),(t+2<NT),(t+2<NT));     ENDW(t+1); RESC(); ROT();
  }
  STEPX(pB0,pB1,pA0,pA1,NT-1,false,false,false); RESC();
  { float sacc=pB0[0]+pB0[1]; _Pragma("unroll") for(int r=2;r<16;++r)sacc+=pB0[r]; _Pragma("unroll") for(int r=0;r<16;++r)sacc+=pB1[r]; l_reg+=sacc;
    pw0=(u32x4){PKW(pB0,0),PKW(pB0,2),PKW(pB0,4),PKW(pB0,6)};pw1=(u32x4){PKW(pB0,8),PKW(pB0,10),PKW(pB0,12),PKW(pB0,14)};pw2=(u32x4){PKW(pB1,0),PKW(pB1,2),PKW(pB1,4),PKW(pB1,6)};pw3=(u32x4){PKW(pB1,8),PKW(pB1,10),PKW(pB1,12),PKW(pB1,14)};
    SBAR(); pv(o,vb0+sl_cur,PAF(0),PAF(1),PAF(2),PAF(3)); }
  #undef PKW
  #undef PAF
  #undef VFR
  #undef PIN
  #undef MX3
  #undef GAPA
  #undef GAPB
  #undef EX
  #undef VRD
  #undef VRDS
  #undef VFS
  #undef KRD
  #undef STEP
  #undef STEPF
  #undef STEPX
  #undef GAPB2
  #undef ENDW
  l_reg=xsum32(l_reg);
  if(hi==0)wsf[32+r32]=l_reg;asm volatile("s_waitcnt lgkmcnt(0)":::"memory");
  float rli[16];
  #pragma unroll
  for(int r=0;r<16;++r)rli[r]=__builtin_amdgcn_rcpf(wsf[32+crow(r,hi)]);
  bf16*Ow=O+(long)(q0+wid*QBLK)*PK+h*D;
  { bf16*stg=(bf16*)(shm+LDS_OST)+wid*2048;
    #pragma unroll
    for(int r=0;r<16;++r){const int orow=crow(r,hi);
      #pragma unroll
      for(int d0=0;d0<2;++d0)stg[orow*64+d0*32+r32]=__float2bfloat16(o[d0][r]*rli[r]);}
    asm volatile("s_waitcnt lgkmcnt(0)":::"memory");
    #pragma unroll
    for(int i=0;i<4;++i){const int row=i*8+(lane>>3),ch=lane&7; const u32x4 v=*(const u32x4*)(stg+row*64+ch*8); ATTN_STORE16(Ow+(long)row*PK+ch*8,v);} }
  asm volatile("s_waitcnt lgkmcnt(0)\n\ts_barrier":::"memory");
  #undef DMA_K
  #undef DMA_V
  #undef CMASK
  #undef CMASKH
  #undef START
  #undef RESC
  #undef ROT
}
__device__ __forceinline__ float qnorm2_max(int h,int qb,const bf16*Q,const int wave_id){
  int ln_; asm volatile("v_mbcnt_lo_u32_b32 %0, -1, 0\n\tv_mbcnt_hi_u32_b32 %0, -1, %0" : "=v"(ln_));
  const int r32=ln_&31,hi=ln_>>5; const unsigned*qp=reinterpret_cast<const unsigned*>(Q+(long)(qb*QB+wave_id*QBLK+r32)*PQ+h*DQK+hi*8);
  float s=0.f;
  #pragma unroll
  for(int d0=0;d0<6;++d0){ const u32x4 w=*reinterpret_cast<const u32x4*>(qp+d0*8);
    #pragma unroll
    for(int j=0;j<4;++j){ const float a=__builtin_bit_cast(float,w[j]<<16),b=__builtin_bit_cast(float,w[j]&0xffff0000u); s+=a*a; s+=b*b; } }
  return wave_max_nn(xsum32(s)); }
constexpr int ATTN_LDS_BYTES=LDS_BYTES;
#undef SBAR
#undef WB
#undef WAIT_BAR
#undef KOFF
}
#define GAS __attribute__((address_space(1)))
#define LAS __attribute__((address_space(3)))
typedef unsigned short bf16;
typedef unsigned v4u __attribute__((ext_vector_type(4)));
typedef float f32x4 __attribute__((ext_vector_type(4)));
typedef short bf16x8 __attribute__((ext_vector_type(8)));
typedef GAS unsigned gu32;
typedef GAS unsigned long long gu64;
#define RLX_AGENT __ATOMIC_RELAXED, __HIP_MEMORY_SCOPE_AGENT
#define LDS_WAIT() asm volatile("s_waitcnt lgkmcnt(0)" ::: "memory")
#define VM_WAIT() asm volatile("s_waitcnt vmcnt(0)" ::: "memory")
__device__ __forceinline__ unsigned long long rt() { return __builtin_amdgcn_s_memrealtime(); }
__device__ __forceinline__ unsigned f2bf(float f) { unsigned u = __builtin_bit_cast(unsigned, f); return (u + 0x7fffu + ((u >> 16) & 1u)) >> 16; }
__device__ __forceinline__ unsigned pk2(float lo, float hi) { return f2bf(lo) | (f2bf(hi) << 16); }

#define XB_TMO      128
#define XB_XCNT(j)  (256  + 64 * (j))
#define XB_XSUB(j)  (1280 + 64 * (j))
#define XB_XGEN(j)  (2304 + 64 * (j))
#define XB_TOP      3328
#define XB_TOPGEN   3392
#define XCD_BAR_WORDS 3456
#define XB_SPIN_CAP (1u << 18)

__device__ __forceinline__ unsigned xb_ld(unsigned* p)              { return __hip_atomic_load(p, __ATOMIC_RELAXED, __HIP_MEMORY_SCOPE_AGENT); }
__device__ __forceinline__ unsigned xb_add(unsigned* p, unsigned v) { return __hip_atomic_fetch_add(p, v, __ATOMIC_RELAXED, __HIP_MEMORY_SCOPE_AGENT); }
__device__ __forceinline__ unsigned xb_xcc_id() { return (unsigned)__builtin_amdgcn_s_getreg((3 << 11) | 20) & 0xFu; }
#define XB_SPIN(cond, bar) do { unsigned _sp = 0; while (cond) { __builtin_amdgcn_s_sleep(1); \
    if ((++_sp & 255u) == 0u) { if (xb_ld(&(bar)[XB_TMO])) break; if (_sp > XB_SPIN_CAP) { atomicAdd(&(bar)[XB_TMO], 1u); break; } } } } while (0)

struct XcdBarrier {
    unsigned* bar; unsigned x;
    volatile LAS unsigned* st;
};

__device__ __forceinline__ XcdBarrier xcd_barrier_post(unsigned* bar, volatile LAS unsigned* st) {
    XcdBarrier b; b.bar = bar; b.x = xb_xcc_id(); b.st = st;
    if (threadIdx.x == 0) (void)xb_add(&bar[XB_XCNT(b.x)], 1u);
    return b;
}
__device__ __forceinline__ void xcd_barrier_complete(unsigned* bar, unsigned x, unsigned& nloc, unsigned& nx) {
    const unsigned G = gridDim.x * gridDim.y * gridDim.z;
    unsigned sum, cnt, mine, sp = 0u;
    for (;;) {
        sum = 0u; cnt = 0u; mine = 0u;
#pragma unroll
        for (unsigned j = 0; j < 16; ++j) { const unsigned c = xb_ld(&bar[XB_XCNT(j)]); sum += c; cnt += (c > 0u) ? 1u : 0u; mine = (j == x) ? c : mine; }
        if (sum == G) break;
        __builtin_amdgcn_s_sleep(1);
        if ((++sp & 255u) == 0u) { if (xb_ld(&bar[XB_TMO])) break; if (sp > XB_SPIN_CAP) { atomicAdd(&bar[XB_TMO], 1u); break; } }
    }
    nloc = mine > 0u ? mine : 1u; nx = cnt > 0u ? cnt : 1u;
}

__device__ __forceinline__ void xcd_barrier(const XcdBarrier& b, const bool leader  ) {
    asm volatile("s_waitcnt vmcnt(0)" ::: "memory");
    __syncthreads();
    if (leader) {
        unsigned* bar = b.bar;
        __builtin_amdgcn_s_waitcnt(0);
        unsigned nloc = b.st[0], nx = b.st[1];
        if (nloc == 0u) { xcd_barrier_complete(bar, b.x, nloc, nx); b.st[0] = nloc; b.st[1] = nx; }
        const unsigned old = xb_add(&bar[XB_XSUB(b.x)], 1u);
        const unsigned gen = old / nloc;
        if (old + 1u == (gen + 1u) * nloc) {
            __builtin_amdgcn_fence(__ATOMIC_RELEASE, "agent");
            asm volatile("s_waitcnt vmcnt(0)" ::: "memory");
            const unsigned og = xb_add(&bar[XB_TOP], 1u);
            const unsigned tg = og / nx;
            if (og + 1u == (tg + 1u) * nx) xb_add(&bar[XB_TOPGEN], 1u);
            else XB_SPIN(xb_ld(&bar[XB_TOPGEN]) == tg, bar);
            __builtin_amdgcn_fence(__ATOMIC_ACQUIRE, "agent");
            xb_add(&bar[XB_XGEN(b.x)], 1u);
            asm volatile("s_waitcnt vmcnt(0)" ::: "memory");
        } else {
            XB_SPIN(xb_ld(&bar[XB_XGEN(b.x)]) == gen, bar);
            __builtin_amdgcn_fence(__ATOMIC_ACQUIRE, "agent");
            asm volatile("s_waitcnt vmcnt(0)" ::: "memory");
        }
    }
    __syncthreads();
}
constexpr int NWAVES = 8;
constexpr int M = 16384, D = 1024, NL = 2;
constexpr int GW = 512, CHUNK = 128, NGRP = 8;
constexpr int NH = 8, DQK = 96, DNOPE = 64, DROPE = 32, DV = 64, QLORA = 384, KVLORA = 256;
constexpr int IN_TOTAL = 3744, NPROJ = 3840;
constexpr int FF = 2752, FFP = 2816;
#ifndef ACT_LD_DEF
#define ACT_LD_DEF 2816
#endif
constexpr int ACT_LD = ACT_LD_DEF;
constexpr int NE = 8, EFF = 3584;
constexpr float EPS = 1e-6f;
constexpr int PC_U = 0, PC_V = 512, PC_GA = 1024, PC_GB = 2048, PC_CKV = 3072, PC_CQ = 3328, PC_KR = 3712;
constexpr int MOE_ROWS = 2 * M + NE * 256;
constexpr int MOE_PANELS = MOE_ROWS / 256, MOE_PASS_PANELS = 64, MOE_PASS_MAX = MOE_PANELS - MOE_PASS_PANELS;

constexpr size_t MiB = 1u << 20;
constexpr size_t WS_CTL = 0, CTL_ZERO_BYTES = 64 * 1024;
constexpr size_t WS_STATS = 1 * MiB;
constexpr size_t WS_MOD = 2 * MiB;
constexpr size_t WS_KMAXS = 2 * MiB + 512 * 1024;
constexpr size_t WS_SA = 2 * MiB + 640 * 1024;
constexpr size_t WS_AMAX = 2 * MiB + 896 * 1024;
constexpr size_t WS_COS = 3 * MiB, WS_SIN = 4 * MiB;
constexpr size_t WS_TOPI = 5 * MiB, WS_TOPG = 5 * MiB + 128 * 1024, WS_LIST = 5 * MiB + 256 * 1024;
constexpr size_t WS_LSA = 6 * MiB;
constexpr size_t WS_LHS = 6 * MiB + 512 * 1024;
constexpr size_t WS_ROWDEST = 6 * MiB + 512 * 1024, WS_ROWGATE = 6 * MiB + 768 * 1024;
constexpr size_t WS_WST = 7 * MiB;
constexpr size_t WS_WIN = 8 * MiB, WS_WUQ = 23 * MiB, WS_WUKV = 25 * MiB, WS_WA = 26 * MiB, WS_WB = 28 * MiB, WS_WO = 30 * MiB;
constexpr size_t WS_WGU = 34 * MiB, WS_WD = 45 * MiB, WS_W13 = 51 * MiB, WS_W2 = 163 * MiB;
constexpr size_t WS_SP = 8 * MiB;
constexpr size_t WS_H = 220 * MiB;
constexpr size_t WS_PROJ = 252 * MiB;
constexpr size_t WS_Q = 372 * MiB, WS_KN = 396 * MiB, WS_VV = 412 * MiB, WS_KPE = 428 * MiB, WS_GM = 429 * MiB, WS_ATT = 445 * MiB, WS_Y = 461 * MiB;
constexpr size_t WS_ACT = WS_PROJ;
constexpr size_t WS_ACTM = 252 * MiB, WS_Y2 = WS_W13;
constexpr size_t WS_XB = 493 * MiB;
constexpr size_t WS_PST = 525 * MiB;
constexpr size_t WS_END = 529 * MiB;
static_assert(WS_ACTM + (size_t)MOE_ROWS * EFF * 2 <= WS_XB && WS_Y + (size_t)M * D * 2 <= WS_XB && WS_XB + (size_t)M * D * 2 <= WS_PST && WS_PST + 4 * MiB <= WS_END && (size_t)M * 2 * D * 2 <= (size_t)NE * 2 * EFF * D * 2, "moe map");
static_assert(WS_W13 + (size_t)NE * 2 * EFF * D * 2 <= WS_W2 && WS_W2 + (size_t)NE * D * EFF * 2 <= WS_H, "weights map");
constexpr int CW_TMO = 0, CW_CODE = 1;
constexpr int CW_BAR = 4096;
constexpr int CW_XRANK = 12288;
constexpr int CW_KMAX = 1024;
constexpr int CW_MOE = 8192;
constexpr int CW_DIAG = 16384;
constexpr int RING_OFF = 0, RING_BYTES = 131072;
constexpr int LDSCTL_OFF = RING_BYTES, MISC_OFF = LDSCTL_OFF + 320;
constexpr int LDS_BYTES = 147456;
struct Args { const void* in[29]; float* out; unsigned char* ws; int ph_lo, ph_hi; };
__device__ __forceinline__ float sum4f(const f32x4& v) { return (v[0] + v[1]) + (v[2] + v[3]); }
__device__ __forceinline__ int fresh_lane() { int ln_; asm volatile("v_mbcnt_lo_u32_b32 %0, -1, 0\n\tv_mbcnt_hi_u32_b32 %0, -1, %0" : "=v"(ln_)); return ln_; }
__device__ __forceinline__ const float* inptr(const LAS unsigned long long* ptab, int i) { const unsigned long long v = ptab[i]; const unsigned lo = __builtin_amdgcn_readfirstlane((unsigned)v), hi = __builtin_amdgcn_readfirstlane((unsigned)(v >> 32)); const GAS float* gp = (const GAS float*)(((unsigned long long)hi << 32) | lo); return (const float*)gp; }
struct Ctx { LAS unsigned char* lds; gu32* ctl; unsigned char* ws; int tid, lane, wave, vcu, G, gw, NGW; };
__device__ __forceinline__ float wave_sum(float v) {
    float s = v + dpp_f(v, 0x111, 0xf, 0xf); s += dpp_f(v, 0x112, 0xf, 0xf); s += dpp_f(v, 0x113, 0xf, 0xf);
    s += dpp_f(s, 0x114, 0xf, 0xe); s += dpp_f(s, 0x118, 0xf, 0xc); s += dpp_f(s, 0x142, 0xa, 0xf); s += dpp_f(s, 0x143, 0xc, 0xf);
    return __builtin_bit_cast(float, __builtin_amdgcn_readlane(__builtin_bit_cast(int, s), 63)); }
__device__ __forceinline__ float siluf_(float x) { return x / (1.0f + __expf(-x)); }
template <class Map>
__device__ __forceinline__ void p0_item(const Map& mp, int Ksrc, const float* gain, bf16* WT, int ldt, int nblk, LAS float* scr, int item, int lane) {
    const int kb = item / nblk, nb = item % nblk, k0 = 64 * kb, n0 = 32 * nb;
    const float* src; int ldw; const int sc = mp(n0 + (lane & 31), src, ldw);
    float vv[32];
#pragma unroll
    for (int i = 0; i < 32; ++i) { const int k = k0 + 2 * i + (lane >> 5); vv[i] = (sc >= 0 && k < Ksrc) ? src[(size_t)k * ldw + sc] : 0.f; }
    if (gain) {
#pragma unroll
        for (int i = 0; i < 32; ++i) { const int k = k0 + 2 * i + (lane >> 5); vv[i] *= (k < Ksrc) ? gain[k] : 0.f; } }
#pragma unroll
    for (int i = 0; i < 32; ++i) scr[(2 * i + (lane >> 5)) * 33 + (lane & 31)] = vv[i];
    LDS_WAIT(); asm volatile("" ::: "memory");
    const int c = lane & 7;
#pragma unroll
    for (int j = 0; j < 4; ++j) { const int n = (lane >> 3) + 8 * j; const LAS float* s = scr + (8 * c) * 33 + n;
        v4u o; o.x = pk2(s[0 * 33], s[1 * 33]); o.y = pk2(s[2 * 33], s[3 * 33]); o.z = pk2(s[4 * 33], s[5 * 33]); o.w = pk2(s[6 * 33], s[7 * 33]);
        *(GAS v4u*)(WT + (size_t)(n0 + n) * ldt + k0 + 8 * c) = o; }
    LDS_WAIT(); asm volatile("" ::: "memory");
}
template <class Map>
__device__ __forceinline__ void p0_item8(const Map& mp, int Ksrc, float inv, unsigned char* WT, int ldt, int nblk, LAS float* scr, int item, int lane) {
    const int kb = item / nblk, nb = item % nblk, k0 = 64 * kb, n0 = 32 * nb;
    const float* src; int ldw; const int sc = mp(n0 + (lane & 31), src, ldw);
    float vv[32];
#pragma unroll
    for (int i = 0; i < 32; ++i) { const int k = k0 + 2 * i + (lane >> 5); vv[i] = (sc >= 0 && k < Ksrc) ? src[(size_t)k * ldw + sc] : 0.f; }
#pragma unroll
    for (int i = 0; i < 32; ++i) scr[(2 * i + (lane >> 5)) * 33 + (lane & 31)] = vv[i];
    LDS_WAIT(); asm volatile("" ::: "memory");
    const int c = lane & 7;
#pragma unroll
    for (int j = 0; j < 4; ++j) { const int n = (lane >> 3) + 8 * j; const LAS float* s = scr + (8 * c) * 33 + n;
        const unsigned long long o = (unsigned long long)q8x4(s[0 * 33], s[1 * 33], s[2 * 33], s[3 * 33], inv) | ((unsigned long long)q8x4(s[4 * 33], s[5 * 33], s[6 * 33], s[7 * 33], inv) << 32);
        *(unsigned long long*)(WT + (size_t)(n0 + n) * ldt + k0 + 8 * c) = o; }
    LDS_WAIT(); asm volatile("" ::: "memory");
}
__device__ __forceinline__ void tensor_absmax(const Ctx& C, const float* w0, const float* w1, int n4, float* slots, int step = 1, float* sqslots = nullptr) {
    float am = 0.f, sq = 0.f;
    for (int i = C.gw * 64 * step + C.lane; i < n4; i += C.NGW * 64 * step) {     const f32x4 a = ((const f32x4*)w0)[i], b = ((const f32x4*)w1)[i];
        am = fmaxf(am, fmaxf(fmaxf(fmaxf(fabsf(a.x), fabsf(a.y)), fmaxf(fabsf(a.z), fabsf(a.w))), fmaxf(fmaxf(fabsf(b.x), fabsf(b.y)), fmaxf(fabsf(b.z), fabsf(b.w)))));
        sq += (sum4f(a * a) + sum4f(b * b)); }
    am = wave_max_nn(am); if (sqslots) sq = wave_sum(sq);
    LAS float* st = (LAS float*)(C.lds + 14336);
    __syncthreads(); if (C.lane == 0) { st[C.wave] = am; st[8 + C.wave] = sq; } __syncthreads();
    if (C.tid == 0) { float t = st[0], u2 = st[8];
#pragma unroll
        for (int q = 1; q < 8; ++q) { t = fmaxf(t, st[q]); u2 += st[8 + q]; } slots[C.vcu] = t; if (sqslots) sqslots[C.vcu] = u2; }
    __syncthreads();
}
__device__ __forceinline__ float slots_sum(const float* slots, int G, int lane) { float t = 0.f; for (int i = lane; i < G; i += 64) t += slots[i]; return wave_sum(t); }
__device__ __forceinline__ float slots_max(const float* slots, int G, int lane) { float am = 0.f; for (int i = lane; i < G; i += 64) am = fmaxf(am, slots[i]); return wave_max_nn(am); }
struct MapIdent { const float* W; int ld; __device__ __forceinline__ int operator()(int n, const float*& s, int& l) const { s = W; l = ld; return n; } };
struct MapWin { const float* W; __device__ __forceinline__ int operator()(int n, const float*& s, int& l) const { s = W; l = IN_TOTAL;
    if (n < 1024) return n; if (n < 2048) return 1696 + (n - 1024); if (n < 3072) return 2720 + (n - 2048); if (n < 3328) return 1408 + (n - 3072); if (n < 3712) return 1024 + (n - 3328);
    if (n < 3744) { const int j = (n - 3712) >> 1, p = (n - 3712) & 1; return 1664 + j + 16 * p; } return -1; } };
struct MapWuq { const float* W; __device__ __forceinline__ int operator()(int n, const float*& s, int& l) const { s = W; l = 768; const int h = n / 96, o = n % 96;
    if (o < 64) return 96 * h + o; const int j = (o - 64) >> 1, p = (o - 64) & 1; return 96 * h + 64 + j + 16 * p; } };
struct MapWukv { const float* W; __device__ __forceinline__ int operator()(int n, const float*& s, int& l) const { s = W; l = 1024; if (n < 512) return 128 * (n >> 6) + (n & 63); const int m = n - 512; return 128 * (m >> 6) + 64 + (m & 63); } };
struct MapGU { const float* Wg; const float* Wu; int ld, nch; __device__ __forceinline__ int operator()(int n, const float*& s, int& l) const { const int r = n & 255, ch = 128 * (n >> 8) + (r & 127); s = Wg + ((r < 128) ? (ptrdiff_t)0 : (Wu - Wg)); l = ld; return ch < nch ? ch : -1; } };

constexpr float HID_KAPPA = 8.0f;
constexpr int W13_SAMPLES = NE * D * EFF / 16 * 2;
constexpr float W13_RANGE = 1.25f;
constexpr int P0_I13 = 16 * (2 * EFF / 32), P0_I2 = (EFF / 64) * 32, P0_MOE_ITEMS = NE * (P0_I13 + P0_I2);
#ifndef TAIL_G1
#define TAIL_G1 4
#endif
#ifndef TAIL_Q
#define TAIL_Q 2
#endif
#ifndef TAIL_FFN
#define TAIL_FFN 4
#endif
constexpr int TW64 = 64 * NWAVES, TW128 = 128 * NWAVES;
constexpr int TB_G1_0 = 0, TB_Q_0 = TB_G1_0 + TAIL_G1 * TW64, TB_FFN = TB_Q_0 + TAIL_Q * TW64, TB_G1_1 = TB_FFN + TAIL_FFN * TW128, TB_Q_1 = TB_G1_1 + TAIL_G1 * TW64, TB_END = TB_Q_1 + TAIL_Q * TW64;
static_assert(TB_END <= P0_MOE_ITEMS, "tail slices exceed the MoE items");
__device__ __forceinline__ void moe_item(const Ctx& C, const LAS unsigned long long* ptab, LAS float* scr, int m, int lane, float inv13, float inv2) {
    unsigned char* ws = C.ws; const int e = m / (P0_I13 + P0_I2); int r = m - e * (P0_I13 + P0_I2);
    if (r < P0_I13) { p0_item8(MapGU{inptr(ptab, 26) + (size_t)e * D * EFF, inptr(ptab, 27) + (size_t)e * D * EFF, EFF, EFF}, D, inv13, ws + WS_W13 + (size_t)e * 2 * EFF * D, D, 2 * EFF / 32, scr, r, lane); return; }
    r -= P0_I13;
    p0_item8(MapIdent{inptr(ptab, 28) + (size_t)e * EFF * D, D}, EFF, inv2, ws + WS_W2 + (size_t)e * D * EFF, EFF, D / 32, scr, r, lane);
}
__device__ __forceinline__ void moe_tail(const Ctx& C, const LAS unsigned long long* ptab, int cid, int first_cid, int base, int per_wave) {
    if (C.G != 256 || cid < first_cid) return;
    LAS float* scr = (LAS float*)(C.lds + C.wave * 16384); const int lane = fresh_lane(), widx = (cid - first_cid) * NWAVES + C.wave, nw = (256 - first_cid) * NWAVES;
    const float a13 = slots_max((const float*)(C.ws + WS_AMAX) + 256, C.G, lane) * W13_RANGE, inv13 = a13 > 0.f ? 127.0f / a13 : 0.f;
    const float a2 = slots_max((const float*)(C.ws + WS_AMAX) + 1024, C.G, lane) * W13_RANGE, inv2 = a2 > 0.f ? 127.0f / a2 : 0.f;
    for (int i = 0; i < per_wave; ++i) moe_item(C, ptab, scr, base + i * nw + widx, lane, inv13, inv2);
    __syncthreads();
}
template <int PART>
__device__ __forceinline__ void phase_prologue(const Ctx& C, const LAS unsigned long long* ptab) {
    LAS float* scr = (LAS float*)(C.lds + C.wave * 16384);
    unsigned char* ws = C.ws;
    constexpr int I_WIN = 16 * (NPROJ / 32), I_UQ = 6 * (768 / 32), I_UKV = 4 * (1024 / 32), I_AB = 8 * 32, I_WO = 16 * 32, I_GU = 16 * (2 * FFP / 32), I_WD = (FFP / 64) * 32, I_13 = 16 * (2 * EFF / 32), I_2 = (EFF / 64) * 32;
    constexpr int I_L = I_WIN + I_UQ + I_UKV + 2 * I_AB + I_WO;
    constexpr int NONMOE = NL * I_L + I_GU + I_WD; static_assert(I_13 == P0_I13 && I_2 == P0_I2, "item counts");
    const int m_first = (C.G == 256) ? TB_END : 0, NT_ITEMS = NONMOE + P0_MOE_ITEMS - m_first;
    if (PART == 1) { const float a13 = slots_max((const float*)(ws + WS_AMAX) + 256, C.G, C.lane) * W13_RANGE, inv13 = a13 > 0.f ? 127.0f / a13 : 0.f;
    const float a2 = slots_max((const float*)(ws + WS_AMAX) + 1024, C.G, C.lane) * W13_RANGE, inv2 = a2 > 0.f ? 127.0f / a2 : 0.f;
    for (int it = C.gw; it < NT_ITEMS; it += C.NGW) {
        int r = it;
        if (r < NL * I_L) { const int l = r / I_L; r -= l * I_L;
            if (r < I_WIN) { const float aw = slots_max((const float*)(ws + WS_AMAX) + 512 + 256 * l, C.G, C.lane); p0_item8(MapWin{inptr(ptab, 9) + (size_t)l * D * IN_TOTAL}, D, aw > 0.f ? 127.0f / aw : 0.f, ws + WS_WIN + (size_t)l * NPROJ * D, D, NPROJ / 32, scr, r, C.lane); continue; } r -= I_WIN;
            if (r < I_UQ) { p0_item(MapWuq{inptr(ptab, 15) + (size_t)l * QLORA * 768}, QLORA, inptr(ptab, 14) + l * QLORA, (bf16*)(ws + WS_WUQ) + (size_t)l * 768 * QLORA, QLORA, 768 / 32, scr, r, C.lane); continue; } r -= I_UQ;
            if (r < I_UKV) { p0_item(MapWukv{inptr(ptab, 17) + (size_t)l * KVLORA * 1024}, KVLORA, inptr(ptab, 16) + l * KVLORA, (bf16*)(ws + WS_WUKV) + (size_t)l * 1024 * KVLORA, KVLORA, 1024 / 32, scr, r, C.lane); continue; } r -= I_UKV;
            if (r < I_AB) { p0_item(MapIdent{inptr(ptab, 18) + (size_t)l * GW * D, D}, GW, nullptr, (bf16*)(ws + WS_WA) + (size_t)l * D * GW, GW, D / 32, scr, r, C.lane); continue; } r -= I_AB;
            if (r < I_AB) { p0_item(MapIdent{inptr(ptab, 19) + (size_t)l * GW * D, D}, GW, nullptr, (bf16*)(ws + WS_WB) + (size_t)l * D * GW, GW, D / 32, scr, r, C.lane); continue; } r -= I_AB;
            p0_item(MapIdent{inptr(ptab, 20) + (size_t)l * D * D, D}, D, nullptr, (bf16*)(ws + WS_WO) + (size_t)l * D * D, D, D / 32, scr, r, C.lane); continue; }
        r -= NL * I_L;
        if (r < I_GU) { const float ag = slots_max((const float*)(ws + WS_AMAX), C.G, C.lane); p0_item8(MapGU{inptr(ptab, 21), inptr(ptab, 22), FF, FF}, D, ag > 0.f ? 127.0f / ag : 0.f, ws + WS_WGU, D, 2 * FFP / 32, scr, r, C.lane); continue; } r -= I_GU;
        if (r < I_WD) { p0_item(MapIdent{inptr(ptab, 23), D}, FF, nullptr, (bf16*)(ws + WS_WD), FFP, D / 32, scr, r, C.lane); continue; } r -= I_WD;
        moe_item(C, ptab, scr, r + m_first, C.lane, inv13, inv2);
    }
    return; }
    tensor_absmax(C, inptr(ptab, 21), inptr(ptab, 22), D * FF / 4, (float*)(ws + WS_AMAX));
    tensor_absmax(C, inptr(ptab, 26), inptr(ptab, 27), NE * D * EFF / 4, (float*)(ws + WS_AMAX) + 256, 16, (float*)(ws + WS_AMAX) + 1280);
    tensor_absmax(C, inptr(ptab, 28), inptr(ptab, 28) + (size_t)NE * D * EFF / 2, NE * D * EFF / 8, (float*)(ws + WS_AMAX) + 1024, 16);
    tensor_absmax(C, inptr(ptab, 9), inptr(ptab, 9) + D * IN_TOTAL / 2, D * IN_TOTAL / 8, (float*)(ws + WS_AMAX) + 512);
    tensor_absmax(C, inptr(ptab, 9) + D * IN_TOTAL, inptr(ptab, 9) + D * IN_TOTAL + D * IN_TOTAL / 2, D * IN_TOTAL / 8, (float*)(ws + WS_AMAX) + 768);
    { float* MOD = (float*)(ws + WS_MOD); const float* cc = inptr(ptab, 1); const float* aw = inptr(ptab, 3); const float* ab = inptr(ptab, 4);
      for (int it = C.vcu; it < NL * 96; it += C.G) { const int l = it / 96, jb = it % 96, ds = C.wave, g = C.lane >> 4;
          f32x4 s = {0.f, 0.f, 0.f, 0.f}; const float* w = aw + ((size_t)l * D + ds * 128 + g) * (6 * D) + jb * 64 + (C.lane & 15) * 4; const float* cw = cc + ds * 128 + g;
#pragma unroll 16
          for (int i = 0; i < 32; ++i) { const f32x4 wv = *(const f32x4*)(w + (size_t)(4 * i) * 6 * D); s += wv * siluf_(cw[4 * i]); }
          *((LAS f32x4*)(C.lds + C.wave * 16384 + 12288) + C.lane) = s;
          __syncthreads();
          if (C.wave == 0) { const int j = jb * 64 + C.lane; float t = ab[l * 6 * D + j];
#pragma unroll
              for (int q = 0; q < 8; ++q) { const LAS float* pq = (const LAS float*)(C.lds + q * 16384 + 12288) + C.lane; t += pq[0]; t += pq[64]; t += pq[128]; t += pq[192]; }
              MOD[l * 6 * D + j] = t; }
          __syncthreads(); } }
    { const float invf[16] = {1.000000000e+00f, 5.623413324e-01f, 3.162277639e-01f, 1.778279394e-01f, 1.000000015e-01f, 5.623412877e-02f, 3.162277862e-02f, 1.778279431e-02f, 9.999999776e-03f, 5.623413250e-03f, 3.162277862e-03f, 1.778279431e-03f, 1.000000047e-03f, 5.623413017e-04f, 3.162277862e-04f, 1.778279402e-04f};
      const int* pos = (const int*)inptr(ptab, 2); float* ct = (float*)(ws + WS_COS); float* st = (float*)(ws + WS_SIN);
      const int j = C.lane & 15; float f = invf[0];
#pragma unroll
      for (int q = 1; q < 16; ++q) f = (j == q) ? invf[q] : f;
      for (int it = C.gw; it < M / 4; it += C.NGW) { const int row = it * 4 + (C.lane >> 4); const float ang = (float)pos[row] * f;
          const double rev = (double)ang * 0.15915494309189533577; const float fr = (float)(rev - floor(rev));
          ct[row * 16 + j] = __builtin_amdgcn_cosf(fr); st[row * 16 + j] = __builtin_amdgcn_sinf(fr); } }
    { const float* wsrc = inptr(ptab, 12); bf16* wst = (bf16*)(ws + WS_WST);
      for (int it = C.gw; it < NL * NGRP * CHUNK * CHUNK / 256; it += C.NGW) { const int e0 = it * 256 + C.lane * 4; const int t = (e0 >> 7) & 127, s0 = e0 & 127;
          const f32x4 v = *(const f32x4*)(wsrc + e0); unsigned long long o = (unsigned long long)pk2(s0 <= t ? v.x : 0.f, s0 + 1 <= t ? v.y : 0.f) | ((unsigned long long)pk2(s0 + 2 <= t ? v.z : 0.f, s0 + 3 <= t ? v.w : 0.f) << 32);
          *(unsigned long long*)(wst + e0) = o; } }
}
template <bool HQ>
__device__ __forceinline__ void phase_prenorm(const Ctx& C, const float* x, const float* w, const float* sc, const float* sh, bf16* H, float* sa) {
    f32x4 ca[4], cb[4];
#pragma unroll
    for (int j = 0; j < 4; ++j) { const int c = 4 * C.lane + 256 * j; const f32x4 ww = *(const f32x4*)(w + c), s1 = *(const f32x4*)(sc + c); ca[j] = ww * (s1 + 1.0f); cb[j] = *(const f32x4*)(sh + c); }
    for (int blk = C.vcu; blk < M / 64; blk += C.G) {
    const int m0 = blk * 64 + C.wave * 8; f32x4 nx[4];
#pragma unroll
    for (int j = 0; j < 4; ++j) nx[j] = *((const f32x4*)(x + (size_t)m0 * D) + C.lane + 64 * j);
    for (int m = m0; m < m0 + 8; ++m) {
        f32x4 v[4]; float s2 = 0.f;
#pragma unroll
        for (int j = 0; j < 4; ++j) v[j] = nx[j];
        if (m + 1 < m0 + 8) {
#pragma unroll
            for (int j = 0; j < 4; ++j) nx[j] = *((const f32x4*)(x + (size_t)(m + 1) * D) + C.lane + 64 * j); }
#pragma unroll
        for (int j = 0; j < 4; ++j) s2 += sum4f(v[j] * v[j]);
        const float rstd = 1.0f / sqrtf(wave_sum(s2) * (1.0f / D) + EPS);
        unsigned long long* o8 = (unsigned long long*)(H + (size_t)m * D) + C.lane;
#pragma unroll
        for (int j = 0; j < 4; ++j) { const f32x4 hv = v[j] * rstd * ca[j] + cb[j]; if (HQ) v[j] = hv; else o8[64 * j] = (unsigned long long)pk2(hv.x, hv.y) | ((unsigned long long)pk2(hv.z, hv.w) << 32); }
        if (HQ) { float am = 0.f;
#pragma unroll
            for (int j = 0; j < 4; ++j) am = fmaxf(am, fmaxf(fmaxf(fabsf(v[j].x), fabsf(v[j].y)), fmaxf(fabsf(v[j].z), fabsf(v[j].w))));
            am = wave_max_nn(am); const float inv = am > 0.f ? 127.0f / am : 0.f; unsigned* q4 = (unsigned*)((unsigned char*)H + (size_t)m * D) + C.lane;
#pragma unroll
            for (int j = 0; j < 4; ++j) q4[64 * j] = q8x4(v[j].x, v[j].y, v[j].z, v[j].w, inv);
            if (C.lane == 0) sa[m] = am * (1.0f / 127.0f); }
    }
    }
}
__device__ __forceinline__ void ld_bf4(const bf16* p, f32x4& v) { const unsigned long long w = *(const unsigned long long*)p; const unsigned lo = (unsigned)w, hi = (unsigned)(w >> 32);
    v = (f32x4){__uint_as_float(lo << 16), __uint_as_float(lo & 0xffff0000u), __uint_as_float(hi << 16), __uint_as_float(hi & 0xffff0000u)}; }
template <int MODE, bool XIB, bool XOB, bool HQ = false>
__device__ __forceinline__ void phase_resid(const Ctx& C, const void* xin_, void* xout_, const bf16* Y, const bf16* Ysecond, int ypitch, const float* g, const float* wpost,
                                            const float* wpre, const float* sc, const float* sh, bf16* H, const float* wr, const float* br, int* topi, float* topg, int* list, gu32* cnt, float* sa = nullptr) {
    f32x4 cg[4], ca[4], cb[4];
#pragma unroll
    for (int j = 0; j < 4; ++j) { const int c = 4 * C.lane + 256 * j; cg[j] = *(const f32x4*)(g + c) * *(const f32x4*)(wpost + c);
        if (MODE >= 1) { ca[j] = *(const f32x4*)(wpre + c) * (*(const f32x4*)(sc + c) + 1.0f); cb[j] = *(const f32x4*)(sh + c); } }
    LAS float* WR = (LAS float*)C.lds;
    LAS int* lcnt = (LAS int*)(C.lds + 32768);
    LAS int* lsel = (LAS int*)(C.lds + 32768 + 64);
    LAS float* rsc = (LAS float*)(C.lds + 36864) + C.wave * 1024;
    if (MODE == 2) { for (int i = C.tid; i < D * NE / 4; i += NWAVES * 64) ((LAS f32x4*)WR)[i] = ((const f32x4*)wr)[i]; if (C.tid < 16) lcnt[C.tid] = 0; __syncthreads(); }
    for (int blk = C.vcu; blk < M / 64; blk += C.G) {
        const int m_begin = blk * 64 + C.wave * 8, m_end = m_begin + 8;
        unsigned long long yr[4], yr2[4], xb[4]; f32x4 xr[4]; const float* xin = (const float*)xin_; const bf16* xinb = (const bf16*)xin_; float* xout = (float*)xout_; bf16* xoutb = (bf16*)xout_;
#define RES_LOAD(mm) do { _Pragma("unroll") for (int j = 0; j < 4; ++j) { yr[j] = *(const unsigned long long*)(Y + (size_t)(mm) * ypitch + 4 * C.lane + 256 * j); if (Ysecond) yr2[j] = *(const unsigned long long*)(Ysecond + (size_t)(mm) * ypitch + 4 * C.lane + 256 * j); \
            if (XIB) xb[j] = *((const unsigned long long*)(xinb + (size_t)(mm) * D) + C.lane + 64 * j); else xr[j] = *((const f32x4*)(xin + (size_t)(mm) * D) + C.lane + 64 * j); } } while (0)
#define RES_CVT(w, v) do { const unsigned lo_ = (unsigned)(w), hi_ = (unsigned)((w) >> 32); v = (f32x4){__uint_as_float(lo_ << 16), __uint_as_float(lo_ & 0xffff0000u), __uint_as_float(hi_ << 16), __uint_as_float(hi_ & 0xffff0000u)}; } while (0)
        RES_LOAD(m_begin);
        for (int m = m_begin; m < m_end; ++m) {
            f32x4 y[4], xv[4]; float s2 = 0.f;
#pragma unroll
            for (int j = 0; j < 4; ++j) { RES_CVT(yr[j], y[j]); if (Ysecond) { f32x4 t; RES_CVT(yr2[j], t); y[j] += t; } if (XIB) RES_CVT(xb[j], xv[j]); else xv[j] = xr[j]; }
            if (m + 1 < m_end) RES_LOAD(m + 1);
#pragma unroll
            for (int j = 0; j < 4; ++j) s2 += sum4f(y[j] * y[j]);
            const float rstd = 1.0f / sqrtf(wave_sum(s2) * (1.0f / D) + EPS); float s3 = 0.f;
#pragma unroll
            for (int j = 0; j < 4; ++j) { xv[j] += cg[j] * (y[j] * rstd);
                if (XOB) { const unsigned long long w = (unsigned long long)pk2(xv[j].x, xv[j].y) | ((unsigned long long)pk2(xv[j].z, xv[j].w) << 32); *((unsigned long long*)(xoutb + (size_t)m * D) + C.lane + 64 * j) = w; RES_CVT(w, xv[j]); }
                else *((f32x4*)(xout + (size_t)m * D) + C.lane + 64 * j) = xv[j];
                s3 += sum4f(xv[j] * xv[j]); }
            if (MODE >= 1) {
                const float rstd2 = 1.0f / sqrtf(wave_sum(s3) * (1.0f / D) + EPS);
                unsigned long long* o8 = (unsigned long long*)(H + (size_t)m * D) + C.lane; float lg[8];
                if (MODE == 2) {
#pragma unroll
                    for (int e = 0; e < 8; ++e) lg[e] = 0.f; }
                if (HQ) { float am = 0.f;
#pragma unroll
                    for (int j = 0; j < 4; ++j) { xv[j] = xv[j] * rstd2 * ca[j] + cb[j]; am = fmaxf(am, fmaxf(fmaxf(fabsf(xv[j].x), fabsf(xv[j].y)), fmaxf(fabsf(xv[j].z), fabsf(xv[j].w)))); }
                    am = wave_max_nn(am); const float inv = am > 0.f ? 127.0f / am : 0.f; unsigned* q4 = (unsigned*)((unsigned char*)H + (size_t)m * D) + C.lane;
#pragma unroll
                    for (int j = 0; j < 4; ++j) q4[64 * j] = q8x4(xv[j].x, xv[j].y, xv[j].z, xv[j].w, inv);
                    if (C.lane == 0) sa[m] = am * (1.0f / 127.0f);
                    if (MODE == 2) { float hs = 0.f;
#pragma unroll
                        for (int j = 0; j < 4; ++j) hs += sum4f(xv[j] * xv[j]);
                        hs = wave_sum(hs); if (C.lane == 0) sa[m + M] = hs; }
                    if (MODE == 2) {
#pragma unroll
                        for (int j = 0; j < 4; ++j)
#pragma unroll
                            for (int q = 0; q < 4; ++q) { const int c = 4 * C.lane + 256 * j + q; const f32x4 w0 = *(const LAS f32x4*)(WR + c * 8), w1 = *(const LAS f32x4*)(WR + c * 8 + 4); const float hq = xv[j][q];
                                lg[0] += hq * w0.x; lg[1] += hq * w0.y; lg[2] += hq * w0.z; lg[3] += hq * w0.w; lg[4] += hq * w1.x; lg[5] += hq * w1.y; lg[6] += hq * w1.z; lg[7] += hq * w1.w; } } }
                else
#pragma unroll
                for (int j = 0; j < 4; ++j) { const f32x4 hv = xv[j] * rstd2 * ca[j] + cb[j]; o8[64 * j] = (unsigned long long)pk2(hv.x, hv.y) | ((unsigned long long)pk2(hv.z, hv.w) << 32);
                    if (MODE == 2) {
#pragma unroll
                        for (int q = 0; q < 4; ++q) { const int c = 4 * C.lane + 256 * j + q; const f32x4 w0 = *(const LAS f32x4*)(WR + c * 8), w1 = *(const LAS f32x4*)(WR + c * 8 + 4); const float hq = hv[q];
                            lg[0] += hq * w0.x; lg[1] += hq * w0.y; lg[2] += hq * w0.z; lg[3] += hq * w0.w; lg[4] += hq * w1.x; lg[5] += hq * w1.y; lg[6] += hq * w1.z; lg[7] += hq * w1.w; } } }
                if (MODE == 2) {
#pragma unroll
                    for (int e = 0; e < 8; ++e) rsc[e * 64 + C.lane] = lg[e];
                    __builtin_amdgcn_fence(__ATOMIC_RELEASE, "wavefront"); __builtin_amdgcn_wave_barrier(); __builtin_amdgcn_fence(__ATOMIC_ACQUIRE, "wavefront");
                    if (C.lane < 8) { float t = br[C.lane];
                        for (int i = 0; i < 64; ++i) t += rsc[C.lane * 64 + i];
                        rsc[512 + C.lane] = t; }
                    __builtin_amdgcn_fence(__ATOMIC_RELEASE, "wavefront"); __builtin_amdgcn_wave_barrier(); __builtin_amdgcn_fence(__ATOMIC_ACQUIRE, "wavefront");
#pragma unroll
                    for (int e = 0; e < 8; ++e) lg[e] = rsc[512 + e];
                    __builtin_amdgcn_fence(__ATOMIC_RELEASE, "wavefront"); __builtin_amdgcn_wave_barrier(); __builtin_amdgcn_fence(__ATOMIC_ACQUIRE, "wavefront");
#ifdef DIAG_LOGITS
                    if (C.lane == 0) { float* LG = (float*)(C.ws + 514 * MiB) + (size_t)m * 8;
#pragma unroll
                        for (int e = 0; e < 8; ++e) LG[e] = lg[e]; }
#endif
                    int i0 = 0; float v0 = lg[0];
#pragma unroll
                    for (int e = 1; e < 8; ++e) if (lg[e] > v0) { v0 = lg[e]; i0 = e; }
                    int i1 = -1; float v1 = -INFINITY;
#pragma unroll
                    for (int e = 0; e < 8; ++e) if (e != i0 && lg[e] > v1) { v1 = lg[e]; i1 = e; }
                    const float e1 = __expf(v1 - v0), g0 = 1.0f / (1.0f + e1), g1 = e1 * g0;
                    if (C.lane == 0) { topi[2 * m] = i0; topi[2 * m + 1] = i1; topg[2 * m] = g0; topg[2 * m + 1] = g1;
                        const int lr = m - blk * 64; lsel[2 * lr] = i0; lsel[2 * lr + 1] = i1; }
                }
            }
        }
        if (MODE == 2) {
            __syncthreads();
            if (C.tid < 128) { const int e = lsel[C.tid]; int rk = 0; for (int t2 = 0; t2 < C.tid; ++t2) rk += (lsel[t2] == e) ? 1 : 0; ((int*)list)[(size_t)NE * M + blk * 128 + C.tid] = (e << 16) | rk; }
            if (C.tid >= 128 && C.tid < 136) { const int e = C.tid - 128; int c = 0; for (int t2 = 0; t2 < 128; ++t2) c += (lsel[t2] == e) ? 1 : 0; ((int*)list)[(size_t)NE * M + (M / 64) * 128 + blk * 8 + e] = c; }
            __syncthreads();
        }
    }
}
__device__ __forceinline__ void phase_moe_lists(const Ctx& C, int* list, const float* sa, float* lsa, float* lhs, float hidk) {
    const int* RANK = list + (size_t)NE * M; const int* CNTB = RANK + (M / 64) * 128; LAS int* base = (LAS int*)C.lds;
    for (int blk = C.vcu; blk < M / 64; blk += C.G) {
        __syncthreads();
        { float s = 0.f;
#pragma unroll
          for (int i = 0; i < 4; ++i) { const int b2 = C.lane + 64 * i; s += (b2 < blk) ? (float)CNTB[b2 * 8 + C.wave] : 0.f; }
          s = wave_sum(s); if (C.lane == 0) base[C.wave] = (int)s; }
        __syncthreads();
        if (C.tid < 128) { const int v = RANK[blk * 128 + C.tid], e = v >> 16, rk = v & 0xffff; list[e * M + base[e] + rk] = ((blk * 64 + (C.tid >> 1)) << 1) | (C.tid & 1); lsa[e * M + base[e] + rk] = sa[blk * 64 + (C.tid >> 1)]; lhs[e * M + base[e] + rk] = hidk * sa[M + blk * 64 + (C.tid >> 1)]; }
    }
}
__device__ __forceinline__ void phase_gmlp(const Ctx& C, const bf16* PROJ, const float* sumv, const float* ssqv, const float* lng, const float* lnb, const bf16* WST, const float* bs, bf16* GM) {
    typedef __attribute__((ext_vector_type(16))) float f32x16; typedef unsigned u32x4v __attribute__((ext_vector_type(4)));
    LAS bf16* VT = (LAS bf16*)C.lds;
    const int r32 = C.lane & 31, hi = C.lane >> 5;
    const int xg = C.G >> 3, xq = C.vcu / (xg > 0 ? xg : 1), xr = C.vcu - xq * xg;
    for (int uu = xr; uu < 128; uu += xg) {
        const int u = xq * 128 + uu;
        const int c = u >> 3, g = u & 7, t0 = c * CHUNK, ch0 = g * 64;
        { const int s = C.tid >> 2, dq = (C.tid & 3) * 16, row = t0 + s; const f32x4 sa = *(const f32x4*)(sumv + row * 8), sb = *(const f32x4*)(sumv + row * 8 + 4), qa = *(const f32x4*)(ssqv + row * 8), qb = *(const f32x4*)(ssqv + row * 8 + 4);
          const float mean = (((sa[0] + sa[1]) + (sa[2] + sa[3])) + ((sb[0] + sb[1]) + (sb[2] + sb[3]))) * (1.0f / GW), var = (((qa[0] + qa[1]) + (qa[2] + qa[3])) + ((qb[0] + qb[1]) + (qb[2] + qb[3]))) * (1.0f / GW) - mean * mean, rstd = 1.0f / sqrtf(var + EPS);
          const u32x4v w0 = *(const u32x4v*)(PROJ + (size_t)row * NPROJ + PC_V + ch0 + dq), w1 = *(const u32x4v*)(PROJ + (size_t)row * NPROJ + PC_V + ch0 + dq + 8);
#pragma unroll
          for (int i = 0; i < 8; ++i) { const unsigned wa = (i < 4) ? w0[i] : w1[i - 4]; const int d = dq + 2 * i;
              const float a = (__uint_as_float(wa << 16) - mean) * rstd * lng[ch0 + d] + lnb[ch0 + d], b = (__uint_as_float(wa & 0xffff0000u) - mean) * rstd * lng[ch0 + d + 1] + lnb[ch0 + d + 1];
              VT[d * 136 + s] = (bf16)f2bf(a); VT[(d + 1) * 136 + s] = (bf16)f2bf(b); } }
        __syncthreads();
        const int dblk = C.wave & 1, tblk = C.wave >> 1; f32x16 acc = {};
        const bf16* wrow = WST + ((size_t)g * CHUNK + 32 * tblk + r32) * CHUNK + 8 * hi;
        for (int ks = 0; ks <= 2 * tblk + 1; ++ks) {
            const bf16x8 af = *(const LAS bf16x8*)(VT + (32 * dblk + r32) * 136 + 16 * ks + 8 * hi);
            const bf16x8 bfr = *(const bf16x8*)(wrow + 16 * ks);
            acc = __builtin_amdgcn_mfma_f32_32x32x16_bf16(af, bfr, acc, 0, 0, 0);
        }
        const int tl = 32 * tblk + r32, row = t0 + tl; const float bias = bs[g * CHUNK + tl];
#pragma unroll
        for (int q = 0; q < 4; ++q) { const int ch = ch0 + 32 * dblk + 8 * q + 4 * hi; f32x4 uv; ld_bf4(PROJ + (size_t)row * NPROJ + PC_U + ch, uv);
            const f32x4 z = (f32x4){acc[4 * q] + bias, acc[4 * q + 1] + bias, acc[4 * q + 2] + bias, acc[4 * q + 3] + bias}, o = uv * z;
            *(unsigned long long*)(GM + (size_t)row * GW + ch) = (unsigned long long)pk2(o.x, o.y) | ((unsigned long long)pk2(o.z, o.w) << 32); }
        __syncthreads();
    }
}
__device__ __forceinline__ void moe_tab_build(const Ctx& C, const int* list, LAS int* tab) {
    const int* CNTB = list + (size_t)NE * M + (M / 64) * 128;
    __syncthreads();
    { float s = 0.f;
#pragma unroll
      for (int i = 0; i < 4; ++i) s += (float)CNTB[(C.lane + 64 * i) * 8 + C.wave];
      s = wave_sum(s); if (C.lane == 0) tab[16 + C.wave] = (int)s; }
    __syncthreads();
    if (C.tid == 0) { int acc = 0; for (int e = 0; e < 8; ++e) { tab[e] = acc; acc += (tab[16 + e] + 255) >> 8; } tab[8] = acc; }
    __syncthreads();
}
__device__ __forceinline__ int moe_expert_of(const LAS int* tab, int panel) { int e = 0;
#pragma unroll
    for (int q = 1; q < 8; ++q) e += (panel >= tab[q]) ? 1 : 0; return e; }
__device__ __forceinline__ void phase_gather(const Ctx& C, const LAS int* tab, const bf16* H, const int* list, const float* topg, bf16* XG, int* rowdest, float* rowgate) {
    typedef unsigned u32x4v __attribute__((ext_vector_type(4)));
    const int total = tab[8] * 256;
    for (int p = C.gw; p < total; p += C.NGW) {
        const int e = moe_expert_of(tab, p >> 8), i = p - tab[e] * 256; u32x4v v0 = {0u, 0u, 0u, 0u}, v1 = {0u, 0u, 0u, 0u}; int dest = -1; float gt = 0.f;
        if (i < tab[16 + e]) { dest = list[e * M + i]; gt = topg[dest]; const u32x4v* src = (const u32x4v*)(H + (size_t)(dest >> 1) * D); v0 = src[C.lane]; v1 = src[64 + C.lane]; }
        u32x4v* dst = (u32x4v*)(XG + (size_t)p * D); dst[C.lane] = v0; dst[64 + C.lane] = v1;
        if (C.lane == 0) { rowdest[p] = dest; rowgate[p] = gt; }
    }
}
struct MoeOrder {
    pg8::StaticOrder S; int p0; size_t estride; int absA; const LAS int* tab; const int* list; int rowbytes; const float* lsa;
    long limit;
    __device__ bool next(int i, pg8::Unit& u) const { const long L = (long)i * S.G + S.c; if (L >= limit) return false; return at(L, u); }
    __device__ bool at(long L, pg8::Unit& u) const { if (!S.at(L, u)) return false; const int P = p0 + u.pm; const int e = __builtin_amdgcn_readfirstlane(moe_expert_of(tab, P)); u.aux = P; u.aoff = (size_t)(absA ? P : u.pm) * S.astep; u.boff += (size_t)e * estride; return true; }
    __device__ __forceinline__ float rowscale_of(const pg8::Unit& u, int rl) const { const int P = u.aux, e = __builtin_amdgcn_readfirstlane(moe_expert_of(tab, P)), i = (P - tab[e]) * 256 + rl; return (i < tab[16 + e]) ? lsa[e * M + i] : 0.f; }
    __device__ __forceinline__ int rowtok(const pg8::Unit& u, int rl) const {
        const int P = u.aux, e = __builtin_amdgcn_readfirstlane(moe_expert_of(tab, P)), i = (P - tab[e]) * 256 + rl; return (i < tab[16 + e]) ? (list[e * M + i] >> 1) : 0; }
    __device__ __forceinline__ void avoff(const pg8::Unit& u, const int (&R)[2], const int (&C)[2], unsigned (&v)[2][2]) const {
        const int P = u.aux, e = __builtin_amdgcn_readfirstlane(moe_expert_of(tab, P)), base = (P - tab[e]) * 256, cnt = tab[16 + e];
#pragma unroll
        for (int h = 0; h < 2; ++h)
#pragma unroll
            for (int i = 0; i < 2; ++i) { const int r = base + h * 128 + R[i]; const int tk = (r < cnt) ? list[e * M + r] : 0; v[h][i] = (unsigned)(tk >> 1) * (unsigned)rowbytes + (unsigned)C[i] * 2u; }
    }
};
struct OneUnit { MoeOrder S; long L; __device__ bool next(int i, pg8::Unit& u) const { if (i != 0) return false; return S.at(L, u); }
    __device__ __forceinline__ float rowscale_of(const pg8::Unit& u, int rl) const { return S.rowscale_of(u, rl); } };
__device__ __forceinline__ void phase_moe_reduce(const Ctx& C, const MoeOrder& S, long nfull, int nleft, int nsplit, const bf16* SP, const int* list, const float* topg, const LAS int* tab, bf16* Y2) {
    for (int it = C.gw; it < nleft * 256; it += C.NGW) {
        const int j = it >> 8, r = it & 255; pg8::Unit u; if (!S.at(nfull + j, u)) continue;
        const int P = u.aux, e = __builtin_amdgcn_readfirstlane(moe_expert_of(tab, P)), i = (P - tab[e]) * 256 + r;
        if (i >= tab[16 + e]) continue;
        const int d = list[e * M + i]; const float gt = topg[d];
        const bf16* p = SP + ((size_t)(nsplit * j) * 256 + r) * 256 + 4 * C.lane; const size_t ts = (size_t)256 * 256;
        f32x4 s; ld_bf4(p, s); for (int q = 1; q < nsplit; ++q) { f32x4 t; ld_bf4(p + q * ts, t); s += t; }
        *(unsigned long long*)(Y2 + (size_t)d * D + u.pn * 256 + 4 * C.lane) = (unsigned long long)pk2(s.x * gt, s.y * gt) | ((unsigned long long)pk2(s.z * gt, s.w * gt) << 32);
    }
}
#ifndef EN_LEFT
#define EN_LEFT 1
#endif
#ifndef ATTN_BOUND2
#define ATTN_BOUND2 4096.0f
#endif
#ifndef ATTN_FASTSEL
#define ATTN_FASTSEL true
#endif
#ifndef PR_ATT
#define PR_ATT 1
#endif
#ifndef PR_G1
#define PR_G1 1
#endif
#ifndef PR_GMLP
#define PR_GMLP 1
#endif
#ifndef PR_QKV
#define PR_QKV 1
#endif
#ifndef PR_OUT
#define PR_OUT 1
#endif
#ifndef PR_FFN1
#define PR_FFN1 1
#endif
#ifndef PR_FFN2
#define PR_FFN2 1
#endif
#ifndef PR_MOE1
#define PR_MOE1 1
#endif
#ifndef PR_MOE2
#define PR_MOE2 1
#endif
#ifndef PR_P0
#define PR_P0 1
#endif
#ifndef EN_ALL
#define EN_ALL 1
#endif
#ifndef DIAG_TWIN_OFF
#define DIAG_TWIN_OFF WS_ACT
#endif
#ifndef EN_FFN2
#define EN_FFN2 1
#endif
#ifndef EN_BR2
#define EN_BR2 1
#endif
#ifndef EN_C1
#define EN_C1 1
#endif
#ifndef EN_C2
#define EN_C2 1
#endif
#ifndef EN_C3
#define EN_C3 1
#endif
#ifndef EN_P0
#define EN_P0 EN_ALL
#endif
#ifndef EN_P1
#define EN_P1 EN_ALL
#endif
#ifndef EN_G1
#define EN_G1 EN_ALL
#endif
#ifndef EN_C
#define EN_C EN_ALL
#endif
#ifndef EN_ATT
#define EN_ATT EN_ALL
#endif
#ifndef EN_BR
#define EN_BR EN_ALL
#endif
#ifndef EN_OUT
#define EN_OUT EN_ALL
#endif
#ifndef EN_T1
#define EN_T1 EN_ALL
#endif
#ifndef EN_FFN
#define EN_FFN EN_ALL
#endif
#ifndef EN_T2
#define EN_T2 EN_ALL
#endif
#ifndef EN_GA
#define EN_GA EN_ALL
#endif
#ifndef EN_MOE
#define EN_MOE EN_ALL
#endif
#ifndef EN_FIN
#define EN_FIN EN_ALL
#endif
constexpr int NPHASES = 23;
__global__ void __launch_bounds__(NWAVES * 64, 2) mega_fwd(Args args) {
    extern __shared__ __attribute__((aligned(16))) unsigned char lds[];
    Ctx C; C.lds = (LAS unsigned char*)lds; C.ws = args.ws; C.ctl = (gu32*)(args.ws + WS_CTL);
    C.tid = threadIdx.x; C.lane = C.tid & 63; C.wave = __builtin_amdgcn_readfirstlane(C.tid >> 6);
    for (int u = threadIdx.x; u < (LDS_BYTES - LDSCTL_OFF) / 4; u += NWAVES * 64) ((LAS unsigned*)(C.lds + LDSCTL_OFF))[u] = 0u;
    __syncthreads();
    C.G = gridDim.x;
    int cid = blockIdx.x;
    { volatile LAS unsigned* MI = (volatile LAS unsigned*)(C.lds + MISC_OFF);
      if (threadIdx.x == 0) { const unsigned xcc = xb_xcc_id(); const unsigned rk = __hip_atomic_fetch_add((gu32*)(args.ws + WS_CTL) + CW_XRANK + 64 * xcc, 1u, RLX_AGENT); MI[16] = xcc; MI[17] = rk; }
      __syncthreads();
      const int xcc = (int)MI[16], rk = (int)MI[17], per = C.G >> 3;
      if ((C.G & 7) == 0 && xcc < 8 && rk < per) { C.vcu = xcc * per + rk; cid = rk * 8 + xcc; } else { const int bx = blockIdx.x; C.vcu = (C.G % 8 == 0) ? (bx % 8) * (C.G / 8) + bx / 8 : bx; cid = bx; } }
    C.gw = C.vcu * NWAVES + C.wave; C.NGW = C.G * NWAVES;
    volatile LAS unsigned* MISC = (volatile LAS unsigned*)(C.lds + MISC_OFF);
    LAS int* moetab = (LAS int*)(C.lds + MISC_OFF + 256);
    LAS unsigned long long* ptab = (LAS unsigned long long*)(C.lds + MISC_OFF + 512);
    if (threadIdx.x < 29) ptab[threadIdx.x] = (unsigned long long)args.in[threadIdx.x];
    __syncthreads();
    XcdBarrier bar = xcd_barrier_post((unsigned*)(C.ctl + CW_BAR), MISC + 8);
    const int lo = args.ph_lo, hi = args.ph_hi;
    unsigned char* ws = args.ws;
#define IN(k) (lo <= (k) && (k) < hi)
#define FRESH() do { C.lane = fresh_lane(); C.tid = C.wave * 64 + C.lane; } while (0)
#define SEAM(k) do { if ((k) + 1 < hi) { XcdBarrier b_ = bar; { unsigned long long bp_ = (unsigned long long)b_.bar; asm volatile("" : "+s"(bp_)); b_.bar = (unsigned*)(GAS unsigned*)bp_; } xcd_barrier(b_, C.wave == 0 && fresh_lane() == 0); } } while (0)
#define INF(i) (inptr(ptab, (i)))
#define WSF(off) ([&]() { unsigned long long b_ = (unsigned long long)ws; asm volatile("" : "+s"(b_)); return (float*)(b_ + (off)); }())
    bf16* const Hb = (bf16*)(ws + WS_H); bf16* const PROJ = (bf16*)(ws + WS_PROJ); bf16* const Qb = (bf16*)(ws + WS_Q); bf16* const KNb = (bf16*)(ws + WS_KN); bf16* const VVb = (bf16*)(ws + WS_VV);
    bf16* const KPEb = (bf16*)(ws + WS_KPE); bf16* const GMb = (bf16*)(ws + WS_GM); bf16* const ATTb = (bf16*)(ws + WS_ATT); bf16* const Yb = (bf16*)(ws + WS_Y); bf16* const MRG = Hb; bf16* const H1b = (bf16*)(ws + WS_GM);
    const float* const MOD = (const float*)(ws + WS_MOD); const float* const cosT = (const float*)(ws + WS_COS); const float* const sinT = (const float*)(ws + WS_SIN);
    float* const xres = args.out; bf16* const xbf = (bf16*)(ws + WS_XB);

    if (IN(0)) { FRESH(); _Pragma("unroll") for (int rep_ = 0; rep_ < PR_P0; ++rep_) { phase_prologue<0>(C, ptab); { XcdBarrier b_ = bar; { unsigned long long bp_ = (unsigned long long)b_.bar; asm volatile("" : "+s"(bp_)); b_.bar = (unsigned*)(GAS unsigned*)bp_; } xcd_barrier(b_, C.wave == 0 && fresh_lane() == 0); } FRESH(); phase_prologue<1>(C, ptab); }
        if (EN_P1) phase_prenorm<true>(C, INF(0), INF(5), MOD + 1 * D, MOD + 0 * D, Hb, WSF(WS_SA));
        SEAM(0); }
#pragma unroll
    for (int l = 0; l < NL; ++l) {
        const int pb = (l == 0) ? 1 : 10;
        const float* mod = MOD + l * 6 * D;
        float* st_sumv = (float*)(ws + WS_PST + (size_t)l * 2 * MiB); float* st_ssqv = st_sumv + 8 * M; float* st_ssqq = st_sumv + 16 * M; float* st_ssqkv = st_sumv + 24 * M;
        if (EN_G1 && IN(pb + 1)) { FRESH();
#ifdef DIAG_L2FLUSH
            if (l == 1) { typedef unsigned u32x4f __attribute__((ext_vector_type(4))); const u32x4f* src = (const u32x4f*)(ws + WS_W13 + (size_t)C.vcu * (DIAG_L2FLUSH * 65536)); u32x4f acc_ = {0u, 0u, 0u, 0u};
                for (int i = 0; i < DIAG_L2FLUSH * 8; ++i) { const u32x4f v = src[i * 512 + C.tid]; acc_ ^= v; }
                if ((acc_.x ^ acc_.y ^ acc_.z ^ acc_.w) == 0x12345678u) ((unsigned*)(ws + WS_TOPI))[C.tid] = 1u; __syncthreads(); }
#endif
            pg8::Gemm g{l == 0 ? Hb : H1b, (const bf16*)(ws + WS_WIN + (size_t)l * NPROJ * D), D / 2, D / 2, D / 2, WSF(WS_SA), slots_max(WSF(WS_AMAX) + 512 + 256 * l, C.G, C.lane) * (1.0f / 127.0f)}; pg8::StaticOrder S; S.init(M, NPROJ, D / 2, D / 2, C.G, cid);
            pg8::EpiProj E{PROJ, KPEb, st_sumv, st_ssqv, st_ssqq, st_ssqkv, cosT, sinT};
#if 1
            _Pragma("unroll") for (int rep_ = 0; rep_ < PR_G1; ++rep_) pg8::gemm_phase<pg8::EpiProj, pg8::StaticOrder, true, PG8_SP2_DEFAULT, false, true>(C.lds + RING_OFF, g, S, E, C.wave);
            moe_tail(C, ptab, cid, 192, l ? TB_G1_1 : TB_G1_0, TAIL_G1);
#endif
            SEAM(pb + 1);
        }
        if (EN_C && IN(pb + 2)) { FRESH();
            _Pragma("unroll") for (int rep_ = 0; rep_ < PR_GMLP; ++rep_) phase_gmlp(C, PROJ, st_sumv, st_ssqv, INF(10) + l * GW, INF(11) + l * GW, (const bf16*)(ws + WS_WST) + (size_t)l * NGRP * CHUNK * CHUNK, INF(13) + l * NGRP * CHUNK, GMb);
            {
              const int first = C.G > 192 ? 192 : 0;
              if (cid >= first) for (int blk = cid - first; blk < M / 256; blk += C.G - first) { const int ln = fresh_lane();
                  const attn3::u32x4* kp = (const attn3::u32x4*)(KPEb + (size_t)(blk * 256 + C.wave * 32 + (ln & 31)) * 32) + 2 * (ln >> 5); float q = 0.f;
                  _Pragma("unroll") for (int i = 0; i < 2; ++i) { const attn3::u32x4 w = kp[i];
                      _Pragma("unroll") for (int j = 0; j < 4; ++j) { const float a = __builtin_bit_cast(float, w[j] << 16), b = __builtin_bit_cast(float, w[j] & 0xffff0000u); q += a * a; q += b * b; } }
                  q = wave_max_nn(xsum32(q));
                  if (ln == 0) __hip_atomic_fetch_max((unsigned*)(ws + WS_CTL) + CW_KMAX + 32 * l + 16, __builtin_bit_cast(unsigned, q), __ATOMIC_RELAXED, __HIP_MEMORY_SCOPE_AGENT); } }
            if (EN_C2) { pg8::Gemm g{PROJ + PC_CQ, (const bf16*)(ws + WS_WUQ) + (size_t)l * 768 * QLORA, NPROJ, QLORA, QLORA}; pg8::StaticOrder S; S.init(M, 768, NPROJ, QLORA, C.G, cid);
              pg8::EpiQ E{Qb, st_ssqq, cosT, sinT, 0.10206207261596577f * 1.4426950408889634f};
              _Pragma("unroll") for (int rep_ = 0; rep_ < PR_QKV; ++rep_) pg8::gemm_phase<pg8::EpiQ, pg8::StaticOrder>(C.lds + RING_OFF, g, S, E, C.wave);
              moe_tail(C, ptab, cid, 192, l ? TB_Q_1 : TB_Q_0, TAIL_Q); }
            if (EN_C3) { pg8::Gemm g{PROJ + PC_CKV, (const bf16*)(ws + WS_WUKV) + (size_t)l * 1024 * KVLORA, NPROJ, KVLORA, KVLORA}; pg8::StaticOrder S; S.init(M, 1024, NPROJ, KVLORA, C.G, cid);
              pg8::EpiKV E{KNb, VVb, st_ssqkv, (float*)(ws + WS_KMAXS) + l * 2048};
              _Pragma("unroll") for (int rep_ = 0; rep_ < PR_QKV; ++rep_) pg8::gemm_phase<pg8::EpiKV, pg8::StaticOrder>(C.lds + RING_OFF, g, S, E, C.wave); }
            SEAM(pb + 2);
        }
        if (EN_ATT && IN(pb + 3)) { FRESH();
_Pragma("unroll") for (int rep_ = 0; rep_ < PR_ATT; ++rep_)
            for (int ui = C.vcu; ui < 256; ui += C.G) { const int h = ui >> 5, s = ui & 31;
#ifdef ATTN_V1
                attn1::attn_unit(h, 63 - s, Qb, KNb, KPEb, VVb, ATTb, C.lds + RING_OFF, C.wave);
                attn1::attn_unit(h, s, Qb, KNb, KPEb, VVb, ATTb, C.lds + RING_OFF, C.wave); }
#else
                const unsigned* kmx = (const unsigned*)(ws + WS_CTL) + CW_KMAX + 32 * l;
#define KMXF(i) __builtin_bit_cast(float, __hip_atomic_load(kmx + (i), __ATOMIC_RELAXED, __HIP_MEMORY_SCOPE_AGENT))
                float kn2; { const float* km = (const float*)(ws + WS_KMAXS) + l * 2048 + h * 256 + 2 * fresh_lane(); const pg8::f32x2 a0 = *(const pg8::f32x2*)km, a1 = *(const pg8::f32x2*)(km + 128);
                    kn2 = wave_max_nn(fmaxf(a0.x + a1.x, a0.y + a1.y)); }
                const float kb2 = (kn2 + KMXF(16)) * 1.05f;
#undef KMXF
                const bool fast = ATTN_FASTSEL && fmaxf(attn3::qnorm2_max(h, 63 - s, (const attn3::bf16*)Qb, C.wave), attn3::qnorm2_max(h, s, (const attn3::bf16*)Qb, C.wave)) * kb2 < ATTN_BOUND2;
                if (fast) { _Pragma("nounroll") for (int k2 = 0; k2 < 2; ++k2)
                    attn3::attn_unit<8, true>(h, k2 ? s : 63 - s, (const attn3::bf16*)Qb, (const attn3::bf16*)KNb, (const attn3::bf16*)KPEb, (const attn3::bf16*)VVb, (attn3::bf16*)ATTb, (char*)lds + RING_OFF, C.wave); }
                else { _Pragma("nounroll") for (int k2 = 0; k2 < 2; ++k2)
                    attn3::attn_unit<8, false>(h, k2 ? s : 63 - s, (const attn3::bf16*)Qb, (const attn3::bf16*)KNb, (const attn3::bf16*)KPEb, (const attn3::bf16*)VVb, (attn3::bf16*)ATTb, (char*)lds + RING_OFF, C.wave); } }
#endif
            SEAM(pb + 3);
        }
        if (EN_BR && IN(pb + 4)) { FRESH();
            { pg8::Gemm g{GMb, (const bf16*)(ws + WS_WA) + (size_t)l * D * GW, GW, GW, GW}; pg8::StaticOrder S; S.init(M, D, GW, GW, C.G, cid);
#ifdef DIAG_BR_PLAIN
              pg8::EpiPlain E{MRG, D}; pg8::gemm_phase<pg8::EpiPlain, pg8::StaticOrder>(C.lds + RING_OFF, g, S, E, C.wave); }
#else
              pg8::EpiGate<0> E{MRG, PROJ + PC_GA}; pg8::gemm_phase<pg8::EpiGate<0>, pg8::StaticOrder>(C.lds + RING_OFF, g, S, E, C.wave); }
#endif
            if (EN_BR2) { pg8::Gemm g{ATTb, (const bf16*)(ws + WS_WB) + (size_t)l * D * GW, GW, GW, GW}; pg8::StaticOrder S; S.init(M, D, GW, GW, C.G, cid);
              pg8::EpiGate<1> E{MRG, PROJ + PC_GB}; pg8::gemm_phase<pg8::EpiGate<1>, pg8::StaticOrder>(C.lds + RING_OFF, g, S, E, C.wave); }
            SEAM(pb + 4);
        }
        if (EN_OUT && IN(pb + 5)) { FRESH();
            pg8::Gemm g{MRG, (const bf16*)(ws + WS_WO) + (size_t)l * D * D, D, D, D}; pg8::StaticOrder S; S.init(M, D, D, D, C.G, cid);
            pg8::EpiPlain E{Yb, D}; _Pragma("unroll") for (int rep_ = 0; rep_ < PR_OUT; ++rep_) pg8::gemm_phase<pg8::EpiPlain, pg8::StaticOrder>(C.lds + RING_OFF, g, S, E, C.wave);
            SEAM(pb + 5);
        }
        if (l == 0) {
            if (EN_T1 && IN(7)) { FRESH(); phase_resid<1, false, true, true>(C, INF(0), xbf, Yb, nullptr, D, mod + 2 * D, INF(6) + l * D, INF(7) + l * D, mod + 4 * D, mod + 3 * D, H1b, nullptr, nullptr, nullptr, nullptr, nullptr, nullptr, WSF(WS_SA) + M); SEAM(7); }
            if (EN_FFN && IN(8)) { FRESH();
                pg8::Gemm g{H1b, (const bf16*)(ws + WS_WGU), D / 2, D / 2, D / 2, WSF(WS_SA) + M, slots_max(WSF(WS_AMAX), C.G, C.lane) * (1.0f / 127.0f)}; pg8::StaticOrder S; S.init(M, 2 * FFP, D / 2, D / 2, C.G, cid);
#ifdef DIAG_FFN1_PLAIN
#ifndef DIAG_PLAIN_SHIFT
#define DIAG_PLAIN_SHIFT 0
#endif
                pg8::EpiPlain E{(bf16*)(ws + WS_ACT) + DIAG_PLAIN_SHIFT, 2 * FFP}; pg8::gemm_phase<pg8::EpiPlain, pg8::StaticOrder>(C.lds + RING_OFF, g, S, E, C.wave);
#else
#ifdef DIAG_FFN1_NOALIGN
                pg8::EpiSwiGLU E{(bf16*)(ws + WS_ACT), FFP}; pg8::gemm_phase<pg8::EpiSwiGLU, pg8::StaticOrder, false, true>(C.lds + RING_OFF, g, S, E, C.wave);
#else
                pg8::EpiSwiGLU E{(bf16*)(ws + WS_ACT), ACT_LD}; _Pragma("unroll") for (int rep_ = 0; rep_ < PR_FFN1; ++rep_) pg8::gemm_phase<pg8::EpiSwiGLU, pg8::StaticOrder, true, PG8_SP2_DEFAULT, false, true>(C.lds + RING_OFF, g, S, E, C.wave);
                moe_tail(C, ptab, cid, 128, TB_FFN, TAIL_FFN);
#endif
#ifdef DIAG_FFN1_TWICE
                { pg8::EpiSwiGLU E2{(bf16*)(ws + DIAG_TWIN_OFF), FFP}; pg8::gemm_phase<pg8::EpiSwiGLU, pg8::StaticOrder>(C.lds + RING_OFF, g, S, E2, C.wave); }
#endif
#endif
                SEAM(8);
            }
            if (EN_FFN && EN_FFN2 && IN(9)) { FRESH();
                pg8::Gemm g{(const bf16*)(ws + WS_ACT), (const bf16*)(ws + WS_WD), FFP, FFP, FFP}; pg8::StaticOrder S; S.init(M, D, FFP, FFP, C.G, cid);
                pg8::EpiPlain E{Yb, D}; _Pragma("unroll") for (int rep_ = 0; rep_ < PR_FFN2; ++rep_) pg8::gemm_phase<pg8::EpiPlain, pg8::StaticOrder>(C.lds + RING_OFF, g, S, E, C.wave);
                SEAM(9);
            }
            if (EN_T1 && IN(10)) { FRESH(); const float* mod1 = MOD + 6 * D;
                phase_resid<1, true, true, true>(C, xbf, xbf, Yb, nullptr, D, mod + 5 * D, INF(8) + l * D, INF(5) + D, mod1 + 1 * D, mod1 + 0 * D, H1b, nullptr, nullptr, nullptr, nullptr, nullptr, nullptr, WSF(WS_SA)); SEAM(10); }
        } else {
            int* topi = (int*)(ws + WS_TOPI); float* topg = (float*)(ws + WS_TOPG); int* list = (int*)(ws + WS_LIST);
            bf16* ACTM = (bf16*)(ws + WS_ACTM); bf16* Y2 = (bf16*)(ws + WS_Y2);
            if (EN_T2 && IN(16)) { FRESH(); phase_resid<2, true, true, true>(C, xbf, xbf, Yb, nullptr, D, mod + 2 * D, INF(6) + l * D, INF(7) + l * D, mod + 4 * D, mod + 3 * D, Hb, INF(24), INF(25), topi, topg, list, C.ctl + CW_MOE, WSF(WS_SA) + 2 * M); SEAM(16); }
            if (EN_T2 && IN(17)) { FRESH(); phase_moe_lists(C, list, WSF(WS_SA) + 2 * M, WSF(WS_LSA), WSF(WS_LHS), HID_KAPPA * slots_sum(WSF(WS_AMAX) + 1280, C.G, C.lane) * (1.0f / ((float)W13_SAMPLES * 127.0f))); SEAM(17); }
            if (EN_MOE && IN(18)) { FRESH();
                moe_tab_build(C, list, moetab);
                const int np = moetab[8];
                pg8::Gemm g{Hb, (const bf16*)(ws + WS_W13), D / 2, D / 2, D / 2, WSF(WS_SA) + 2 * M, slots_max(WSF(WS_AMAX) + 256, C.G, C.lane) * (W13_RANGE / 127.0f)};
                MoeOrder S; S.S.init(np * 256, 2 * EFF, D / 2, D / 2, C.G, cid); S.p0 = 0; S.estride = (size_t)2 * EFF * D; S.absA = 1; S.tab = moetab; S.list = list; S.rowbytes = D; S.lsa = WSF(WS_LSA); S.limit = (long)np * 2 * EFF / 256;
                pg8::EpiSwiGLU8 E{(unsigned char*)ACTM, EFF, WSF(WS_LHS), moetab, M}; _Pragma("unroll") for (int rep_ = 0; rep_ < PR_MOE1; ++rep_) pg8::gemm_phase<pg8::EpiSwiGLU8, MoeOrder, true, true, true, true>(C.lds + RING_OFF, g, S, E, C.wave);
                SEAM(19);
            }
            if (EN_MOE && IN(20)) { FRESH();
                moe_tab_build(C, list, moetab);
                const int np = moetab[8]; const long U = (long)np * 4, nfull = (U / C.G) * C.G; const int nleft = (int)(U - nfull);
                const float b2 = slots_max(WSF(WS_AMAX) + 1024, C.G, C.lane) * (W13_RANGE / 127.0f);
                MoeOrder S; S.S.init(np * 256, D, EFF / 2, EFF / 2, C.G, cid); S.p0 = 0; S.estride = (size_t)D * EFF; S.absA = 1; S.tab = moetab; S.list = list; S.rowbytes = 0; S.lsa = WSF(WS_LHS); const int nsplit = (7 * nleft <= C.G) ? 7 : 2;
                S.limit = (nsplit * nleft <= C.G) ? nfull : U;
                { pg8::Gemm g{ACTM, (const bf16*)(ws + WS_W2), EFF / 2, EFF / 2, EFF / 2, nullptr, b2};
                  pg8::EpiMoeDown E{Y2, list, topg, moetab, M}; _Pragma("unroll") for (int rep_ = 0; rep_ < PR_MOE2; ++rep_) pg8::gemm_phase<pg8::EpiMoeDown, MoeOrder, true, PG8_SP2_DEFAULT, false, true, true>(C.lds + RING_OFF, g, S, E, C.wave); }
                if (EN_LEFT && nsplit * nleft <= C.G && cid < nsplit * nleft) { const int j = cid / nsplit, kq = cid - j * nsplit, kb = EFF / nsplit; OneUnit O1; O1.S = S; O1.L = nfull + j; {
                    pg8::Gemm g{(const bf16*)((const unsigned char*)ACTM + kq * kb), (const bf16*)(ws + WS_W2 + kq * kb), EFF / 2, EFF / 2, kb / 2, nullptr, b2};
                    pg8::EpiBf16Tile E{(bf16*)(ws + WS_SP) + (size_t)cid * 256 * 256}; pg8::gemm_phase<pg8::EpiBf16Tile, OneUnit, true, PG8_SP2_DEFAULT, false, true, true>(C.lds + RING_OFF, g, O1, E, C.wave); } }
                SEAM(20);
            }
            if (EN_MOE && IN(21)) { FRESH();
                moe_tab_build(C, list, moetab);
                const int np = moetab[8]; const long U = (long)np * 4, nfull = (U / C.G) * C.G; const int nleft = (int)(U - nfull);
                const int nsplit = (7 * nleft <= C.G) ? 7 : 2;
                if (nsplit * nleft <= C.G && nleft > 0) { MoeOrder S; S.S.init(np * 256, D, EFF / 2, EFF / 2, C.G, cid); S.p0 = 0; S.estride = (size_t)D * EFF; S.absA = 1; S.tab = moetab; S.list = list; S.rowbytes = 0; S.limit = nfull;
                    phase_moe_reduce(C, S, nfull, nleft, nsplit, (const bf16*)(ws + WS_SP), list, topg, moetab, Y2); }
                SEAM(21);
            }
            if (EN_FIN && IN(22)) { FRESH(); phase_resid<0, true, false>(C, xbf, xres, Y2, Y2 + D, 2 * D, mod + 5 * D, INF(8) + l * D, nullptr, nullptr, nullptr, nullptr, nullptr, nullptr, nullptr, nullptr, nullptr, nullptr); }
        }
    }
#undef IN
#undef SEAM
#undef INF
}
#ifndef MK_DIAG
#define MK_DIAG 0
#endif
extern "C" void kernel_launch(void* const* d_in, const int* in_sizes, int n_in, void* d_out, int out_size, void* d_ws, size_t ws_size, hipStream_t stream) {
    static int grid = 0;
    if (grid == 0) {
        if (n_in != 29 || in_sizes[0] != M * D || out_size != M * D || ws_size < WS_END) { fprintf(stderr, "kernel_launch: unexpected sizes n_in %d in0 %d out %d ws %zu\n", n_in, n_in > 0 ? in_sizes[0] : -1, out_size, ws_size); grid = -1; return; }
        int dev = 0, cus = 0, per_cu = 0;
        if (hipGetDevice(&dev) != hipSuccess || hipDeviceGetAttribute(&cus, hipDeviceAttributeMultiprocessorCount, dev) != hipSuccess) { grid = -1; return; }
        if (hipFuncSetAttribute((const void*)mega_fwd, hipFuncAttributeMaxDynamicSharedMemorySize, LDS_BYTES) != hipSuccess) { fprintf(stderr, "hipFuncSetAttribute failed\n"); grid = -1; return; }
        if (hipOccupancyMaxActiveBlocksPerMultiprocessor(&per_cu, (const void*)mega_fwd, NWAVES * 64, LDS_BYTES) != hipSuccess || per_cu < 1) fprintf(stderr, "occupancy query reports %d\n", per_cu);
        (void)hipGetLastError();
        grid = cus;
    }
    if (grid < 0) return;
    if (hipMemsetAsync((char*)d_ws + WS_CTL, 0, CTL_ZERO_BYTES, stream) != hipSuccess) return;
    Args a{};
    for (int i = 0; i < 29; ++i) a.in[i] = d_in[i];
    a.out = (float*)d_out; a.ws = (unsigned char*)d_ws;
#if MK_DIAG
    diag_run(a, grid, stream);
#else
    a.ph_lo = 0; a.ph_hi = NPHASES;
    hipLaunchKernelGGL(mega_fwd, dim3(grid), dim3(NWAVES * 64), LDS_BYTES, stream, a);
#endif
}
```

```cpp
#include <hip/hip_runtime.h>
#include <hip/hip_bf16.h>
#include <cstdio>
#include <cstdint>
#include <cmath>
__device__ __forceinline__ int xor_idx16() { int i_; asm volatile("v_mbcnt_lo_u32_b32 %0, -1, 0\n\tv_mbcnt_hi_u32_b32 %0, -1, %0\n\tv_xor_b32 %0, 16, %0\n\tv_lshlrev_b32 %0, 2, %0" : "=v"(i_)); return i_; }
__device__ __forceinline__ int xor_idx32() { int i_; asm volatile("v_mbcnt_lo_u32_b32 %0, -1, 0\n\tv_mbcnt_hi_u32_b32 %0, -1, %0\n\tv_xor_b32 %0, 32, %0\n\tv_lshlrev_b32 %0, 2, %0" : "=v"(i_)); return i_; }
__device__ __forceinline__ float bperm_f(int idx, float v) { return __builtin_bit_cast(float, __builtin_amdgcn_ds_bpermute(idx, __builtin_bit_cast(int, v))); }
__device__ __forceinline__ float xsum32(float v) { return v + bperm_f(xor_idx32(), v); }
__device__ __forceinline__ float xmax32(float v) { return fmaxf(v, bperm_f(xor_idx32(), v)); }
#define dpp_f(v, ctrl, rmask, bmask) __builtin_bit_cast(float, __builtin_amdgcn_update_dpp(0, __builtin_bit_cast(int, (float)(v)), (ctrl), (rmask), (bmask), false))
__device__ __forceinline__ unsigned q8x4(float a, float b, float c, float d, float inv) {
    const int qa = __builtin_amdgcn_fmed3f(rintf(a * inv), -127.f, 127.f), qb = __builtin_amdgcn_fmed3f(rintf(b * inv), -127.f, 127.f), qc = __builtin_amdgcn_fmed3f(rintf(c * inv), -127.f, 127.f), qd = __builtin_amdgcn_fmed3f(rintf(d * inv), -127.f, 127.f);
    return (unsigned)(qa & 255) | ((unsigned)(qb & 255) << 8) | ((unsigned)(qc & 255) << 16) | ((unsigned)(qd & 255) << 24); }
__device__ __forceinline__ float wave_max_nn(float v) {
    float s = fmaxf(v, dpp_f(v, 0x111, 0xf, 0xf)); s = fmaxf(s, dpp_f(v, 0x112, 0xf, 0xf)); s = fmaxf(s, dpp_f(v, 0x113, 0xf, 0xf));
    s = fmaxf(s, dpp_f(s, 0x114, 0xf, 0xe)); s = fmaxf(s, dpp_f(s, 0x118, 0xf, 0xc)); s = fmaxf(s, dpp_f(s, 0x142, 0xa, 0xf)); s = fmaxf(s, dpp_f(s, 0x143, 0xc, 0xf));
    return __builtin_bit_cast(float, __builtin_amdgcn_readlane(__builtin_bit_cast(int, s), 63)); }
namespace pg8 {
#define PG8_LAS __attribute__((address_space(3)))
#ifndef PG8_SP2_DEFAULT
#define PG8_SP2_DEFAULT true
#endif
#ifndef PG8_AUX
#define PG8_AUX 0
#endif
typedef unsigned short bf16_t;
typedef short bf16x8 __attribute__((ext_vector_type(8)));
typedef float f32x4 __attribute__((ext_vector_type(4)));
typedef unsigned u32x4 __attribute__((ext_vector_type(4)));
typedef int i32x4 __attribute__((ext_vector_type(4)));
constexpr int BM = 256, BK = 64, HALF = 128, HTB = HALF * BK * 2  , STAGE_BYTES = 8 * HTB, NXCD = 8, WGM = 8;

__host__ __device__ __forceinline__ int lds_byte(int r, int c) { const int st = (r >> 4) * 2 + (c >> 5), rr = r & 15, cc = c & 31, ob = rr * 64 + cc * 2; return st * 1024 + (ob ^ (((ob >> 9) & 1) << 5)); }
__host__ __device__ __forceinline__ void stage_rc(int b, int& R, int& C) { const int st = b / 1024, sb = b % 1024, swz = sb ^ (((sb >> 9) & 1) << 5); R = (st >> 1) * 16 + swz / 64; C = (st & 1) * 32 + (swz % 64) / 2; }
__host__ __device__ __forceinline__ int perm32(int rho) { const int n = rho >> 4, i = rho & 15; return 8 * (i >> 2) + 4 * n + (i & 3); }


struct Unit { int pm, pn, aux; size_t aoff, boff; };
struct Gemm { const bf16_t* A; const bf16_t* Bt; int lda, ldb, K; const float* rowscale; float bscale; };
struct StaticOrder {
    int nM, nN, nwg, G, c; size_t astep, bstep;
    __device__ void init(int M, int N, int lda, int ldb, int G_, int c_) { nM = M / BM; nN = N / BM; nwg = nM * nN; G = G_; c = c_; astep = (size_t)BM * lda * 2; bstep = (size_t)BM * ldb * 2; }
    __device__ bool next(int i, Unit& u) const { return at((long)i * G + c, u); }
    __device__ bool at(long L, Unit& u) const {
        if (L >= nwg) return false;
        int wgid = (int)L; { const int q = nwg / NXCD, r = nwg % NXCD, xcd = wgid % NXCD, off = wgid / NXCD; wgid = (xcd < r ? xcd * (q + 1) : r * (q + 1) + (xcd - r) * q) + off; }
        const int nig = WGM * nN, gid = wgid / nig, fm = gid * WGM, gsz = (nM - fm) < WGM ? (nM - fm) : WGM;
        u.pm = fm + ((wgid % nig) % gsz); u.pn = (wgid % nig) / gsz; u.aux = 0; u.aoff = (size_t)u.pm * astep; u.boff = (size_t)u.pn * bstep; return true;
    }
};

typedef float f32x2cv_t __attribute__((ext_vector_type(2))); typedef __bf16 bf16x2cv_t __attribute__((ext_vector_type(2)));
__device__ __forceinline__ unsigned cvt_pk_bf16(float lo, float hi) { const f32x2cv_t v = {lo, hi}; const bf16x2cv_t b = __builtin_convertvector(v, bf16x2cv_t); return __builtin_bit_cast(unsigned, b); }
typedef float f32x2 __attribute__((ext_vector_type(2)));
__device__ __forceinline__ f32x2 gelu_pk(f32x2 v) {
    const f32x2 av = __builtin_elementwise_abs(v), d = av * 0.2316418882f + 1.0f;
    f32x2 t; t.x = __builtin_amdgcn_rcpf(d.x); t.y = __builtin_amdgcn_rcpf(d.y);
    f32x2 q = t * 0.5307027145f + (-0.7265760135f); q = q * t + 0.7107068705f; q = q * t + (-0.142248368f); q = q * t + 0.127414796f; q = q * t;
    const f32x2 s = (v * v) * (-0.72134752044f);
    f32x2 e; e.x = __builtin_amdgcn_exp2f(s.x); e.y = __builtin_amdgcn_exp2f(s.y);
    const f32x2 m = v * (q * e), r = v - m;
    f32x2 o; o.x = v.x < 0.f ? m.x : r.x; o.y = v.y < 0.f ? m.y : r.y; return o;
}
template <class Epi, class Sched, bool ALIGN_EPI = true, bool SP2 = PG8_SP2_DEFAULT, bool GATHER = false, bool I8 = false, bool PSC = false>
__device__ __forceinline__ void gemm_phase(PG8_LAS unsigned char* lds, const Gemm g, const Sched& S, const Epi& E, const int wave_id) {
    int ln_; asm volatile("v_mbcnt_lo_u32_b32 %0, -1, 0\n\tv_mbcnt_hi_u32_b32 %0, -1, %0" : "=v"(ln_)); const int tid_ = wave_id * 64 + ln_;
    const int tid = tid_, wid = __builtin_amdgcn_readfirstlane(tid >> 6), lane = tid & 63, wr = wid >> 2, wc = wid & 3, fr = lane & 15, fq = lane >> 4;
    const int K = g.K, nt = K / BK;
    unsigned voffA[2], voffB[2];
#pragma unroll
    for (int i = 0; i < 2; ++i) { int R, C; stage_rc(tid * 16 + i * 8192, R, C); const int Rb = Epi::PERM ? ((R & ~31) + perm32(R & 31)) : R;
        voffA[i] = (unsigned)(R * g.lda + C) * 2u; voffB[i] = (unsigned)(Rb * g.ldb + C) * 2u; }
    unsigned vg[2][2] = {{0u, 0u}, {0u, 0u}}, vn[2][2] = {{0u, 0u}, {0u, 0u}}; int gR[2], gC[2];
#pragma unroll
    for (int i = 0; i < 2; ++i) { stage_rc(tid * 16 + i * 8192, gR[i], gC[i]); }
    const size_t kstep = (size_t)(BK * 2);
    const size_t hstepA = (size_t)HALF * g.lda * 2, hstepB = (size_t)HALF * g.ldb * 2;
    const unsigned ldsw = (unsigned)wid * 1024u;
    const int aoff = lds_byte(wr * 64 + fr, fq * 8), boff = lds_byte(wc * 32 + fr, fq * 8);
#define PG8_SA(b, h) (((b) * 2 + (h)) * HTB)
#define PG8_SB(b, h) ((4 + (b) * 2 + (h)) * HTB)
#define PG8_STAGE(bufoff, gbase, voff) do { _Pragma("unroll") for (int _i = 0; _i < 2; ++_i) \
        __builtin_amdgcn_global_load_lds((const unsigned*)((const char*)(gbase) + (voff)[_i]), (PG8_LAS unsigned*)(lds + (bufoff) + ldsw + _i * 8192), 16, 0, PG8_AUX); } while (0)
#define PG8_LDA(dst, b, h) do { _Pragma("unroll") for (int m = 0; m < 4; ++m) _Pragma("unroll") for (int k = 0; k < 2; ++k) dst[m][k] = *(const PG8_LAS bf16x8*)(lds + PG8_SA(b, h) + aoff + m * 2048 + k * 1024); } while (0)
#define PG8_LDB(dst, b, h) do { _Pragma("unroll") for (int n = 0; n < 2; ++n) _Pragma("unroll") for (int k = 0; k < 2; ++k) dst[n][k] = *(const PG8_LAS bf16x8*)(lds + PG8_SB(b, h) + boff + n * 2048 + k * 1024); } while (0)
#define PG8_MMA(ai, bj, At, Bt) do { __builtin_amdgcn_s_setprio(1); _Pragma("unroll") for (int m = 0; m < 4; ++m) _Pragma("unroll") for (int n = 0; n < 2; ++n) _Pragma("unroll") for (int k = 0; k < 2; ++k) \
        { if constexpr (I8) acc[ai][bj][m][n] = __builtin_bit_cast(f32x4, __builtin_amdgcn_mfma_i32_16x16x64_i8(__builtin_bit_cast(i32x4, Bt[n][k]), __builtin_bit_cast(i32x4, At[m][k]), __builtin_bit_cast(i32x4, acc[ai][bj][m][n]), 0, 0, 0)); \
          else acc[ai][bj][m][n] = __builtin_amdgcn_mfma_f32_16x16x32_bf16(Bt[n][k], At[m][k], acc[ai][bj][m][n], 0, 0, 0); } __builtin_amdgcn_s_setprio(0); } while (0)
#define PG8_WAIT_V(n) asm volatile("s_waitcnt vmcnt(" #n ")" ::: "memory")
#define PG8_WAIT_L(n) asm volatile("s_waitcnt lgkmcnt(" #n ")" ::: "memory")
#define PG8_BAR __builtin_amdgcn_s_barrier()
#define PG8_SCHED __builtin_amdgcn_sched_barrier(0)
    static_assert(!GATHER || SP2, "GATHER is written for the SP2 loop");
    Unit cur, nxt; int ui = 0;
    if (!S.next(0, cur)) return;
    f32x4 acc[2][2][4][2];
#pragma unroll
    for (int a = 0; a < 2; ++a)
#pragma unroll
        for (int b = 0; b < 2; ++b)
#pragma unroll
            for (int m = 0; m < 4; ++m)
#pragma unroll
                for (int n = 0; n < 2; ++n) acc[a][b][m][n] = (f32x4){0.f, 0.f, 0.f, 0.f};
    bf16x8 At[4][2], B0[2][2], B1[2][2];
    const char* cA = (const char*)g.A + (GATHER ? (size_t)0 : cur.aoff); const char* cB = (const char*)g.Bt + cur.boff;
    if constexpr (GATHER) S.avoff(cur, gR, gC, vg);
#define PG8_STAGE_A(bufoff, ptr, h, useNext) do { if constexpr (GATHER) { if (useNext) PG8_STAGE(bufoff, ptr, vn[h]); else PG8_STAGE(bufoff, ptr, vg[h]); } else PG8_STAGE(bufoff, (ptr) + (h) * hstepA, voffA); } while (0)
    if constexpr (SP2) {
        PG8_STAGE(PG8_SB(0, 0), cB, voffB); PG8_STAGE(PG8_SB(0, 1), cB + hstepB, voffB); PG8_STAGE_A(PG8_SA(0, 0), cA, 0, false); PG8_STAGE_A(PG8_SA(0, 1), cA, 1, false);
        if (wr == 1) PG8_BAR;
        PG8_WAIT_V(2); PG8_BAR;
        PG8_STAGE(PG8_SB(1, 0), cB + kstep, voffB); PG8_STAGE_A(PG8_SA(1, 0), cA + kstep, 0, false); PG8_STAGE(PG8_SB(1, 1), cB + hstepB + kstep, voffB);
        PG8_WAIT_V(6); PG8_BAR;
    } else {
        PG8_STAGE(PG8_SB(0, 0), cB, voffB); PG8_STAGE(PG8_SA(0, 0), cA, voffA); PG8_STAGE(PG8_SB(0, 1), cB + hstepB, voffB); PG8_STAGE(PG8_SA(0, 1), cA + hstepA, voffA);
        if (wr == 1) PG8_BAR;
        PG8_WAIT_V(4); PG8_BAR;
        PG8_STAGE(PG8_SB(1, 0), cB + kstep, voffB); PG8_STAGE(PG8_SA(1, 0), cA + kstep, voffA); PG8_STAGE(PG8_SB(1, 1), cB + hstepB + kstep, voffB);
        PG8_WAIT_V(6); PG8_BAR;
    }
    for (;;) {
        const bool has_next = S.next(ui + 1, nxt);
        const char* nA = GATHER ? (const char*)g.A : (has_next ? (const char*)g.A + nxt.aoff : cA); const char* nB = has_next ? (const char*)g.Bt + nxt.boff : cB;
        if constexpr (GATHER) { if (has_next && nxt.aux != cur.aux) S.avoff(nxt, gR, gC, vn); else { vn[0][0] = vg[0][0]; vn[0][1] = vg[0][1]; vn[1][0] = vg[1][0]; vn[1][1] = vg[1][1]; } }
        for (int t = 0; t < nt; t += 2) {
            const bool last = (t == nt - 2);
            const char* a1 = cA + (size_t)(t + 1) * kstep;
            const char* a2 = last ? nA : cA + (size_t)(t + 2) * kstep; const char* b2 = last ? nB : cB + (size_t)(t + 2) * kstep;
            const char* a3 = a2 + kstep; const char* b3 = b2 + kstep;
            if constexpr (SP2) {
            PG8_LDB(B0, 0, 0); PG8_LDB(B1, 0, 1); PG8_SCHED; PG8_LDA(At, 0, 0); PG8_STAGE_A(PG8_SA(1, 1), a1, 1, false);
            PG8_WAIT_V(8); PG8_WAIT_L(0); PG8_BAR; PG8_MMA(0, 0, At, B0); PG8_MMA(0, 1, At, B1); PG8_BAR; PG8_SCHED;
            PG8_LDA(At, 0, 1); PG8_STAGE(PG8_SB(0, 0), b2, voffB); PG8_STAGE(PG8_SB(0, 1), b2 + hstepB, voffB); PG8_STAGE_A(PG8_SA(0, 0), a2, 0, last);
            PG8_WAIT_V(8); PG8_WAIT_L(0); PG8_BAR; PG8_MMA(1, 0, At, B0); PG8_MMA(1, 1, At, B1); PG8_BAR; PG8_SCHED;
            PG8_LDB(B0, 1, 0); PG8_LDB(B1, 1, 1); PG8_SCHED; PG8_LDA(At, 1, 0); PG8_STAGE_A(PG8_SA(0, 1), a2, 1, last);
            PG8_WAIT_V(8); PG8_WAIT_L(0); PG8_BAR; PG8_MMA(0, 0, At, B0); PG8_MMA(0, 1, At, B1); PG8_BAR; PG8_SCHED;
            PG8_LDA(At, 1, 1); PG8_STAGE(PG8_SB(1, 0), b3, voffB); PG8_STAGE(PG8_SB(1, 1), b3 + hstepB, voffB); PG8_STAGE_A(PG8_SA(1, 0), a3, 0, last);
            PG8_WAIT_V(8); PG8_WAIT_L(0); PG8_BAR; PG8_MMA(1, 0, At, B0); PG8_MMA(1, 1, At, B1); PG8_BAR; PG8_SCHED;
            } else {
            PG8_LDB(B0, 0, 0); PG8_SCHED; PG8_LDA(At, 0, 0); PG8_STAGE(PG8_SA(1, 1), a1 + hstepA, voffA);
            PG8_WAIT_L(8); PG8_BAR; PG8_WAIT_L(0); PG8_MMA(0, 0, At, B0); PG8_BAR; PG8_SCHED;
            PG8_LDB(B1, 0, 1); PG8_STAGE(PG8_SB(0, 0), b2, voffB);
            PG8_BAR; PG8_WAIT_L(0); PG8_MMA(0, 1, At, B1); PG8_BAR;
            PG8_LDA(At, 0, 1); PG8_STAGE(PG8_SA(0, 0), a2, voffA);
            PG8_BAR; PG8_WAIT_L(0); PG8_MMA(1, 0, At, B0); PG8_BAR; PG8_SCHED;
            PG8_STAGE(PG8_SB(0, 1), b2 + hstepB, voffB);
            PG8_WAIT_V(6); PG8_BAR; PG8_MMA(1, 1, At, B1); PG8_BAR;
            PG8_LDB(B0, 1, 0); PG8_SCHED; PG8_LDA(At, 1, 0); PG8_STAGE(PG8_SA(0, 1), a2 + hstepA, voffA);
            PG8_WAIT_L(8); PG8_BAR; PG8_WAIT_L(0); PG8_MMA(0, 0, At, B0); PG8_BAR; PG8_SCHED;
            PG8_LDB(B1, 1, 1); PG8_STAGE(PG8_SB(1, 0), b3, voffB);
            PG8_BAR; PG8_WAIT_L(0); PG8_MMA(0, 1, At, B1); PG8_BAR;
            PG8_LDA(At, 1, 1); PG8_STAGE(PG8_SA(1, 0), a3, voffA);
            PG8_BAR; PG8_WAIT_L(0); PG8_MMA(1, 0, At, B0); PG8_BAR; PG8_SCHED;
            PG8_STAGE(PG8_SB(1, 1), b3 + hstepB, voffB);
            PG8_WAIT_V(6); PG8_BAR; PG8_MMA(1, 1, At, B1); PG8_BAR;
            }
        }
        if constexpr (ALIGN_EPI) { if (wr == 0) PG8_BAR; }
        int lnE_; asm volatile("v_mbcnt_lo_u32_b32 %0, -1, 0\n\tv_mbcnt_hi_u32_b32 %0, -1, %0" : "=v"(lnE_)); const int frE = lnE_ & 15, fqE = lnE_ >> 4;
        if constexpr (I8) {
            float rsv[2][4];
            if constexpr (GATHER || PSC) {
#pragma unroll
                for (int a = 0; a < 2; ++a)
#pragma unroll
                    for (int m = 0; m < 4; ++m) rsv[a][m] = S.rowscale_of(cur, wr * 64 + frE + a * HALF + m * 16) * g.bscale;
            } else {
#pragma unroll
                for (int a = 0; a < 2; ++a)
#pragma unroll
                    for (int m = 0; m < 4; ++m) rsv[a][m] = g.rowscale[cur.pm * BM + wr * 64 + frE + a * HALF + m * 16] * g.bscale; }
#pragma unroll
            for (int a = 0; a < 2; ++a)
#pragma unroll
                for (int m = 0; m < 4; ++m)
#pragma unroll
                    for (int b = 0; b < 2; ++b)
#pragma unroll
                        for (int n = 0; n < 2; ++n) acc[a][b][m][n] = __builtin_convertvector(__builtin_bit_cast(i32x4, acc[a][b][m][n]), f32x4) * rsv[a][m]; }
        if constexpr (!Epi::AFTER_DRAIN) { E(acc, cur, wr, wc, frE, fqE); }
        if (!has_next) break;
#pragma unroll
        for (int a = 0; a < 2; ++a)
#pragma unroll
            for (int b = 0; b < 2; ++b)
#pragma unroll
                for (int m = 0; m < 4; ++m)
#pragma unroll
                    for (int n = 0; n < 2; ++n) acc[a][b][m][n] = (f32x4){0.f, 0.f, 0.f, 0.f};
        cur = nxt; cA = nA; cB = nB; ++ui;
        if constexpr (GATHER) { vg[0][0] = vn[0][0]; vg[0][1] = vn[0][1]; vg[1][0] = vn[1][0]; vg[1][1] = vn[1][1]; }
        if constexpr (ALIGN_EPI) { if (wr == 1) PG8_BAR; }
    }
    PG8_WAIT_V(0);
    if constexpr (!ALIGN_EPI) { if (wr == 0) PG8_BAR; }
    PG8_BAR;

#undef PG8_SA
#undef PG8_SB
#undef PG8_STAGE
#undef PG8_STAGE_A
#undef PG8_LDA
#undef PG8_LDB
#undef PG8_MMA
#undef PG8_WAIT_V
#undef PG8_WAIT_L
#undef PG8_BAR
#undef PG8_SCHED
}
typedef unsigned u32x4_t __attribute__((ext_vector_type(4)));
__device__ __forceinline__ u32x4_t pack8(const f32x4& v0, const f32x4& v1) { u32x4_t w; w.x = cvt_pk_bf16(v0[0], v0[1]); w.y = cvt_pk_bf16(v0[2], v0[3]); w.z = cvt_pk_bf16(v1[0], v1[1]); w.w = cvt_pk_bf16(v1[2], v1[3]); return w; }
__device__ __forceinline__ float bf_lo(unsigned w) { return __uint_as_float(w << 16); }
__device__ __forceinline__ float bf_hi(unsigned w) { return __uint_as_float(w & 0xffff0000u); }
__device__ __forceinline__ void unpack8(const u32x4_t& w, f32x4& v0, f32x4& v1) { v0 = (f32x4){bf_lo(w.x), bf_hi(w.x), bf_lo(w.y), bf_hi(w.y)}; v1 = (f32x4){bf_lo(w.z), bf_hi(w.z), bf_lo(w.w), bf_hi(w.w)}; }
__device__ __forceinline__ float sigmoidf_(float x) { return __builtin_amdgcn_rcpf(1.0f + __builtin_amdgcn_exp2f(-1.4426950408889634f * x)); }
__device__ __forceinline__ f32x4 gelu4(const f32x4& v) { const f32x2 a = gelu_pk((f32x2){v[0], v[1]}), b = gelu_pk((f32x2){v[2], v[3]}); return (f32x4){a.x, a.y, b.x, b.y}; }
__device__ __forceinline__ f32x4 sig4(const f32x4& v) { return (f32x4){sigmoidf_(v[0]), sigmoidf_(v[1]), sigmoidf_(v[2]), sigmoidf_(v[3])}; }
__device__ __forceinline__ float sum4(const f32x4& v) { return (v[0] + v[1]) + (v[2] + v[3]); }
__device__ __forceinline__ float red_fq(float s) { s += bperm_f(xor_idx16(), s); return xsum32(s); }

struct EpiProj {
    static constexpr bool PERM = true, AFTER_DRAIN = false;
    bf16_t* P; bf16_t* KPE; float* sumv; float* ssqv; float* ssqq; float* ssqkv; const float* cosT; const float* sinT;
    __device__ __forceinline__ void operator()(const f32x4 (&acc)[2][2][4][2], const Unit& u, int wr, int wc, int fr, int fq) const {
        const int row0 = u.pm * BM + wr * 64 + fr, col0 = u.pn * BM + wc * 32 + 8 * fq, pn = u.pn;
#pragma unroll
        for (int ai = 0; ai < 2; ++ai)
#pragma unroll
            for (int m = 0; m < 4; ++m) {
                const int row = row0 + ai * HALF + m * 16; bf16_t* rowp = P + (size_t)row * 3840 + col0;
                if (pn < 4) {
                    float s = 0.f, q = 0.f;
#pragma unroll
                    for (int bj = 0; bj < 2; ++bj) { const f32x4 v0 = gelu4(acc[ai][bj][m][0]), v1 = gelu4(acc[ai][bj][m][1]); *(u32x4_t*)(rowp + bj * HALF) = pack8(v0, v1);
                        s += sum4(v0) + sum4(v1); q += sum4(v0 * v0) + sum4(v1 * v1); }
                    if (pn >= 2) { s = red_fq(s); q = red_fq(q); if (fq == 0) { sumv[row * 8 + (pn - 2) * 4 + wc] = s; ssqv[row * 8 + (pn - 2) * 4 + wc] = q; } }
                } else if (pn < 12) {
#pragma unroll
                    for (int bj = 0; bj < 2; ++bj) *(u32x4_t*)(rowp + bj * HALF) = pack8(sig4(acc[ai][bj][m][0]), sig4(acc[ai][bj][m][1]));
                } else if (pn < 14) {
                    float q = 0.f;
#pragma unroll
                    for (int bj = 0; bj < 2; ++bj) { const f32x4 v0 = acc[ai][bj][m][0], v1 = acc[ai][bj][m][1]; *(u32x4_t*)(rowp + bj * HALF) = pack8(v0, v1); q += sum4(v0 * v0) + sum4(v1 * v1); }
                    q = red_fq(q); if (fq == 0) { if (pn == 12) ssqkv[row * 4 + wc] = q; else ssqq[row * 8 + wc] = q; }
                } else {
                    { const f32x4 v0 = acc[ai][0][m][0], v1 = acc[ai][0][m][1]; *(u32x4_t*)(rowp) = pack8(v0, v1); float q = sum4(v0 * v0) + sum4(v1 * v1); q = red_fq(q); if (fq == 0) ssqq[row * 8 + 4 + wc] = q; }
                    if (wc == 0) { const f32x4 v0 = acc[ai][1][m][0], v1 = acc[ai][1][m][1];
                        const f32x4 cs = *(const f32x4*)(cosT + (size_t)row * 16 + 4 * fq), sn = *(const f32x4*)(sinT + (size_t)row * 16 + 4 * fq);
                        const f32x4 o0 = (f32x4){v0[0] * cs[0] - v0[1] * sn[0], v0[1] * cs[0] + v0[0] * sn[0], v0[2] * cs[1] - v0[3] * sn[1], v0[3] * cs[1] + v0[2] * sn[1]};
                        const f32x4 o1 = (f32x4){v1[0] * cs[2] - v1[1] * sn[2], v1[1] * cs[2] + v1[0] * sn[2], v1[2] * cs[3] - v1[3] * sn[3], v1[3] * cs[3] + v1[2] * sn[3]};
                        *(u32x4_t*)(KPE + (size_t)row * 32 + 8 * fq) = pack8(o0, o1); }
                }
#ifndef DIAG_NOFENCE
                asm volatile("" ::: "memory");
#endif
            }
    }
};
struct EpiQ {
    static constexpr bool PERM = true, AFTER_DRAIN = false;
    bf16_t* Q; const float* ssqq; const float* cosT; const float* sinT; float c2;
    __device__ __forceinline__ void operator()(const f32x4 (&acc)[2][2][4][2], const Unit& u, int wr, int wc, int fr, int fq) const {
        const int row0 = u.pm * BM + wr * 64 + fr, col0 = u.pn * BM + wc * 32 + 8 * fq;
#pragma unroll
        for (int ai = 0; ai < 2; ++ai)
#pragma unroll
            for (int m = 0; m < 4; ++m) {
                const int row = row0 + ai * HALF + m * 16; const f32x4 qa = *(const f32x4*)(ssqq + row * 8), qb = *(const f32x4*)(ssqq + row * 8 + 4);
                const float sc = c2 * __builtin_amdgcn_rsqf((((qa[0] + qa[1]) + (qa[2] + qa[3])) + ((qb[0] + qb[1]) + (qb[2] + qb[3]))) * (1.0f / 384.0f) + 1e-6f);
#pragma unroll
                for (int bj = 0; bj < 2; ++bj) { const int c = col0 + bj * HALF, off = c % 96; f32x4 v0 = acc[ai][bj][m][0] * sc, v1 = acc[ai][bj][m][1] * sc;
                    if (off >= 64) { const int j0 = (off - 64) >> 1; const f32x4 cs = *(const f32x4*)(cosT + (size_t)row * 16 + j0), sn = *(const f32x4*)(sinT + (size_t)row * 16 + j0);
                        const f32x4 o0 = (f32x4){v0[0] * cs[0] - v0[1] * sn[0], v0[1] * cs[0] + v0[0] * sn[0], v0[2] * cs[1] - v0[3] * sn[1], v0[3] * cs[1] + v0[2] * sn[1]};
                        const f32x4 o1 = (f32x4){v1[0] * cs[2] - v1[1] * sn[2], v1[1] * cs[2] + v1[0] * sn[2], v1[2] * cs[3] - v1[3] * sn[3], v1[3] * cs[3] + v1[2] * sn[3]};
                        v0 = o0; v1 = o1; }
                    *(u32x4_t*)(Q + (size_t)row * 768 + c) = pack8(v0, v1); }
                asm volatile("" ::: "memory");
            }
    }
};
struct EpiKV {
    static constexpr bool PERM = true, AFTER_DRAIN = false;
    bf16_t* KN; bf16_t* VV; const float* ssqkv; float* kmaxs;
    __device__ __forceinline__ void operator()(const f32x4 (&acc)[2][2][4][2], const Unit& u, int wr, int wc, int fr, int fq) const {
        const int row0 = u.pm * BM + wr * 64 + fr, col0 = (u.pn & 1) * BM + wc * 32 + 8 * fq; bf16_t* base = (u.pn < 2) ? KN : VV;
        float mx0 = 0.f, mx1 = 0.f;
#pragma unroll
        for (int ai = 0; ai < 2; ++ai)
#pragma unroll
            for (int m = 0; m < 4; ++m) {
                const int row = row0 + ai * HALF + m * 16; const f32x4 qa = *(const f32x4*)(ssqkv + row * 4); const float sc = __builtin_amdgcn_rsqf(((qa[0] + qa[1]) + (qa[2] + qa[3])) * (1.0f / 256.0f) + 1e-6f);
                const f32x4 a0 = acc[ai][0][m][0] * sc, a1 = acc[ai][0][m][1] * sc, b0 = acc[ai][1][m][0] * sc, b1 = acc[ai][1][m][1] * sc;
                *(u32x4_t*)(base + (size_t)row * 512 + col0) = pack8(a0, a1); *(u32x4_t*)(base + (size_t)row * 512 + col0 + HALF) = pack8(b0, b1);
                if (u.pn < 2) { mx0 = fmaxf(mx0, red_fq(sum4(a0 * a0) + sum4(a1 * a1))); mx1 = fmaxf(mx1, red_fq(sum4(b0 * b0) + sum4(b1 * b1))); }
                asm volatile("" ::: "memory");
            }
        if (u.pn < 2) { mx0 = wave_max_nn(mx0); mx1 = wave_max_nn(mx1);
            if ((fr | fq) == 0) { float* kp = kmaxs + ((2 * (4 * u.pn + (wc >> 1)) + (wc & 1)) * 64 + u.pm) * 2 + wr; kp[0] = mx0; kp[4 * 128] = mx1; } }
    }
};
template <int MODE> struct EpiGate {
    static constexpr bool PERM = true, AFTER_DRAIN = false;
    bf16_t* O; const bf16_t* G;
    __device__ __forceinline__ void operator()(const f32x4 (&acc)[2][2][4][2], const Unit& u, int wr, int wc, int fr, int fq) const {
        const int row0 = u.pm * BM + wr * 64 + fr, col0 = u.pn * BM + wc * 32 + 8 * fq;
#pragma unroll
        for (int ai = 0; ai < 2; ++ai)
#pragma unroll
            for (int m = 0; m < 4; ++m) {
                const int row = row0 + ai * HALF + m * 16;
#pragma unroll
                for (int bj = 0; bj < 2; ++bj) { const int c = col0 + bj * HALF; f32x4 g0, g1; unpack8(*(const u32x4_t*)(G + (size_t)row * 3840 + c), g0, g1);
                    f32x4 v0 = acc[ai][bj][m][0] * g0, v1 = acc[ai][bj][m][1] * g1;
                    if (MODE == 1) { f32x4 t0, t1; unpack8(*(const u32x4_t*)(O + (size_t)row * 1024 + c), t0, t1); v0 += t0; v1 += t1; }
                    *(u32x4_t*)(O + (size_t)row * 1024 + c) = pack8(v0, v1); }
                asm volatile("" ::: "memory");
            }
    }
};
struct EpiPlain {
    static constexpr bool PERM = true, AFTER_DRAIN = false;
    bf16_t* O; int ldc;
    __device__ __forceinline__ void operator()(const f32x4 (&acc)[2][2][4][2], const Unit& u, int wr, int wc, int fr, int fq) const {
        const int row0 = u.pm * BM + wr * 64 + fr, col0 = u.pn * BM + wc * 32 + 8 * fq;
#pragma unroll
        for (int ai = 0; ai < 2; ++ai)
#pragma unroll
            for (int m = 0; m < 4; ++m) {
                const int row = row0 + ai * HALF + m * 16;
#pragma unroll
                for (int bj = 0; bj < 2; ++bj) *(u32x4_t*)(O + (size_t)row * ldc + col0 + bj * HALF) = pack8(acc[ai][bj][m][0], acc[ai][bj][m][1]);
            }
    }
};
struct EpiSwiGLU {
    static constexpr bool PERM = true, AFTER_DRAIN = false;
    bf16_t* O; int ldc;
    __device__ __forceinline__ void operator()(const f32x4 (&acc)[2][2][4][2], const Unit& u, int wr, int wc, int fr, int fq) const {
        const int row0 = u.pm * BM + wr * 64 + fr, col0 = u.pn * HALF + wc * 32 + 8 * fq;
#pragma unroll
        for (int ai = 0; ai < 2; ++ai)
#pragma unroll
            for (int m = 0; m < 4; ++m) {
                const int row = row0 + ai * HALF + m * 16;
                const f32x4 g0 = acc[ai][0][m][0], g1 = acc[ai][0][m][1];
#ifdef DIAG_NOSIG
#if DIAG_NOSIG == 2
                const f32x4 v0 = g0, v1 = g1;
#elif DIAG_NOSIG == 3
                const f32x4 v0 = acc[ai][1][m][0], v1 = acc[ai][1][m][1];
#else
                const f32x4 v0 = g0 * acc[ai][1][m][0], v1 = g1 * acc[ai][1][m][1];
#endif
#else
                const f32x4 v0 = g0 * sig4(g0) * acc[ai][1][m][0], v1 = g1 * sig4(g1) * acc[ai][1][m][1];
#endif
#ifdef DIAG_SWIGLU_WIDE
#ifndef DIAG_WIDE_SHIFT
#define DIAG_WIDE_SHIFT 0
#endif
                *(u32x4_t*)(O + (size_t)row * (2 * ldc) + u.pn * BM + DIAG_WIDE_SHIFT + wc * 32 + 8 * fq) = pack8(v0, v1);
#ifndef DIAG_WIDE_8
                *(u32x4_t*)(O + (size_t)row * (2 * ldc) + u.pn * BM + wc * 32 + 8 * fq + HALF) = pack8(acc[ai][1][m][0], acc[ai][1][m][1]);
#endif
#else
                *(u32x4_t*)(O + (size_t)row * ldc + col0) = pack8(v0, v1);
#endif
#ifdef DIAG_STORE_NOP
                asm volatile("s_nop 7\n\ts_nop 7" ::: "memory");
#endif
            }
    }
};
struct EpiSwiGLU8s {
    static constexpr bool PERM = true, AFTER_DRAIN = false;
    unsigned char* O; int ldc; const float* hsc;
    __device__ __forceinline__ void operator()(const f32x4 (&acc)[2][2][4][2], const Unit& u, int wr, int wc, int fr, int fq) const {
        const int row0 = u.pm * BM + wr * 64 + fr, col0 = u.pn * HALF + wc * 32 + 8 * fq;
        float inv[2][4];
#pragma unroll
        for (int ai = 0; ai < 2; ++ai)
#pragma unroll
            for (int m = 0; m < 4; ++m) { const float sc = hsc[row0 + ai * HALF + m * 16]; inv[ai][m] = sc > 0.f ? __builtin_amdgcn_rcpf(sc) : 0.f; }
#pragma unroll
        for (int ai = 0; ai < 2; ++ai)
#pragma unroll
            for (int m = 0; m < 4; ++m) {
                const int row = row0 + ai * HALF + m * 16; const f32x4 g0 = acc[ai][0][m][0], g1 = acc[ai][0][m][1];
                const f32x4 v0 = g0 * sig4(g0) * acc[ai][1][m][0], v1 = g1 * sig4(g1) * acc[ai][1][m][1]; const float iv = inv[ai][m];
                *(unsigned long long*)(O + (size_t)row * ldc + col0) = (unsigned long long)q8x4(v0[0], v0[1], v0[2], v0[3], iv) | ((unsigned long long)q8x4(v1[0], v1[1], v1[2], v1[3], iv) << 32);
                asm volatile("" ::: "memory");
            }
    }
};
struct EpiSwiGLU8 {
    static constexpr bool PERM = true, AFTER_DRAIN = false;
    unsigned char* O; int ldc; const float* lhs; const __attribute__((address_space(3))) int* tab; int mrows;
    __device__ __forceinline__ void operator()(const f32x4 (&acc)[2][2][4][2], const Unit& u, int wr, int wc, int fr, int fq) const {
        int e = 0;
#pragma unroll
        for (int q = 1; q < 8; ++q) e += (u.aux >= tab[q]) ? 1 : 0;
        e = __builtin_amdgcn_readfirstlane(e);
        const int rl0 = wr * 64 + fr, pos0 = (u.aux - tab[e]) * BM, cnt = tab[16 + e], row0 = u.pm * BM + rl0, col0 = u.pn * HALF + wc * 32 + 8 * fq;
        float inv[2][4];
#pragma unroll
        for (int ai = 0; ai < 2; ++ai)
#pragma unroll
            for (int m = 0; m < 4; ++m) { const int i = pos0 + rl0 + ai * HALF + m * 16; const float sc = (i < cnt) ? lhs[e * mrows + i] : 0.f; inv[ai][m] = sc > 0.f ? __builtin_amdgcn_rcpf(sc) : 0.f; }
#pragma unroll
        for (int ai = 0; ai < 2; ++ai)
#pragma unroll
            for (int m = 0; m < 4; ++m) {
                const int row = row0 + ai * HALF + m * 16; const f32x4 g0 = acc[ai][0][m][0], g1 = acc[ai][0][m][1];
                const f32x4 v0 = g0 * sig4(g0) * acc[ai][1][m][0], v1 = g1 * sig4(g1) * acc[ai][1][m][1]; const float iv = inv[ai][m];
                *(unsigned long long*)(O + (size_t)row * ldc + col0) = (unsigned long long)q8x4(v0[0], v0[1], v0[2], v0[3], iv) | ((unsigned long long)q8x4(v1[0], v1[1], v1[2], v1[3], iv) << 32);
                asm volatile("" ::: "memory");
            }
    }
};
struct EpiMoeDown {
    static constexpr bool PERM = true, AFTER_DRAIN = false;
    bf16_t* Y2; const int* list; const float* topg; const __attribute__((address_space(3))) int* tab; int mrows;
    __device__ __forceinline__ void operator()(const f32x4 (&acc)[2][2][4][2], const Unit& u, int wr, int wc, int fr, int fq) const {
        int e = 0;
#pragma unroll
        for (int q = 1; q < 8; ++q) e += (u.aux >= tab[q]) ? 1 : 0;
        e = __builtin_amdgcn_readfirstlane(e);
        const int base = (u.aux - tab[e]) * BM + wr * 64 + fr, cnt = tab[16 + e], col0 = u.pn * BM + wc * 32 + 8 * fq;
#pragma unroll
        for (int ai = 0; ai < 2; ++ai)
#pragma unroll
            for (int m = 0; m < 4; ++m) {
                const int i = base + ai * HALF + m * 16;
                if (i < cnt) { const int d = list[e * mrows + i]; const float g = topg[d];
#pragma unroll
                    for (int bj = 0; bj < 2; ++bj) *(u32x4_t*)(Y2 + (size_t)d * 1024 + col0 + bj * HALF) = pack8(acc[ai][bj][m][0] * g, acc[ai][bj][m][1] * g); }
                asm volatile("" ::: "memory");
            }
    }
};
struct EpiF32Tile {
    static constexpr bool PERM = true, AFTER_DRAIN = false;
    float* T;
    __device__ __forceinline__ void operator()(const f32x4 (&acc)[2][2][4][2], const Unit& u, int wr, int wc, int fr, int fq) const {
        const int row0 = wr * 64 + fr, col0 = wc * 32 + 8 * fq;
#pragma unroll
        for (int ai = 0; ai < 2; ++ai)
#pragma unroll
            for (int m = 0; m < 4; ++m) { float* rp = T + (size_t)(row0 + ai * HALF + m * 16) * BM + col0;
#pragma unroll
                for (int bj = 0; bj < 2; ++bj) { *(f32x4*)(rp + bj * HALF) = acc[ai][bj][m][0]; *(f32x4*)(rp + bj * HALF + 4) = acc[ai][bj][m][1]; } }
    }
};
}
namespace attn1 {
using bf16x8 = __attribute__((ext_vector_type(8))) short;
using s16x4 = __attribute__((ext_vector_type(4))) short;
using f32x16 = __attribute__((ext_vector_type(16))) float;
using u32x4 = __attribute__((ext_vector_type(4))) unsigned;
typedef short v4i16_t __attribute__((ext_vector_type(4)));
typedef __attribute__((address_space(3))) unsigned char* lptr;
constexpr int KSLOT = 12288, VSLOT = 8192;
constexpr int L_K = 0, L_V = 2 * KSLOT, L_WS = L_V + 2 * VSLOT, L_OST = L_WS + 8 * 256, L_BYTES = L_OST + 8 * 4096;
__device__ __forceinline__ int crow(int r, int hi) { return (r & 3) + 8 * (r >> 2) + 4 * hi; }
__device__ __forceinline__ unsigned cvtpk(float lo, float hi) { return pg8::cvt_pk_bf16(lo, hi); }
#define ATT_MFMA(a, b, c) __builtin_amdgcn_mfma_f32_32x32x16_bf16(a, b, c, 0, 0, 0)
__device__ __forceinline__ void attn_unit(int h, int qb, const unsigned short* Q, const unsigned short* KN, const unsigned short* KPE, const unsigned short* VV, unsigned short* O, lptr L, const int wave_id) {
    int ln_; asm volatile("v_mbcnt_lo_u32_b32 %0, -1, 0\n\tv_mbcnt_hi_u32_b32 %0, -1, %0" : "=v"(ln_)); const int tid_ = wave_id * 64 + ln_;
    const int tid = tid_, lane = tid & 63, r32 = lane & 31, hi = lane >> 5; const int wid = __builtin_amdgcn_readfirstlane(tid >> 6);
    const int q0 = qb * 256, qrow = q0 + wid * 32 + r32;
    bf16x8 qr[6];
#pragma unroll
    for (int s = 0; s < 6; ++s) qr[s] = *(const bf16x8*)(Q + (size_t)qrow * 768 + h * 96 + s * 16 + hi * 8);
    const int NT = 4 * qb + 4;
    const unsigned short* kn_src = KN + (size_t)lane * 512 + h * 64 + wid * 8;
    const unsigned short* kp_src = KPE + (size_t)lane * 32 + (wid & 3) * 8;
    const unsigned short* v_src = VV + (size_t)(16 * (wid & 3) + (lane >> 2)) * 512 + h * 64 + (wid >> 2) * 32 + (lane & 3) * 8;
    const int kn_dst = L_K + wid * 1024 + lane * 16, kp_dst = L_K + (8 + (wid & 3)) * 1024 + lane * 16, v_dst = L_V + wid * 1024 + lane * 16;
    u32x4 rk = *(const u32x4*)kn_src, rp = *(const u32x4*)kp_src, rv = *(const u32x4*)v_src;
    float mrun = -INFINITY, lrun = 0.f; f32x16 o0 = {}, o1 = {};
    __attribute__((address_space(3))) float* wsf = (__attribute__((address_space(3))) float*)(L + L_WS) + wid * 64;
    const int vrd = ((lane >> 4) & 1) * 32 + (lane & 3) * 8 + (4 * hi + ((lane & 15) >> 2)) * 64;
    for (int t = 0; t < NT; ++t) {
        const int kb = (t & 1) * KSLOT, vb = (t & 1) * VSLOT;
        *(__attribute__((address_space(3))) u32x4*)(L + kb + kn_dst) = rk;
        if (wid < 4) *(__attribute__((address_space(3))) u32x4*)(L + kb + kp_dst) = rp;
        *(__attribute__((address_space(3))) u32x4*)(L + vb + v_dst) = rv;
        __syncthreads();
        if (t + 1 < NT) { const size_t adv = (size_t)(t + 1) * 64; rk = *(const u32x4*)(kn_src + adv * 512); rp = *(const u32x4*)(kp_src + adv * 32); rv = *(const u32x4*)(v_src + adv * 512); }
        if (64 * t > q0 + wid * 32 + 31) continue;
        f32x16 p0 = {}, p1 = {};
#pragma unroll
        for (int s = 0; s < 6; ++s) {
            const bf16x8 k0 = *(const __attribute__((address_space(3))) bf16x8*)(L + kb + L_K + (2 * s + hi) * 1024 + r32 * 16);
            const bf16x8 k1 = *(const __attribute__((address_space(3))) bf16x8*)(L + kb + L_K + (2 * s + hi) * 1024 + 512 + r32 * 16);
            p0 = ATT_MFMA(k0, qr[s], p0); p1 = ATT_MFMA(k1, qr[s], p1);
        }
        if (64 * t + 63 > q0 + wid * 32) {
#pragma unroll
            for (int r = 0; r < 16; ++r) { const int kv = 64 * t + crow(r, hi); if (kv > qrow) p0[r] = -INFINITY; if (kv + 32 > qrow) p1[r] = -INFINITY; }
        }
        float rm = fmaxf(p0[0], p1[0]);
#pragma unroll
        for (int r = 1; r < 16; ++r) rm = fmaxf(rm, fmaxf(p0[r], p1[r]));
        rm = xmax32(rm);
        const float mnew = fmaxf(mrun, rm), alpha = __builtin_amdgcn_exp2f(mrun - mnew);
        float rs = 0.f;
#pragma unroll
        for (int r = 0; r < 16; ++r) { p0[r] = __builtin_amdgcn_exp2f(p0[r] - mnew); p1[r] = __builtin_amdgcn_exp2f(p1[r] - mnew); rs += p0[r] + p1[r]; }
        rs = xsum32(rs);
        lrun = lrun * alpha + rs; mrun = mnew;
        if (hi == 0) wsf[r32] = alpha;
        u32x4 pw0, pw1, pw2, pw3;
        pw0 = (u32x4){cvtpk(p0[0], p0[1]), cvtpk(p0[2], p0[3]), cvtpk(p0[4], p0[5]), cvtpk(p0[6], p0[7])};
        pw1 = (u32x4){cvtpk(p0[8], p0[9]), cvtpk(p0[10], p0[11]), cvtpk(p0[12], p0[13]), cvtpk(p0[14], p0[15])};
        pw2 = (u32x4){cvtpk(p1[0], p1[1]), cvtpk(p1[2], p1[3]), cvtpk(p1[4], p1[5]), cvtpk(p1[6], p1[7])};
        pw3 = (u32x4){cvtpk(p1[8], p1[9]), cvtpk(p1[10], p1[11]), cvtpk(p1[12], p1[13]), cvtpk(p1[14], p1[15])};
        __builtin_amdgcn_fence(__ATOMIC_RELEASE, "wavefront"); __builtin_amdgcn_wave_barrier(); __builtin_amdgcn_fence(__ATOMIC_ACQUIRE, "wavefront");
#pragma unroll
        for (int r = 0; r < 16; ++r) { const float a = wsf[crow(r, hi)]; o0[r] *= a; o1[r] *= a; }
        const bf16x8 pa[4] = {__builtin_bit_cast(bf16x8, pw0), __builtin_bit_cast(bf16x8, pw1), __builtin_bit_cast(bf16x8, pw2), __builtin_bit_cast(bf16x8, pw3)};
#pragma unroll
        for (int ks = 0; ks < 4; ++ks) {
#pragma unroll
            for (int d0 = 0; d0 < 2; ++d0) {
                const s16x4 lo = __builtin_bit_cast(s16x4, __builtin_amdgcn_ds_read_tr16_b64_v4i16((__attribute__((address_space(3))) v4i16_t*)(L + vb + L_V + vrd + d0 * 4096 + ks * 1024)));
                const s16x4 hh = __builtin_bit_cast(s16x4, __builtin_amdgcn_ds_read_tr16_b64_v4i16((__attribute__((address_space(3))) v4i16_t*)(L + vb + L_V + vrd + d0 * 4096 + ks * 1024 + 512)));
                const bf16x8 vf = (bf16x8){lo[0], lo[1], lo[2], lo[3], hh[0], hh[1], hh[2], hh[3]};
                if (d0 == 0) o0 = ATT_MFMA(pa[ks], vf, o0); else o1 = ATT_MFMA(pa[ks], vf, o1);
            }
        }
        __builtin_amdgcn_wave_barrier();
    }
    __syncthreads();
    if (hi == 0) wsf[r32] = 1.0f / lrun;
    __builtin_amdgcn_fence(__ATOMIC_RELEASE, "wavefront"); __builtin_amdgcn_wave_barrier(); __builtin_amdgcn_fence(__ATOMIC_ACQUIRE, "wavefront");
    __attribute__((address_space(3))) unsigned short* stg = (__attribute__((address_space(3))) unsigned short*)(L + L_OST) + wid * 2048;
#pragma unroll
    for (int r = 0; r < 16; ++r) { const int orow = crow(r, hi); const float a = wsf[orow];
        stg[orow * 64 + r32] = (unsigned short)(cvtpk(o0[r] * a, 0.f) & 0xffffu); stg[orow * 64 + 32 + r32] = (unsigned short)(cvtpk(o1[r] * a, 0.f) & 0xffffu); }
    __builtin_amdgcn_fence(__ATOMIC_RELEASE, "wavefront"); __builtin_amdgcn_wave_barrier(); __builtin_amdgcn_fence(__ATOMIC_ACQUIRE, "wavefront");
    unsigned short* Ow = O + (size_t)(q0 + wid * 32) * 512 + h * 64;
#pragma unroll
    for (int i = 0; i < 4; ++i) { const int row = i * 8 + (lane >> 3), ch = lane & 7; const u32x4 v = *(const __attribute__((address_space(3))) u32x4*)(stg + row * 64 + ch * 8); *(u32x4*)(Ow + (size_t)row * 512 + ch * 8) = v; }
    __syncthreads();
}
#undef ATT_MFMA
}
namespace attn3 {
using bf16=__hip_bfloat16;
using bf16x8=__attribute__((ext_vector_type(8)))short;
using s16x4=__attribute__((ext_vector_type(4)))short;
using f32x16=__attribute__((ext_vector_type(16)))float;
using u32x4=__attribute__((ext_vector_type(4)))unsigned;
constexpr int NHEAD=8,D=64,DQK=96,PQ=NHEAD*DQK,PK=NHEAD*D,PR=32;
constexpr int NW=8,QBLK=32,QB=QBLK*NW,KVBLK=64;
__device__ __forceinline__ int crow(int r,int hi){return (r&3)+8*(r>>2)+4*hi;}
#define SBAR() __builtin_amdgcn_sched_barrier(0)
__device__ __forceinline__ void cmask(f32x16&p0,f32x16&p1,int jb,int qrel,int hi){
  const float NEG=-INFINITY; int kb=64*jb+4*hi;
  #pragma unroll
  for(int r=0;r<16;++r){int kv=kb+(r&3)+8*(r>>2); if(kv>qrel)p0[r]=NEG; if(kv+32>qrel)p1[r]=NEG;}
}
__device__ __forceinline__ void cmask1(f32x16&p,int jb,int qrel,int hi,int koff){
  const float NEG=-INFINITY; int kb=64*jb+4*hi+koff;
  #pragma unroll
  for(int r=0;r<16;++r){int kv=kb+(r&3)+8*(r>>2); if(kv>qrel)p[r]=NEG;}
}

constexpr int NSLOT=3, SLOTB=8192, KSLOTB=12288;
#define KOFF(x) (((x)*3)>>1)
constexpr int LDS_K=0, LDS_V=NSLOT*KSLOTB, LDS_WS=LDS_V+NSLOT*SLOTB, LDS_OST=LDS_WS+NW*64*4, LDS_BYTES=LDS_OST+NW*4096;
constexpr float C2=0.10206207261596577f*1.4426950408889634f;
__device__ __forceinline__ void glds16(const void*gsrc,unsigned lds_dst){unsigned keep;
  asm volatile("s_mov_b32 %0, m0\n\ts_mov_b32 m0, %2\n\ts_nop 0\n\tglobal_load_lds_dwordx4 %1, off\n\ts_mov_b32 m0, %0":"=&s"(keep):"v"(gsrc),"s"(lds_dst):"memory");}
__device__ __forceinline__ float max3f(float a,float b,float c){float r;asm("v_max3_f32 %0, %1, %2, %3":"=v"(r):"v"(a),"v"(b),"v"(c));return r;}
__device__ __forceinline__ float max2f(float a,float b){float r;asm("v_max_f32_e32 %0, %1, %2":"=v"(r):"v"(a),"v"(b));return r;}
__device__ __forceinline__ float fadd_s(float a,float b){float r;asm("v_add_f32_e32 %0, %1, %2":"=v"(r):"v"(a),"v"(b));return r;}
__device__ __forceinline__ float fsub_s(float a,float b){float r;asm("v_sub_f32_e32 %0, %1, %2":"=v"(r):"v"(a),"v"(b));return r;}
typedef float f32x2_t __attribute__((ext_vector_type(2))); typedef __bf16 bf16x2_t __attribute__((ext_vector_type(2)));
__device__ __forceinline__ unsigned cvtpk_s(float lo,float hi){f32x2_t v={lo,hi};bf16x2_t b=__builtin_convertvector(v,bf16x2_t);return __builtin_bit_cast(unsigned,b);}
#define WAIT_BAR(N) asm volatile("s_waitcnt vmcnt(" #N ") lgkmcnt(0)\n\ts_barrier":::"memory")
#define WB(A,B) do{ if(wid<4){WAIT_BAR(A);}else{WAIT_BAR(B);} }while(0)

__device__ __forceinline__ void qkt(f32x16&p0,f32x16&p1,const char*Kslot,const bf16x8*qr,const f32x16&negm,int r32,int hi){
  const char*kb=Kslot+hi*1024+r32*16;
  #pragma unroll
  for(int d0=0;d0<6;++d0){
    const bf16x8 b0=*reinterpret_cast<const bf16x8*>(kb+d0*2048);
    const bf16x8 b1=*reinterpret_cast<const bf16x8*>(kb+d0*2048+512);
    if(d0==0){p0=__builtin_amdgcn_mfma_f32_32x32x16_bf16(b0,qr[0],negm,0,0,0);p1=__builtin_amdgcn_mfma_f32_32x32x16_bf16(b1,qr[0],negm,0,0,0);}
    else{p0=__builtin_amdgcn_mfma_f32_32x32x16_bf16(b0,qr[d0],p0,0,0,0);p1=__builtin_amdgcn_mfma_f32_32x32x16_bf16(b1,qr[d0],p1,0,0,0);}}
}
typedef __attribute__((address_space(3))) const char* lds_cptr;
typedef short v4i16_t __attribute__((ext_vector_type(4)));
__device__ __forceinline__ void kload8(bf16x8*kf,lds_cptr kp){
  kf[0]=*(const __attribute__((address_space(3))) bf16x8*)(kp);      kf[1]=*(const __attribute__((address_space(3))) bf16x8*)(kp+512);
  kf[2]=*(const __attribute__((address_space(3))) bf16x8*)(kp+2048); kf[3]=*(const __attribute__((address_space(3))) bf16x8*)(kp+2560);
  kf[4]=*(const __attribute__((address_space(3))) bf16x8*)(kp+4096); kf[5]=*(const __attribute__((address_space(3))) bf16x8*)(kp+4608);
  kf[6]=*(const __attribute__((address_space(3))) bf16x8*)(kp+6144); kf[7]=*(const __attribute__((address_space(3))) bf16x8*)(kp+6656);
  kf[8]=*(const __attribute__((address_space(3))) bf16x8*)(kp+8192); kf[9]=*(const __attribute__((address_space(3))) bf16x8*)(kp+8704);
  kf[10]=*(const __attribute__((address_space(3))) bf16x8*)(kp+10240); kf[11]=*(const __attribute__((address_space(3))) bf16x8*)(kp+10752);
}
__device__ __forceinline__ void kload2(bf16x8*kf,lds_cptr kp,int j){ kf[2*j]=*(const __attribute__((address_space(3))) bf16x8*)(kp+j*2048); kf[2*j+1]=*(const __attribute__((address_space(3))) bf16x8*)(kp+j*2048+512); }
__device__ __forceinline__ s16x4 vtr(lds_cptr p){ return __builtin_bit_cast(s16x4,__builtin_amdgcn_ds_read_tr16_b64_v4i16((__attribute__((address_space(3))) v4i16_t*)p)); }
__device__ __forceinline__ float rowmax(const f32x16&p0,const f32x16&p1){
  float a=max3f(p0[0],p0[1],p1[0]),b=max3f(p0[2],p0[3],p1[1]);a=max3f(a,p1[2],p1[3]);
  #pragma unroll
  for(int r=4;r<16;r+=4){a=max3f(a,p0[r],p0[r+1]);b=max3f(b,p0[r+2],p0[r+3]);a=max3f(a,p1[r],p1[r+1]);b=max3f(b,p1[r+2],p1[r+3]);}
  const float m=max2f(a,b);
  return xmax32(m);
}
__device__ __forceinline__ void pv(f32x16*o,int vb,bf16x8 pa0,bf16x8 pa1,bf16x8 pa2,bf16x8 pa3){
  #pragma unroll
  for(int d0=0;d0<2;++d0){s16x4 lo[4],hi[4];
    #pragma unroll
    for(int ks=0;ks<4;++ks){
      asm volatile("ds_read_b64_tr_b16 %0,%1 offset:%c2":"=&v"(lo[ks]):"v"(vb),"i"(d0*4096+ks*1024):"memory");
      asm volatile("ds_read_b64_tr_b16 %0,%1 offset:%c2":"=&v"(hi[ks]):"v"(vb),"i"(d0*4096+ks*1024+512):"memory");}
    asm volatile("s_waitcnt lgkmcnt(0)":::"memory");SBAR();
    #define PK(k) (bf16x8){lo[k][0],lo[k][1],lo[k][2],lo[k][3],hi[k][0],hi[k][1],hi[k][2],hi[k][3]}
    o[d0]=__builtin_amdgcn_mfma_f32_32x32x16_bf16(pa0,PK(0),o[d0],0,0,0);
    o[d0]=__builtin_amdgcn_mfma_f32_32x32x16_bf16(pa1,PK(1),o[d0],0,0,0);
    o[d0]=__builtin_amdgcn_mfma_f32_32x32x16_bf16(pa2,PK(2),o[d0],0,0,0);
    o[d0]=__builtin_amdgcn_mfma_f32_32x32x16_bf16(pa3,PK(3),o[d0],0,0,0);
    #undef PK
  }
}

#ifndef ATTN_STORE16
#define ATTN_STORE16(p,v) (*(u32x4*)(p)=(v))
#endif
template<int THRL,bool FAST> __device__ __forceinline__ void attn_unit(int h,int qb,const bf16*Q,const bf16*__restrict__ K,const bf16*__restrict__ KP,const bf16*__restrict__ V,bf16*O,char*shm,const int wave_id){
  int ln_; asm volatile("v_mbcnt_lo_u32_b32 %0, -1, 0\n\tv_mbcnt_hi_u32_b32 %0, -1, %0" : "=v"(ln_));
  const int lane=ln_,r32=lane&31,hi=lane>>5; const int wid=wave_id;
  const int q0=qb*QB;
  const bf16*Qw=Q+(long)(q0+wid*QBLK)*PQ+h*DQK;
  const bf16*Kh=K+h*D,*Vh=V+h*D;
  const unsigned lds0=(unsigned)(uintptr_t)shm;
  float*wsf=(float*)(shm+LDS_WS)+wid*64;
  const bf16*ksrc=Kh+(long)lane*PK+wid*8; const bf16*kpsrc=KP+(long)lane*PR+(wid&3)*8;
  const bf16*vsrc=Vh+(long)(16*(wid&3)+(lane>>2))*PK+(wid>>2)*32+(lane&3)*8;
  const unsigned kdst=lds0+LDS_K+wid*1024, kpdst=lds0+LDS_K+(8+(wid&3))*1024, vdst=lds0+LDS_V+wid*1024;
  #define DMA_K(t,slot) do{ glds16(ksrc+(long)(t)*KVBLK*PK,(unsigned)__builtin_amdgcn_readfirstlane(kdst+KOFF(slot))); if(wid<4) glds16(kpsrc+(long)(t)*KVBLK*PR,(unsigned)__builtin_amdgcn_readfirstlane(kpdst+KOFF(slot))); }while(0)
  #define DMA_V(t,slot) glds16(vsrc+(long)(t)*KVBLK*PK,(unsigned)__builtin_amdgcn_readfirstlane(vdst+(slot)))
  const int vb0=(int)(lds0+LDS_V)+((lane>>4)&1)*32+(lane&3)*8+(4*hi+((lane&15)>>2))*64;
  const char*Kbase=shm+LDS_K; bf16x8 kf[12];
  const lds_cptr shm3=(lds_cptr)shm; const lds_cptr kp0=shm3+LDS_K+hi*1024+r32*16; const lds_cptr vp0=shm3+LDS_V+((lane>>4)&1)*32+(lane&3)*8+(4*hi+((lane&15)>>2))*64;
  const int NT=(q0+QB)/KVBLK;
  DMA_K(0,0);DMA_V(0,0);DMA_K(1,SLOTB);
  bf16x8 qr[6];
  #pragma unroll
  for(int d0=0;d0<6;++d0)qr[d0]=*reinterpret_cast<const bf16x8*>(&Qw[(long)r32*PQ+d0*16+hi*8]);
  float mhat=0.f,l_reg=0.f;f32x16 o[2];o[0]=f32x16{};o[1]=f32x16{};const f32x16 negm=f32x16{};
  const int qrel=wid*QBLK+r32;
  #define CMASK(P0,P1,t) do{int jb_=(t)-(NT-4); if(jb_>=0)cmask(P0,P1,jb_,qrel,hi);}while(0)
  #define CMASKH(P,t,ko) do{int jb_=(t)-(NT-4); if(jb_>=0)cmask1(P,jb_,qrel,hi,ko);}while(0)
  bool resc=false;
  #define START(P0,P1) do{ resc=false; if(!FAST){ const float rm=rowmax(P0,P1); \
    { const float dl=rm; mhat=fadd_s(mhat,dl); \
      _Pragma("unroll") for(int r=0;r<16;++r){P0[r]=fsub_s(P0[r],dl);P1[r]=fsub_s(P1[r],dl);} \
      } } \
    _Pragma("unroll") for(int r=0;r<16;++r)P0[r]=__builtin_amdgcn_exp2f(P0[r]); }while(0)
  #define RESC() do{ if(!FAST&&resc){ asm volatile("s_waitcnt lgkmcnt(0)":::"memory"); \
      _Pragma("unroll") for(int d_=0;d_<2;++d_) _Pragma("unroll") for(int r=0;r<16;++r)o[d_][r]*=wsf[crow(r,hi)]; } }while(0)
  f32x16 pA0,pA1,pB0,pB1;
  int sl_prev=0,sl_cur=0,sl_next=SLOTB;
  #define ROT() do{sl_prev=sl_cur;sl_cur=sl_next;sl_next=(sl_next==(NSLOT-1)*SLOTB)?0:sl_next+SLOTB;}while(0)
  DMA_K(2,2*SLOTB);
  WB(5,3);
  qkt(pA0,pA1,Kbase,qr,negm,r32,hi);asm volatile("s_nop 15\n\ts_nop 7":"+v"(pA0),"+v"(pA1));CMASK(pA0,pA1,0);
  START(pA0,pA1);
  _Pragma("unroll") for(int r=0;r<16;++r)pA1[r]=__builtin_amdgcn_exp2f(pA1[r]);
  WAIT_BAR(0);
  DMA_K(3,0);DMA_V(1,SLOTB);
  ROT();
  kload8(kf,kp0+KOFF(sl_cur));
  WB(3,2);
  s16x4 vlo[2],vhi[2]; u32x4 pw0,pw1,pw2,pw3;
  #define PKW(P,B) cvtpk_s(P[B],P[B+1])
  #define PAF(k) __builtin_bit_cast(bf16x8,pw##k)
  #define VFR(i) (bf16x8){vlo[(i)&1][0],vlo[(i)&1][1],vlo[(i)&1][2],vlo[(i)&1][3],vhi[(i)&1][0],vhi[(i)&1][1],vhi[(i)&1][2],vhi[(i)&1][3]}
  #define PIN(x) asm volatile("":"+v"(x))
  #define MX3(a,b,c) __builtin_fmaxf(__builtin_fmaxf((a),(b)),(c))
  #define GAPA(MF,A0,A1,A2,A3,W0,W1,PW) do{ MF; sacc+=A0; sacc+=A1; sacc+=A2; sacc+=A3; PIN(sacc); W0; W1; PIN(PW); SBAR(); }while(0)
  #define EX(v) __builtin_amdgcn_exp2f(v)
  #define GAPB(MF,X,B) do{ MF; X[B]=EX(X[B]); X[B+1]=EX(X[B+1]); X[B+2]=EX(X[B+2]); X[B+3]=EX(X[B+3]); PIN(X); SBAR(); }while(0)
  #define VRD(i) do{}while(0)
  #define VFS(sl) (bf16x8){vlo[sl][0],vlo[sl][1],vlo[sl][2],vlo[sl][3],vhi[sl][0],vhi[sl][1],vhi[sl][2],vhi[sl][3]}
  #define VRDS(sl,i) do{ vlo[sl]=vtr(vp_+(((i)>>2)*4096+((i)&3)*1024)); vhi[sl]=vtr(vp_+(((i)>>2)*4096+((i)&3)*1024+512)); SBAR(); }while(0)
  #define KRD(G,j) do{ if(G){ kload2(kf,kp0+KOFF(sl_next),j); SBAR(); } }while(0)
  #define STEP(C0,C1,P0,P1,t,GK,GV,GL) do{ SBAR(); \
    const lds_cptr vp_=vp0+sl_prev; \
    VRD(0); SBAR(); float sacc=(P0[0]+P0[1]); \
    GAPA(C0=__builtin_amdgcn_mfma_f32_32x32x16_bf16(kf[0],qr[0],negm,0,0,0), P0[2],P0[3],P0[4],P0[5],     pw0[0]=PKW(P0,0), pw0[1]=PKW(P0,2), pw0); \
    VRD(4); SBAR(); GAPA(C1=__builtin_amdgcn_mfma_f32_32x32x16_bf16(kf[1],qr[0],negm,0,0,0), P0[6],P0[7],P0[8],P0[9],     pw0[2]=PKW(P0,4), pw0[3]=PKW(P0,6), pw0); \
    VRD(1); SBAR(); GAPA(C0=__builtin_amdgcn_mfma_f32_32x32x16_bf16(kf[2],qr[1],C0,0,0,0),   P0[10],P0[11],P0[12],P0[13], pw1[0]=PKW(P0,8), pw1[1]=PKW(P0,10), pw1); \
    VRD(5); SBAR(); GAPA(C1=__builtin_amdgcn_mfma_f32_32x32x16_bf16(kf[3],qr[1],C1,0,0,0),   P0[14],P0[15],P1[0],P1[1],   pw1[2]=PKW(P0,12),pw1[3]=PKW(P0,14), pw1); \
    VRD(2); SBAR(); GAPA(C0=__builtin_amdgcn_mfma_f32_32x32x16_bf16(kf[4],qr[2],C0,0,0,0),   P1[2],P1[3],P1[4],P1[5],     pw2[0]=PKW(P1,0), pw2[1]=PKW(P1,2), pw2); \
    VRD(6); SBAR(); GAPA(C1=__builtin_amdgcn_mfma_f32_32x32x16_bf16(kf[5],qr[2],C1,0,0,0),   P1[6],P1[7],P1[8],P1[9],     pw2[2]=PKW(P1,4), pw2[3]=PKW(P1,6), pw2); \
    VRD(3); SBAR(); GAPA(C0=__builtin_amdgcn_mfma_f32_32x32x16_bf16(kf[6],qr[3],C0,0,0,0),   P1[10],P1[11],P1[12],P1[13], pw3[0]=PKW(P1,8), pw3[1]=PKW(P1,10), pw3); \
    VRD(7); SBAR(); GAPA(C1=__builtin_amdgcn_mfma_f32_32x32x16_bf16(kf[7],qr[3],C1,0,0,0),   P1[14],P1[15],0.f,0.f,       pw3[2]=PKW(P1,12),pw3[3]=PKW(P1,14), pw3); \
    C0=__builtin_amdgcn_mfma_f32_32x32x16_bf16(kf[8],qr[4],C0,0,0,0); SBAR(); C1=__builtin_amdgcn_mfma_f32_32x32x16_bf16(kf[9],qr[4],C1,0,0,0); SBAR(); \
    C0=__builtin_amdgcn_mfma_f32_32x32x16_bf16(kf[10],qr[5],C0,0,0,0); SBAR(); C1=__builtin_amdgcn_mfma_f32_32x32x16_bf16(kf[11],qr[5],C1,0,0,0); SBAR(); \
    l_reg+=sacc; \
    if(GK){DMA_K((t)+3,sl_cur);} if(GV){DMA_V((t)+1,sl_next);} \
    if(!FAST){ _Pragma("unroll") for(int r=0;r<16;++r){C0[r]-=mhat;C1[r]-=mhat;} } \
    CMASK(C0,C1,t); \
    if(!FAST){ float a=MX3(C0[0],C0[1],C1[0]),b=MX3(C0[2],C0[3],C1[1]); a=MX3(a,C1[2],C1[3]); \
      _Pragma("unroll") for(int r=4;r<16;r+=4){a=MX3(a,C0[r],C0[r+1]);b=MX3(b,C0[r+2],C0[r+3]);a=MX3(a,C1[r],C1[r+1]);b=MX3(b,C1[r+2],C1[r+3]);} \
      float rm=xmax32(__builtin_fmaxf(a,b)); \
      resc=false; \
      if(__builtin_expect(__any(rm>(float)THRL),0)){ const float dl=__builtin_fmaxf(rm,0.f); mhat+=dl; \
        _Pragma("unroll") for(int r=0;r<16;++r){C0[r]-=dl;C1[r]-=dl;} \
        const float f=__builtin_amdgcn_exp2f(-dl); l_reg*=f; if(hi==0)wsf[r32]=f; resc=true; } } \
    SBAR(); \
    VRDS(0,0); \
    VRDS(1,4); KRD(GL,4); GAPB(o[0]=__builtin_amdgcn_mfma_f32_32x32x16_bf16(PAF(0),VFS(0),o[0],0,0,0), C0,0); \
    VRDS(0,1); KRD(GL,5); GAPB(o[1]=__builtin_amdgcn_mfma_f32_32x32x16_bf16(PAF(0),VFS(1),o[1],0,0,0), C0,4); \
    VRDS(1,5); KRD(GL,0); GAPB(o[0]=__builtin_amdgcn_mfma_f32_32x32x16_bf16(PAF(1),VFS(0),o[0],0,0,0), C0,8); \
    VRDS(0,2); KRD(GL,1); GAPB(o[1]=__builtin_amdgcn_mfma_f32_32x32x16_bf16(PAF(1),VFS(1),o[1],0,0,0), C0,12); \
    VRDS(1,6); KRD(GL,2); GAPB(o[0]=__builtin_amdgcn_mfma_f32_32x32x16_bf16(PAF(2),VFS(0),o[0],0,0,0), C1,0); \
    VRDS(0,3); KRD(GL,3); GAPB(o[1]=__builtin_amdgcn_mfma_f32_32x32x16_bf16(PAF(2),VFS(1),o[1],0,0,0), C1,4); \
    VRDS(1,7); GAPB(o[0]=__builtin_amdgcn_mfma_f32_32x32x16_bf16(PAF(3),VFS(0),o[0],0,0,0), C1,8); \
    GAPB(o[1]=__builtin_amdgcn_mfma_f32_32x32x16_bf16(PAF(3),VFS(1),o[1],0,0,0), C1,12); \
    }while(0)
  #define GAPB2(MF,X,B) do{ MF; X[B]=EX(X[B]); X[B+1]=EX(X[B+1]); PIN(X); SBAR(); }while(0)
  #define STEPF(C0,C1,P0,P1,t,GK,GV,GL) do{ SBAR(); \
    const lds_cptr vp_=vp0+sl_prev; \
    float sacc=(P0[0]+P0[1]); \
    GAPA(C0=__builtin_amdgcn_mfma_f32_32x32x16_bf16(kf[0],qr[0],negm,0,0,0),  P0[2],P0[3],P0[4],P0[5],     pw0[0]=PKW(P0,0), pw0[1]=PKW(P0,2), pw0); \
    GAPA(C0=__builtin_amdgcn_mfma_f32_32x32x16_bf16(kf[2],qr[1],C0,0,0,0),    P0[6],P0[7],P0[8],P0[9],     pw0[2]=PKW(P0,4), pw0[3]=PKW(P0,6), pw0); \
    GAPA(C0=__builtin_amdgcn_mfma_f32_32x32x16_bf16(kf[4],qr[2],C0,0,0,0),    P0[10],P0[11],P0[12],P0[13], pw1[0]=PKW(P0,8), pw1[1]=PKW(P0,10), pw1); \
    GAPA(C0=__builtin_amdgcn_mfma_f32_32x32x16_bf16(kf[6],qr[3],C0,0,0,0),    P0[14],P0[15],P1[0],P1[1],   pw1[2]=PKW(P0,12),pw1[3]=PKW(P0,14), pw1); \
    GAPA(C0=__builtin_amdgcn_mfma_f32_32x32x16_bf16(kf[8],qr[4],C0,0,0,0),    P1[2],P1[3],P1[4],P1[5],     pw2[0]=PKW(P1,0), pw2[1]=PKW(P1,2), pw2); \
    GAPA(C0=__builtin_amdgcn_mfma_f32_32x32x16_bf16(kf[10],qr[5],C0,0,0,0),   P1[6],P1[7],P1[8],P1[9],     pw2[2]=PKW(P1,4), pw2[3]=PKW(P1,6), pw2); \
    GAPA(C1=__builtin_amdgcn_mfma_f32_32x32x16_bf16(kf[1],qr[0],negm,0,0,0),  P1[10],P1[11],P1[12],P1[13], pw3[0]=PKW(P1,8), pw3[1]=PKW(P1,10), pw3); \
    GAPA(C1=__builtin_amdgcn_mfma_f32_32x32x16_bf16(kf[3],qr[1],C1,0,0,0),    P1[14],P1[15],0.f,0.f,       pw3[2]=PKW(P1,12),pw3[3]=PKW(P1,14), pw3); \
    l_reg+=sacc; \
    CMASKH(C0,t,0); \
    GAPB(C1=__builtin_amdgcn_mfma_f32_32x32x16_bf16(kf[5],qr[2],C1,0,0,0), C0,0); \
    GAPB(C1=__builtin_amdgcn_mfma_f32_32x32x16_bf16(kf[7],qr[3],C1,0,0,0), C0,4); \
    GAPB(C1=__builtin_amdgcn_mfma_f32_32x32x16_bf16(kf[9],qr[4],C1,0,0,0), C0,8); \
    GAPB(C1=__builtin_amdgcn_mfma_f32_32x32x16_bf16(kf[11],qr[5],C1,0,0,0), C0,12); \
    if(GK){DMA_K((t)+3,sl_cur);} if(GV){DMA_V((t)+1,sl_next);} \
    CMASKH(C1,t,32); \
    SBAR(); \
    VRDS(0,0); \
    VRDS(1,4); KRD(GL,4); GAPB2(o[0]=__builtin_amdgcn_mfma_f32_32x32x16_bf16(PAF(0),VFS(0),o[0],0,0,0), C1,0); \
    VRDS(0,1); KRD(GL,5); GAPB2(o[1]=__builtin_amdgcn_mfma_f32_32x32x16_bf16(PAF(0),VFS(1),o[1],0,0,0), C1,2); \
    VRDS(1,5); KRD(GL,0); GAPB2(o[0]=__builtin_amdgcn_mfma_f32_32x32x16_bf16(PAF(1),VFS(0),o[0],0,0,0), C1,4); \
    VRDS(0,2); KRD(GL,1); GAPB2(o[1]=__builtin_amdgcn_mfma_f32_32x32x16_bf16(PAF(1),VFS(1),o[1],0,0,0), C1,6); \
    VRDS(1,6); KRD(GL,2); GAPB2(o[0]=__builtin_amdgcn_mfma_f32_32x32x16_bf16(PAF(2),VFS(0),o[0],0,0,0), C1,8); \
    VRDS(0,3); KRD(GL,3); GAPB2(o[1]=__builtin_amdgcn_mfma_f32_32x32x16_bf16(PAF(2),VFS(1),o[1],0,0,0), C1,10); \
    VRDS(1,7); GAPB2(o[0]=__builtin_amdgcn_mfma_f32_32x32x16_bf16(PAF(3),VFS(0),o[0],0,0,0), C1,12); \
    GAPB2(o[1]=__builtin_amdgcn_mfma_f32_32x32x16_bf16(PAF(3),VFS(1),o[1],0,0,0), C1,14); \
    }while(0)
  #define STEPX(C0,C1,P0,P1,t,GK,GV,GL) do{ if(FAST) STEPF(C0,C1,P0,P1,t,GK,GV,GL); else STEP(C0,C1,P0,P1,t,GK,GV,GL); }while(0)
  int t=1;
  #undef CMASK
  #undef CMASKH
  #define CMASK(P0,P1,t) do{}while(0)
  #define CMASKH(P,t,ko) do{}while(0)
  for(;t+5<NT;t+=2){
    STEPX(pB0,pB1,pA0,pA1,t,true,true,true);     WB(3,2); RESC(); ROT();
    STEPX(pA0,pA1,pB0,pB1,t+1,true,true,true);   WB(3,2); RESC(); ROT();
  }
  #undef CMASK
  #undef CMASKH
  #define CMASK(P0,P1,t) do{int jb_=(t)-(NT-4); if(jb_>=0)cmask(P0,P1,jb_,qrel,hi);}while(0)
  #define CMASKH(P,t,ko) do{int jb_=(t)-(NT-4); if(jb_>=0)cmask1(P,jb_,qrel,hi,ko);}while(0)
  #define ENDW(tt) do{ if((tt)+3<NT){WB(3,2);} else if((tt)+2<NT){WAIT_BAR(1);} else {WAIT_BAR(0);} }while(0)
  for(;t+1<NT;t+=2){
    STEPX(pB0,pB1,pA0,pA1,t,(t+3<NT),(t+1<NT),(t+1<NT));       ENDW(t);   RESC(); ROT();
    STEPX(pA0,pA1,pB0,pB1,t+1,(t+4<NT),(t+2<NT),(t+2<NT));     ENDW(t+1); RESC(); ROT();
  }
  STEPX(pB0,pB1,pA0,pA1,NT-1,false,false,false); RESC();
  { float sacc=pB0[0]+pB0[1]; _Pragma("unroll") for(int r=2;r<16;++r)sacc+=pB0[r]; _Pragma("unroll") for(int r=0;r<16;++r)sacc+=pB1[r]; l_reg+=sacc;
    pw0=(u32x4){PKW(pB0,0),PKW(pB0,2),PKW(pB0,4),PKW(pB0,6)};pw1=(u32x4){PKW(pB0,8),PKW(pB0,10),PKW(pB0,12),PKW(pB0,14)};pw2=(u32x4){PKW(pB1,0),PKW(pB1,2),PKW(pB1,4),PKW(pB1,6)};pw3=(u32x4){PKW(pB1,8),PKW(pB1,10),PKW(pB1,12),PKW(pB1,14)};
    SBAR(); pv(o,vb0+sl_cur,PAF(0),PAF(1),PAF(2),PAF(3)); }
  #undef PKW
  #undef PAF
  #undef VFR
  #undef PIN
  #undef MX3
  #undef GAPA
  #undef GAPB
  #undef EX
  #undef VRD
  #undef VRDS
  #undef VFS
  #undef KRD
  #undef STEP
  #undef STEPF
  #undef STEPX
  #undef GAPB2
  #undef ENDW
  l_reg=xsum32(l_reg);
  if(hi==0)wsf[32+r32]=l_reg;asm volatile("s_waitcnt lgkmcnt(0)":::"memory");
  float rli[16];
  #pragma unroll
  for(int r=0;r<16;++r)rli[r]=__builtin_amdgcn_rcpf(wsf[32+crow(r,hi)]);
  bf16*Ow=O+(long)(q0+wid*QBLK)*PK+h*D;
  { bf16*stg=(bf16*)(shm+LDS_OST)+wid*2048;
    #pragma unroll
    for(int r=0;r<16;++r){const int orow=crow(r,hi);
      #pragma unroll
      for(int d0=0;d0<2;++d0)stg[orow*64+d0*32+r32]=__float2bfloat16(o[d0][r]*rli[r]);}
    asm volatile("s_waitcnt lgkmcnt(0)":::"memory");
    #pragma unroll
    for(int i=0;i<4;++i){const int row=i*8+(lane>>3),ch=lane&7; const u32x4 v=*(const u32x4*)(stg+row*64+ch*8); ATTN_STORE16(Ow+(long)row*PK+ch*8,v);} }
  asm volatile("s_waitcnt lgkmcnt(0)\n\ts_barrier":::"memory");
  #undef DMA_K
  #undef DMA_V
  #undef CMASK
  #undef CMASKH
  #undef START
  #undef RESC
  #undef ROT
}
__device__ __forceinline__ float qnorm2_max(int h,int qb,const bf16*Q,const int wave_id){
  int ln_; asm volatile("v_mbcnt_lo_u32_b32 %0, -1, 0\n\tv_mbcnt_hi_u32_b32 %0, -1, %0" : "=v"(ln_));
  const int r32=ln_&31,hi=ln_>>5; const unsigned*qp=reinterpret_cast<const unsigned*>(Q+(long)(qb*QB+wave_id*QBLK+r32)*PQ+h*DQK+hi*8);
  float s=0.f;
  #pragma unroll
  for(int d0=0;d0<6;++d0){ const u32x4 w=*reinterpret_cast<const u32x4*>(qp+d0*8);
    #pragma unroll
    for(int j=0;j<4;++j){ const float a=__builtin_bit_cast(float,w[j]<<16),b=__builtin_bit_cast(float,w[j]&0xffff0000u); s+=a*a; s+=b*b; } }
  return wave_max_nn(xsum32(s)); }
constexpr int ATTN_LDS_BYTES=LDS_BYTES;
#undef SBAR
#undef WB
#undef WAIT_BAR
#undef KOFF
}
#define GAS __attribute__((address_space(1)))
#define LAS __attribute__((address_space(3)))
typedef unsigned short bf16;
typedef unsigned v4u __attribute__((ext_vector_type(4)));
typedef float f32x4 __attribute__((ext_vector_type(4)));
typedef short bf16x8 __attribute__((ext_vector_type(8)));
typedef GAS unsigned gu32;
typedef GAS unsigned long long gu64;
#define RLX_AGENT __ATOMIC_RELAXED, __HIP_MEMORY_SCOPE_AGENT
#define LDS_WAIT() asm volatile("s_waitcnt lgkmcnt(0)" ::: "memory")
#define VM_WAIT() asm volatile("s_waitcnt vmcnt(0)" ::: "memory")
__device__ __forceinline__ unsigned long long rt() { return __builtin_amdgcn_s_memrealtime(); }
__device__ __forceinline__ unsigned f2bf(float f) { unsigned u = __builtin_bit_cast(unsigned, f); return (u + 0x7fffu + ((u >> 16) & 1u)) >> 16; }
__device__ __forceinline__ unsigned pk2(float lo, float hi) { return f2bf(lo) | (f2bf(hi) << 16); }

#define XB_TMO      128
#define XB_XCNT(j)  (256  + 64 * (j))
#define XB_XSUB(j)  (1280 + 64 * (j))
#define XB_XGEN(j)  (2304 + 64 * (j))
#define XB_TOP      3328
#define XB_TOPGEN   3392
#define XCD_BAR_WORDS 3456
#define XB_SPIN_CAP (1u << 18)

__device__ __forceinline__ unsigned xb_ld(unsigned* p)              { return __hip_atomic_load(p, __ATOMIC_RELAXED, __HIP_MEMORY_SCOPE_AGENT); }
__device__ __forceinline__ unsigned xb_add(unsigned* p, unsigned v) { return __hip_atomic_fetch_add(p, v, __ATOMIC_RELAXED, __HIP_MEMORY_SCOPE_AGENT); }
__device__ __forceinline__ unsigned xb_xcc_id() { return (unsigned)__builtin_amdgcn_s_getreg((3 << 11) | 20) & 0xFu; }
#define XB_SPIN(cond, bar) do { unsigned _sp = 0; while (cond) { __builtin_amdgcn_s_sleep(1); \
    if ((++_sp & 255u) == 0u) { if (xb_ld(&(bar)[XB_TMO])) break; if (_sp > XB_SPIN_CAP) { atomicAdd(&(bar)[XB_TMO], 1u); break; } } } } while (0)

struct XcdBarrier {
    unsigned* bar; unsigned x;
    volatile LAS unsigned* st;
};

__device__ __forceinline__ XcdBarrier xcd_barrier_post(unsigned* bar, volatile LAS unsigned* st) {
    XcdBarrier b; b.bar = bar; b.x = xb_xcc_id(); b.st = st;
    if (threadIdx.x == 0) (void)xb_add(&bar[XB_XCNT(b.x)], 1u);
    return b;
}
__device__ __forceinline__ void xcd_barrier_complete(unsigned* bar, unsigned x, unsigned& nloc, unsigned& nx) {
    const unsigned G = gridDim.x * gridDim.y * gridDim.z;
    unsigned sum, cnt, mine, sp = 0u;
    for (;;) {
        sum = 0u; cnt = 0u; mine = 0u;
#pragma unroll
        for (unsigned j = 0; j < 16; ++j) { const unsigned c = xb_ld(&bar[XB_XCNT(j)]); sum += c; cnt += (c > 0u) ? 1u : 0u; mine = (j == x) ? c : mine; }
        if (sum == G) break;
        __builtin_amdgcn_s_sleep(1);
        if ((++sp & 255u) == 0u) { if (xb_ld(&bar[XB_TMO])) break; if (sp > XB_SPIN_CAP) { atomicAdd(&bar[XB_TMO], 1u); break; } }
    }
    nloc = mine > 0u ? mine : 1u; nx = cnt > 0u ? cnt : 1u;
}

__device__ __forceinline__ void xcd_barrier(const XcdBarrier& b, const bool leader  ) {
    asm volatile("s_waitcnt vmcnt(0)" ::: "memory");
    __syncthreads();
    if (leader) {
        unsigned* bar = b.bar;
        __builtin_amdgcn_s_waitcnt(0);
        unsigned nloc = b.st[0], nx = b.st[1];
        if (nloc == 0u) { xcd_barrier_complete(bar, b.x, nloc, nx); b.st[0] = nloc; b.st[1] = nx; }
        const unsigned old = xb_add(&bar[XB_XSUB(b.x)], 1u);
        const unsigned gen = old / nloc;
        if (old + 1u == (gen + 1u) * nloc) {
            __builtin_amdgcn_fence(__ATOMIC_RELEASE, "agent");
            asm volatile("s_waitcnt vmcnt(0)" ::: "memory");
            const unsigned og = xb_add(&bar[XB_TOP], 1u);
            const unsigned tg = og / nx;
            if (og + 1u == (tg + 1u) * nx) xb_add(&bar[XB_TOPGEN], 1u);
            else XB_SPIN(xb_ld(&bar[XB_TOPGEN]) == tg, bar);
            __builtin_amdgcn_fence(__ATOMIC_ACQUIRE, "agent");
            xb_add(&bar[XB_XGEN(b.x)], 1u);
            asm volatile("s_waitcnt vmcnt(0)" ::: "memory");
        } else {
            XB_SPIN(xb_ld(&bar[XB_XGEN(b.x)]) == gen, bar);
            __builtin_amdgcn_fence(__ATOMIC_ACQUIRE, "agent");
            asm volatile("s_waitcnt vmcnt(0)" ::: "memory");
        }
    }
    __syncthreads();
}
constexpr int NWAVES = 8;
constexpr int M = 16384, D = 1024, NL = 2;
constexpr int GW = 512, CHUNK = 128, NGRP = 8;
constexpr int NH = 8, DQK = 96, DNOPE = 64, DROPE = 32, DV = 64, QLORA = 384, KVLORA = 256;
constexpr int IN_TOTAL = 3744, NPROJ = 3840;
constexpr int FF = 2752, FFP = 2816;
#ifndef ACT_LD_DEF
#define ACT_LD_DEF 2816
#endif
constexpr int ACT_LD = ACT_LD_DEF;
constexpr int NE = 8, EFF = 3584;
constexpr float EPS = 1e-6f;
constexpr int PC_U = 0, PC_V = 512, PC_GA = 1024, PC_GB = 2048, PC_CKV = 3072, PC_CQ = 3328, PC_KR = 3712;
constexpr int MOE_ROWS = 2 * M + NE * 256;
constexpr int MOE_PANELS = MOE_ROWS / 256, MOE_PASS_PANELS = 64, MOE_PASS_MAX = MOE_PANELS - MOE_PASS_PANELS;

constexpr size_t MiB = 1u << 20;
constexpr size_t WS_CTL = 0, CTL_ZERO_BYTES = 64 * 1024;
constexpr size_t WS_STATS = 1 * MiB;
constexpr size_t WS_MOD = 2 * MiB;
constexpr size_t WS_KMAXS = 2 * MiB + 512 * 1024;
constexpr size_t WS_SA = 2 * MiB + 640 * 1024;
constexpr size_t WS_AMAX = 2 * MiB + 896 * 1024;
constexpr size_t WS_COS = 3 * MiB, WS_SIN = 4 * MiB;
constexpr size_t WS_TOPI = 5 * MiB, WS_TOPG = 5 * MiB + 128 * 1024, WS_LIST = 5 * MiB + 256 * 1024;
constexpr size_t WS_LSA = 6 * MiB;
constexpr size_t WS_LHS = 6 * MiB + 512 * 1024;
constexpr size_t WS_ROWDEST = 6 * MiB + 512 * 1024, WS_ROWGATE = 6 * MiB + 768 * 1024;
constexpr size_t WS_WST = 7 * MiB;
constexpr size_t WS_WIN = 8 * MiB, WS_WUQ = 23 * MiB, WS_WUKV = 25 * MiB, WS_WA = 26 * MiB, WS_WB = 28 * MiB, WS_WO = 30 * MiB;
constexpr size_t WS_WGU = 34 * MiB, WS_WD = 45 * MiB, WS_W13 = 51 * MiB, WS_W2 = 163 * MiB;
constexpr size_t WS_SP = 8 * MiB;
constexpr size_t WS_H = 220 * MiB;
constexpr size_t WS_PROJ = 252 * MiB;
constexpr size_t WS_Q = 372 * MiB, WS_KN = 396 * MiB, WS_VV = 412 * MiB, WS_KPE = 428 * MiB, WS_GM = 429 * MiB, WS_ATT = 445 * MiB, WS_Y = 461 * MiB;
constexpr size_t WS_ACT = WS_PROJ;
constexpr size_t WS_ACTM = 252 * MiB, WS_Y2 = WS_W13;
constexpr size_t WS_XB = 493 * MiB;
constexpr size_t WS_PST = 525 * MiB;
constexpr size_t WS_END = 529 * MiB;
static_assert(WS_ACTM + (size_t)MOE_ROWS * EFF * 2 <= WS_XB && WS_Y + (size_t)M * D * 2 <= WS_XB && WS_XB + (size_t)M * D * 2 <= WS_PST && WS_PST + 4 * MiB <= WS_END && (size_t)M * 2 * D * 2 <= (size_t)NE * 2 * EFF * D * 2, "moe map");
static_assert(WS_W13 + (size_t)NE * 2 * EFF * D * 2 <= WS_W2 && WS_W2 + (size_t)NE * D * EFF * 2 <= WS_H, "weights map");
constexpr int CW_TMO = 0, CW_CODE = 1;
constexpr int CW_BAR = 4096;
constexpr int CW_XRANK = 12288;
constexpr int CW_KMAX = 1024;
constexpr int CW_MOE = 8192;
constexpr int CW_DIAG = 16384;
constexpr int RING_OFF = 0, RING_BYTES = 131072;
constexpr int LDSCTL_OFF = RING_BYTES, MISC_OFF = LDSCTL_OFF + 320;
constexpr int LDS_BYTES = 147456;
struct Args { const void* in[29]; float* out; unsigned char* ws; int ph_lo, ph_hi; };
__device__ __forceinline__ float sum4f(const f32x4& v) { return (v[0] + v[1]) + (v[2] + v[3]); }
__device__ __forceinline__ int fresh_lane() { int ln_; asm volatile("v_mbcnt_lo_u32_b32 %0, -1, 0\n\tv_mbcnt_hi_u32_b32 %0, -1, %0" : "=v"(ln_)); return ln_; }
__device__ __forceinline__ const float* inptr(const LAS unsigned long long* ptab, int i) { const unsigned long long v = ptab[i]; const unsigned lo = __builtin_amdgcn_readfirstlane((unsigned)v), hi = __builtin_amdgcn_readfirstlane((unsigned)(v >> 32)); const GAS float* gp = (const GAS float*)(((unsigned long long)hi << 32) | lo); return (const float*)gp; }
struct Ctx { LAS unsigned char* lds; gu32* ctl; unsigned char* ws; int tid, lane, wave, vcu, G, gw, NGW; };
__device__ __forceinline__ float wave_sum(float v) {
    float s = v + dpp_f(v, 0x111, 0xf, 0xf); s += dpp_f(v, 0x112, 0xf, 0xf); s += dpp_f(v, 0x113, 0xf, 0xf);
    s += dpp_f(s, 0x114, 0xf, 0xe); s += dpp_f(s, 0x118, 0xf, 0xc); s += dpp_f(s, 0x142, 0xa, 0xf); s += dpp_f(s, 0x143, 0xc, 0xf);
    return __builtin_bit_cast(float, __builtin_amdgcn_readlane(__builtin_bit_cast(int, s), 63)); }
__device__ __forceinline__ float siluf_(float x) { return x / (1.0f + __expf(-x)); }
template <class Map>
__device__ __forceinline__ void p0_item(const Map& mp, int Ksrc, const float* gain, bf16* WT, int ldt, int nblk, LAS float* scr, int item, int lane) {
    const int kb = item / nblk, nb = item % nblk, k0 = 64 * kb, n0 = 32 * nb;
    const float* src; int ldw; const int sc = mp(n0 + (lane & 31), src, ldw);
    float vv[32];
#pragma unroll
    for (int i = 0; i < 32; ++i) { const int k = k0 + 2 * i + (lane >> 5); vv[i] = (sc >= 0 && k < Ksrc) ? src[(size_t)k * ldw + sc] : 0.f; }
    if (gain) {
#pragma unroll
        for (int i = 0; i < 32; ++i) { const int k = k0 + 2 * i + (lane >> 5); vv[i] *= (k < Ksrc) ? gain[k] : 0.f; } }
#pragma unroll
    for (int i = 0; i < 32; ++i) scr[(2 * i + (lane >> 5)) * 33 + (lane & 31)] = vv[i];
    LDS_WAIT(); asm volatile("" ::: "memory");
    const int c = lane & 7;
#pragma unroll
    for (int j = 0; j < 4; ++j) { const int n = (lane >> 3) + 8 * j; const LAS float* s = scr + (8 * c) * 33 + n;
        v4u o; o.x = pk2(s[0 * 33], s[1 * 33]); o.y = pk2(s[2 * 33], s[3 * 33]); o.z = pk2(s[4 * 33], s[5 * 33]); o.w = pk2(s[6 * 33], s[7 * 33]);
        *(GAS v4u*)(WT + (size_t)(n0 + n) * ldt + k0 + 8 * c) = o; }
    LDS_WAIT(); asm volatile("" ::: "memory");
}
template <class Map>
__device__ __forceinline__ void p0_item8(const Map& mp, int Ksrc, float inv, unsigned char* WT, int ldt, int nblk, LAS float* scr, int item, int lane) {
    const int kb = item / nblk, nb = item % nblk, k0 = 64 * kb, n0 = 32 * nb;
    const float* src; int ldw; const int sc = mp(n0 + (lane & 31), src, ldw);
    float vv[32];
#pragma unroll
    for (int i = 0; i < 32; ++i) { const int k = k0 + 2 * i + (lane >> 5); vv[i] = (sc >= 0 && k < Ksrc) ? src[(size_t)k * ldw + sc] : 0.f; }
#pragma unroll
    for (int i = 0; i < 32; ++i) scr[(2 * i + (lane >> 5)) * 33 + (lane & 31)] = vv[i];
    LDS_WAIT(); asm volatile("" ::: "memory");
    const int c = lane & 7;
#pragma unroll
    for (int j = 0; j < 4; ++j) { const int n = (lane >> 3) + 8 * j; const LAS float* s = scr + (8 * c) * 33 + n;
        const unsigned long long o = (unsigned long long)q8x4(s[0 * 33], s[1 * 33], s[2 * 33], s[3 * 33], inv) | ((unsigned long long)q8x4(s[4 * 33], s[5 * 33], s[6 * 33], s[7 * 33], inv) << 32);
        *(unsigned long long*)(WT + (size_t)(n0 + n) * ldt + k0 + 8 * c) = o; }
    LDS_WAIT(); asm volatile("" ::: "memory");
}
__device__ __forceinline__ void tensor_absmax(const Ctx& C, const float* w0, const float* w1, int n4, float* slots, int step = 1, float* sqslots = nullptr) {
    float am = 0.f, sq = 0.f;
    for (int i = C.gw * 64 * step + C.lane; i < n4; i += C.NGW * 64 * step) {     const f32x4 a = ((const f32x4*)w0)[i], b = ((const f32x4*)w1)[i];
        am = fmaxf(am, fmaxf(fmaxf(fmaxf(fabsf(a.x), fabsf(a.y)), fmaxf(fabsf(a.z), fabsf(a.w))), fmaxf(fmaxf(fabsf(b.x), fabsf(b.y)), fmaxf(fabsf(b.z), fabsf(b.w)))));
        sq += (sum4f(a * a) + sum4f(b * b)); }
    am = wave_max_nn(am); if (sqslots) sq = wave_sum(sq);
    LAS float* st = (LAS float*)(C.lds + 14336);
    __syncthreads(); if (C.lane == 0) { st[C.wave] = am; st[8 + C.wave] = sq; } __syncthreads();
    if (C.tid == 0) { float t = st[0], u2 = st[8];
#pragma unroll
        for (int q = 1; q < 8; ++q) { t = fmaxf(t, st[q]); u2 += st[8 + q]; } slots[C.vcu] = t; if (sqslots) sqslots[C.vcu] = u2; }
    __syncthreads();
}
__device__ __forceinline__ float slots_sum(const float* slots, int G, int lane) { float t = 0.f; for (int i = lane; i < G; i += 64) t += slots[i]; return wave_sum(t); }
__device__ __forceinline__ float slots_max(const float* slots, int G, int lane) { float am = 0.f; for (int i = lane; i < G; i += 64) am = fmaxf(am, slots[i]); return wave_max_nn(am); }
struct MapIdent { const float* W; int ld; __device__ __forceinline__ int operator()(int n, const float*& s, int& l) const { s = W; l = ld; return n; } };
struct MapWin { const float* W; __device__ __forceinline__ int operator()(int n, const float*& s, int& l) const { s = W; l = IN_TOTAL;
    if (n < 1024) return n; if (n < 2048) return 1696 + (n - 1024); if (n < 3072) return 2720 + (n - 2048); if (n < 3328) return 1408 + (n - 3072); if (n < 3712) return 1024 + (n - 3328);
    if (n < 3744) { const int j = (n - 3712) >> 1, p = (n - 3712) & 1; return 1664 + j + 16 * p; } return -1; } };
struct MapWuq { const float* W; __device__ __forceinline__ int operator()(int n, const float*& s, int& l) const { s = W; l = 768; const int h = n / 96, o = n % 96;
    if (o < 64) return 96 * h + o; const int j = (o - 64) >> 1, p = (o - 64) & 1; return 96 * h + 64 + j + 16 * p; } };
struct MapWukv { const float* W; __device__ __forceinline__ int operator()(int n, const float*& s, int& l) const { s = W; l = 1024; if (n < 512) return 128 * (n >> 6) + (n & 63); const int m = n - 512; return 128 * (m >> 6) + 64 + (m & 63); } };
struct MapGU { const float* Wg; const float* Wu; int ld, nch; __device__ __forceinline__ int operator()(int n, const float*& s, int& l) const { const int r = n & 255, ch = 128 * (n >> 8) + (r & 127); s = Wg + ((r < 128) ? (ptrdiff_t)0 : (Wu - Wg)); l = ld; return ch < nch ? ch : -1; } };

constexpr float HID_KAPPA = 8.0f;
constexpr int W13_SAMPLES = NE * D * EFF / 16 * 2;
constexpr float W13_RANGE = 1.25f;
constexpr int P0_I13 = 16 * (2 * EFF / 32), P0_I2 = (EFF / 64) * 32, P0_MOE_ITEMS = NE * (P0_I13 + P0_I2);
#ifndef TAIL_G1
#define TAIL_G1 4
#endif
#ifndef TAIL_Q
#define TAIL_Q 2
#endif
#ifndef TAIL_FFN
#define TAIL_FFN 4
#endif
constexpr int TW64 = 64 * NWAVES, TW128 = 128 * NWAVES;
constexpr int TB_G1_0 = 0, TB_Q_0 = TB_G1_0 + TAIL_G1 * TW64, TB_FFN = TB_Q_0 + TAIL_Q * TW64, TB_G1_1 = TB_FFN + TAIL_FFN * TW128, TB_Q_1 = TB_G1_1 + TAIL_G1 * TW64, TB_END = TB_Q_1 + TAIL_Q * TW64;
static_assert(TB_END <= P0_MOE_ITEMS, "tail slices exceed the MoE items");
__device__ __forceinline__ void moe_item(const Ctx& C, const LAS unsigned long long* ptab, LAS float* scr, int m, int lane, float inv13, float inv2) {
    unsigned char* ws = C.ws; const int e = m / (P0_I13 + P0_I2); int r = m - e * (P0_I13 + P0_I2);
    if (r < P0_I13) { p0_item8(MapGU{inptr(ptab, 26) + (size_t)e * D * EFF, inptr(ptab, 27) + (size_t)e * D * EFF, EFF, EFF}, D, inv13, ws + WS_W13 + (size_t)e * 2 * EFF * D, D, 2 * EFF / 32, scr, r, lane); return; }
    r -= P0_I13;
    p0_item8(MapIdent{inptr(ptab, 28) + (size_t)e * EFF * D, D}, EFF, inv2, ws + WS_W2 + (size_t)e * D * EFF, EFF, D / 32, scr, r, lane);
}
__device__ __forceinline__ void moe_tail(const Ctx& C, const LAS unsigned long long* ptab, int cid, int first_cid, int base, int per_wave) {
    if (C.G != 256 || cid < first_cid) return;
    LAS float* scr = (LAS float*)(C.lds + C.wave * 16384); const int lane = fresh_lane(), widx = (cid - first_cid) * NWAVES + C.wave, nw = (256 - first_cid) * NWAVES;
    const float a13 = slots_max((const float*)(C.ws + WS_AMAX) + 256, C.G, lane) * W13_RANGE, inv13 = a13 > 0.f ? 127.0f / a13 : 0.f;
    const float a2 = slots_max((const float*)(C.ws + WS_AMAX) + 1024, C.G, lane) * W13_RANGE, inv2 = a2 > 0.f ? 127.0f / a2 : 0.f;
    for (int i = 0; i < per_wave; ++i) moe_item(C, ptab, scr, base + i * nw + widx, lane, inv13, inv2);
    __syncthreads();
}
template <int PART>
__device__ __forceinline__ void phase_prologue(const Ctx& C, const LAS unsigned long long* ptab) {
    LAS float* scr = (LAS float*)(C.lds + C.wave * 16384);
    unsigned char* ws = C.ws;
    constexpr int I_WIN = 16 * (NPROJ / 32), I_UQ = 6 * (768 / 32), I_UKV = 4 * (1024 / 32), I_AB = 8 * 32, I_WO = 16 * 32, I_GU = 16 * (2 * FFP / 32), I_WD = (FFP / 64) * 32, I_13 = 16 * (2 * EFF / 32), I_2 = (EFF / 64) * 32;
    constexpr int I_L = I_WIN + I_UQ + I_UKV + 2 * I_AB + I_WO;
    constexpr int NONMOE = NL * I_L + I_GU + I_WD; static_assert(I_13 == P0_I13 && I_2 == P0_I2, "item counts");
    const int m_first = (C.G == 256) ? TB_END : 0, NT_ITEMS = NONMOE + P0_MOE_ITEMS - m_first;
    if (PART == 1) { const float a13 = slots_max((const float*)(ws + WS_AMAX) + 256, C.G, C.lane) * W13_RANGE, inv13 = a13 > 0.f ? 127.0f / a13 : 0.f;
    const float a2 = slots_max((const float*)(ws + WS_AMAX) + 1024, C.G, C.lane) * W13_RANGE, inv2 = a2 > 0.f ? 127.0f / a2 : 0.f;
    for (int it = C.gw; it < NT_ITEMS; it += C.NGW) {
        int r = it;
        if (r < NL * I_L) { const int l = r / I_L; r -= l * I_L;
            if (r < I_WIN) { const float aw = slots_max((const float*)(ws + WS_AMAX) + 512 + 256 * l, C.G, C.lane); p0_item8(MapWin{inptr(ptab, 9) + (size_t)l * D * IN_TOTAL}, D, aw > 0.f ? 127.0f / aw : 0.f, ws + WS_WIN + (size_t)l * NPROJ * D, D, NPROJ / 32, scr, r, C.lane); continue; } r -= I_WIN;
            if (r < I_UQ) { p0_item(MapWuq{inptr(ptab, 15) + (size_t)l * QLORA * 768}, QLORA, inptr(ptab, 14) + l * QLORA, (bf16*)(ws + WS_WUQ) + (size_t)l * 768 * QLORA, QLORA, 768 / 32, scr, r, C.lane); continue; } r -= I_UQ;
            if (r < I_UKV) { p0_item(MapWukv{inptr(ptab, 17) + (size_t)l * KVLORA * 1024}, KVLORA, inptr(ptab, 16) + l * KVLORA, (bf16*)(ws + WS_WUKV) + (size_t)l * 1024 * KVLORA, KVLORA, 1024 / 32, scr, r, C.lane); continue; } r -= I_UKV;
            if (r < I_AB) { p0_item(MapIdent{inptr(ptab, 18) + (size_t)l * GW * D, D}, GW, nullptr, (bf16*)(ws + WS_WA) + (size_t)l * D * GW, GW, D / 32, scr, r, C.lane); continue; } r -= I_AB;
            if (r < I_AB) { p0_item(MapIdent{inptr(ptab, 19) + (size_t)l * GW * D, D}, GW, nullptr, (bf16*)(ws + WS_WB) + (size_t)l * D * GW, GW, D / 32, scr, r, C.lane); continue; } r -= I_AB;
            p0_item(MapIdent{inptr(ptab, 20) + (size_t)l * D * D, D}, D, nullptr, (bf16*)(ws + WS_WO) + (size_t)l * D * D, D, D / 32, scr, r, C.lane); continue; }
        r -= NL * I_L;
        if (r < I_GU) { const float ag = slots_max((const float*)(ws + WS_AMAX), C.G, C.lane); p0_item8(MapGU{inptr(ptab, 21), inptr(ptab, 22), FF, FF}, D, ag > 0.f ? 127.0f / ag : 0.f, ws + WS_WGU, D, 2 * FFP / 32, scr, r, C.lane); continue; } r -= I_GU;
        if (r < I_WD) { const float ad = slots_max((const float*)(ws + WS_AMAX) + 1792, C.G, C.lane); p0_item8(MapIdent{inptr(ptab, 23), D}, FF, ad > 0.f ? 127.0f / ad : 0.f, ws + WS_WD, FFP, D / 32, scr, r, C.lane); continue; } r -= I_WD;
        moe_item(C, ptab, scr, r + m_first, C.lane, inv13, inv2);
    }
    return; }
    tensor_absmax(C, inptr(ptab, 21), inptr(ptab, 22), D * FF / 4, (float*)(ws + WS_AMAX), 1, (float*)(ws + WS_AMAX) + 1536);
    tensor_absmax(C, inptr(ptab, 23), inptr(ptab, 23) + D * FF / 2, D * FF / 8, (float*)(ws + WS_AMAX) + 1792);
    tensor_absmax(C, inptr(ptab, 26), inptr(ptab, 27), NE * D * EFF / 4, (float*)(ws + WS_AMAX) + 256, 16, (float*)(ws + WS_AMAX) + 1280);
    tensor_absmax(C, inptr(ptab, 28), inptr(ptab, 28) + (size_t)NE * D * EFF / 2, NE * D * EFF / 8, (float*)(ws + WS_AMAX) + 1024, 16);
    tensor_absmax(C, inptr(ptab, 9), inptr(ptab, 9) + D * IN_TOTAL / 2, D * IN_TOTAL / 8, (float*)(ws + WS_AMAX) + 512);
    tensor_absmax(C, inptr(ptab, 9) + D * IN_TOTAL, inptr(ptab, 9) + D * IN_TOTAL + D * IN_TOTAL / 2, D * IN_TOTAL / 8, (float*)(ws + WS_AMAX) + 768);
    { float* MOD = (float*)(ws + WS_MOD); const float* cc = inptr(ptab, 1); const float* aw = inptr(ptab, 3); const float* ab = inptr(ptab, 4);
      for (int it = C.vcu; it < NL * 96; it += C.G) { const int l = it / 96, jb = it % 96, ds = C.wave, g = C.lane >> 4;
          f32x4 s = {0.f, 0.f, 0.f, 0.f}; const float* w = aw + ((size_t)l * D + ds * 128 + g) * (6 * D) + jb * 64 + (C.lane & 15) * 4; const float* cw = cc + ds * 128 + g;
#pragma unroll 16
          for (int i = 0; i < 32; ++i) { const f32x4 wv = *(const f32x4*)(w + (size_t)(4 * i) * 6 * D); s += wv * siluf_(cw[4 * i]); }
          *((LAS f32x4*)(C.lds + C.wave * 16384 + 12288) + C.lane) = s;
          __syncthreads();
          if (C.wave == 0) { const int j = jb * 64 + C.lane; float t = ab[l * 6 * D + j];
#pragma unroll
              for (int q = 0; q < 8; ++q) { const LAS float* pq = (const LAS float*)(C.lds + q * 16384 + 12288) + C.lane; t += pq[0]; t += pq[64]; t += pq[128]; t += pq[192]; }
              MOD[l * 6 * D + j] = t; }
          __syncthreads(); } }
    { const float invf[16] = {1.000000000e+00f, 5.623413324e-01f, 3.162277639e-01f, 1.778279394e-01f, 1.000000015e-01f, 5.623412877e-02f, 3.162277862e-02f, 1.778279431e-02f, 9.999999776e-03f, 5.623413250e-03f, 3.162277862e-03f, 1.778279431e-03f, 1.000000047e-03f, 5.623413017e-04f, 3.162277862e-04f, 1.778279402e-04f};
      const int* pos = (const int*)inptr(ptab, 2); float* ct = (float*)(ws + WS_COS); float* st = (float*)(ws + WS_SIN);
      const int j = C.lane & 15; float f = invf[0];
#pragma unroll
      for (int q = 1; q < 16; ++q) f = (j == q) ? invf[q] : f;
      for (int it = C.gw; it < M / 4; it += C.NGW) { const int row = it * 4 + (C.lane >> 4); const float ang = (float)pos[row] * f;
          const double rev = (double)ang * 0.15915494309189533577; const float fr = (float)(rev - floor(rev));
          ct[row * 16 + j] = __builtin_amdgcn_cosf(fr); st[row * 16 + j] = __builtin_amdgcn_sinf(fr); } }
    { const float* wsrc = inptr(ptab, 12); bf16* wst = (bf16*)(ws + WS_WST);
      for (int it = C.gw; it < NL * NGRP * CHUNK * CHUNK / 256; it += C.NGW) { const int e0 = it * 256 + C.lane * 4; const int t = (e0 >> 7) & 127, s0 = e0 & 127;
          const f32x4 v = *(const f32x4*)(wsrc + e0); unsigned long long o = (unsigned long long)pk2(s0 <= t ? v.x : 0.f, s0 + 1 <= t ? v.y : 0.f) | ((unsigned long long)pk2(s0 + 2 <= t ? v.z : 0.f, s0 + 3 <= t ? v.w : 0.f) << 32);
          *(unsigned long long*)(wst + e0) = o; } }
}
template <bool HQ>
__device__ __forceinline__ void phase_prenorm(const Ctx& C, const float* x, const float* w, const float* sc, const float* sh, bf16* H, float* sa) {
    f32x4 ca[4], cb[4];
#pragma unroll
    for (int j = 0; j < 4; ++j) { const int c = 4 * C.lane + 256 * j; const f32x4 ww = *(const f32x4*)(w + c), s1 = *(const f32x4*)(sc + c); ca[j] = ww * (s1 + 1.0f); cb[j] = *(const f32x4*)(sh + c); }
    for (int blk = C.vcu; blk < M / 64; blk += C.G) {
    const int m0 = blk * 64 + C.wave * 8; f32x4 nx[4];
#pragma unroll
    for (int j = 0; j < 4; ++j) nx[j] = *((const f32x4*)(x + (size_t)m0 * D) + C.lane + 64 * j);
    for (int m = m0; m < m0 + 8; ++m) {
        f32x4 v[4]; float s2 = 0.f;
#pragma unroll
        for (int j = 0; j < 4; ++j) v[j] = nx[j];
        if (m + 1 < m0 + 8) {
#pragma unroll
            for (int j = 0; j < 4; ++j) nx[j] = *((const f32x4*)(x + (size_t)(m + 1) * D) + C.lane + 64 * j); }
#pragma unroll
        for (int j = 0; j < 4; ++j) s2 += sum4f(v[j] * v[j]);
        const float rstd = 1.0f / sqrtf(wave_sum(s2) * (1.0f / D) + EPS);
        unsigned long long* o8 = (unsigned long long*)(H + (size_t)m * D) + C.lane;
#pragma unroll
        for (int j = 0; j < 4; ++j) { const f32x4 hv = v[j] * rstd * ca[j] + cb[j]; if (HQ) v[j] = hv; else o8[64 * j] = (unsigned long long)pk2(hv.x, hv.y) | ((unsigned long long)pk2(hv.z, hv.w) << 32); }
        if (HQ) { float am = 0.f;
#pragma unroll
            for (int j = 0; j < 4; ++j) am = fmaxf(am, fmaxf(fmaxf(fabsf(v[j].x), fabsf(v[j].y)), fmaxf(fabsf(v[j].z), fabsf(v[j].w))));
            am = wave_max_nn(am); const float inv = am > 0.f ? 127.0f / am : 0.f; unsigned* q4 = (unsigned*)((unsigned char*)H + (size_t)m * D) + C.lane;
#pragma unroll
            for (int j = 0; j < 4; ++j) q4[64 * j] = q8x4(v[j].x, v[j].y, v[j].z, v[j].w, inv);
            if (C.lane == 0) sa[m] = am * (1.0f / 127.0f); }
    }
    }
}
__device__ __forceinline__ void ld_bf4(const bf16* p, f32x4& v) { const unsigned long long w = *(const unsigned long long*)p; const unsigned lo = (unsigned)w, hi = (unsigned)(w >> 32);
    v = (f32x4){__uint_as_float(lo << 16), __uint_as_float(lo & 0xffff0000u), __uint_as_float(hi << 16), __uint_as_float(hi & 0xffff0000u)}; }
template <int MODE, bool XIB, bool XOB, bool HQ = false>
__device__ __forceinline__ void phase_resid(const Ctx& C, const void* xin_, void* xout_, const bf16* Y, const bf16* Ysecond, int ypitch, const float* g, const float* wpost,
                                            const float* wpre, const float* sc, const float* sh, bf16* H, const float* wr, const float* br, int* topi, float* topg, int* list, gu32* cnt, float* sa = nullptr, float hidk = 0.f) {
    f32x4 cg[4], ca[4], cb[4];
#pragma unroll
    for (int j = 0; j < 4; ++j) { const int c = 4 * C.lane + 256 * j; cg[j] = *(const f32x4*)(g + c) * *(const f32x4*)(wpost + c);
        if (MODE >= 1) { ca[j] = *(const f32x4*)(wpre + c) * (*(const f32x4*)(sc + c) + 1.0f); cb[j] = *(const f32x4*)(sh + c); } }
    LAS float* WR = (LAS float*)C.lds;
    LAS int* lcnt = (LAS int*)(C.lds + 32768);
    LAS int* lsel = (LAS int*)(C.lds + 32768 + 64);
    LAS float* rsc = (LAS float*)(C.lds + 36864) + C.wave * 1024;
    if (MODE == 2) { for (int i = C.tid; i < D * NE / 4; i += NWAVES * 64) ((LAS f32x4*)WR)[i] = ((const f32x4*)wr)[i]; if (C.tid < 16) lcnt[C.tid] = 0; __syncthreads(); }
    for (int blk = C.vcu; blk < M / 64; blk += C.G) {
        const int m_begin = blk * 64 + C.wave * 8, m_end = m_begin + 8;
        unsigned long long yr[4], yr2[4], xb[4]; f32x4 xr[4]; const float* xin = (const float*)xin_; const bf16* xinb = (const bf16*)xin_; float* xout = (float*)xout_; bf16* xoutb = (bf16*)xout_;
#define RES_LOAD(mm) do { _Pragma("unroll") for (int j = 0; j < 4; ++j) { yr[j] = *(const unsigned long long*)(Y + (size_t)(mm) * ypitch + 4 * C.lane + 256 * j); if (Ysecond) yr2[j] = *(const unsigned long long*)(Ysecond + (size_t)(mm) * ypitch + 4 * C.lane + 256 * j); \
            if (XIB) xb[j] = *((const unsigned long long*)(xinb + (size_t)(mm) * D) + C.lane + 64 * j); else xr[j] = *((const f32x4*)(xin + (size_t)(mm) * D) + C.lane + 64 * j); } } while (0)
#define RES_CVT(w, v) do { const unsigned lo_ = (unsigned)(w), hi_ = (unsigned)((w) >> 32); v = (f32x4){__uint_as_float(lo_ << 16), __uint_as_float(lo_ & 0xffff0000u), __uint_as_float(hi_ << 16), __uint_as_float(hi_ & 0xffff0000u)}; } while (0)
        RES_LOAD(m_begin);
        for (int m = m_begin; m < m_end; ++m) {
            f32x4 y[4], xv[4]; float s2 = 0.f;
#pragma unroll
            for (int j = 0; j < 4; ++j) { RES_CVT(yr[j], y[j]); if (Ysecond) { f32x4 t; RES_CVT(yr2[j], t); y[j] += t; } if (XIB) RES_CVT(xb[j], xv[j]); else xv[j] = xr[j]; }
            if (m + 1 < m_end) RES_LOAD(m + 1);
#pragma unroll
            for (int j = 0; j < 4; ++j) s2 += sum4f(y[j] * y[j]);
            const float rstd = 1.0f / sqrtf(wave_sum(s2) * (1.0f / D) + EPS); float s3 = 0.f;
#pragma unroll
            for (int j = 0; j < 4; ++j) { xv[j] += cg[j] * (y[j] * rstd);
                if (XOB) { const unsigned long long w = (unsigned long long)pk2(xv[j].x, xv[j].y) | ((unsigned long long)pk2(xv[j].z, xv[j].w) << 32); *((unsigned long long*)(xoutb + (size_t)m * D) + C.lane + 64 * j) = w; RES_CVT(w, xv[j]); }
                else *((f32x4*)(xout + (size_t)m * D) + C.lane + 64 * j) = xv[j];
                s3 += sum4f(xv[j] * xv[j]); }
            if (MODE >= 1) {
                const float rstd2 = 1.0f / sqrtf(wave_sum(s3) * (1.0f / D) + EPS);
                unsigned long long* o8 = (unsigned long long*)(H + (size_t)m * D) + C.lane; float lg[8];
                if (MODE == 2) {
#pragma unroll
                    for (int e = 0; e < 8; ++e) lg[e] = 0.f; }
                if (HQ) { float am = 0.f;
#pragma unroll
                    for (int j = 0; j < 4; ++j) { xv[j] = xv[j] * rstd2 * ca[j] + cb[j]; am = fmaxf(am, fmaxf(fmaxf(fabsf(xv[j].x), fabsf(xv[j].y)), fmaxf(fabsf(xv[j].z), fabsf(xv[j].w)))); }
                    am = wave_max_nn(am); const float inv = am > 0.f ? 127.0f / am : 0.f; unsigned* q4 = (unsigned*)((unsigned char*)H + (size_t)m * D) + C.lane;
#pragma unroll
                    for (int j = 0; j < 4; ++j) q4[64 * j] = q8x4(xv[j].x, xv[j].y, xv[j].z, xv[j].w, inv);
                    if (C.lane == 0) sa[m] = am * (1.0f / 127.0f);
                    if (MODE == 1 && hidk > 0.f) { float hs = 0.f;
#pragma unroll
                        for (int j = 0; j < 4; ++j) hs += sum4f(xv[j] * xv[j]);
                        hs = wave_sum(hs); if (C.lane == 0) sa[m + M] = hidk * hs; }
                    if (MODE == 2) { float hs = 0.f;
#pragma unroll
                        for (int j = 0; j < 4; ++j) hs += sum4f(xv[j] * xv[j]);
                        hs = wave_sum(hs); if (C.lane == 0) sa[m + M] = hs; }
                    if (MODE == 2) {
#pragma unroll
                        for (int j = 0; j < 4; ++j)
#pragma unroll
                            for (int q = 0; q < 4; ++q) { const int c = 4 * C.lane + 256 * j + q; const f32x4 w0 = *(const LAS f32x4*)(WR + c * 8), w1 = *(const LAS f32x4*)(WR + c * 8 + 4); const float hq = xv[j][q];
                                lg[0] += hq * w0.x; lg[1] += hq * w0.y; lg[2] += hq * w0.z; lg[3] += hq * w0.w; lg[4] += hq * w1.x; lg[5] += hq * w1.y; lg[6] += hq * w1.z; lg[7] += hq * w1.w; } } }
                else
#pragma unroll
                for (int j = 0; j < 4; ++j) { const f32x4 hv = xv[j] * rstd2 * ca[j] + cb[j]; o8[64 * j] = (unsigned long long)pk2(hv.x, hv.y) | ((unsigned long long)pk2(hv.z, hv.w) << 32);
                    if (MODE == 2) {
#pragma unroll
                        for (int q = 0; q < 4; ++q) { const int c = 4 * C.lane + 256 * j + q; const f32x4 w0 = *(const LAS f32x4*)(WR + c * 8), w1 = *(const LAS f32x4*)(WR + c * 8 + 4); const float hq = hv[q];
                            lg[0] += hq * w0.x; lg[1] += hq * w0.y; lg[2] += hq * w0.z; lg[3] += hq * w0.w; lg[4] += hq * w1.x; lg[5] += hq * w1.y; lg[6] += hq * w1.z; lg[7] += hq * w1.w; } } }
                if (MODE == 2) {
#pragma unroll
                    for (int e = 0; e < 8; ++e) rsc[e * 64 + C.lane] = lg[e];
                    __builtin_amdgcn_fence(__ATOMIC_RELEASE, "wavefront"); __builtin_amdgcn_wave_barrier(); __builtin_amdgcn_fence(__ATOMIC_ACQUIRE, "wavefront");
                    if (C.lane < 8) { float t = br[C.lane];
                        for (int i = 0; i < 64; ++i) t += rsc[C.lane * 64 + i];
                        rsc[512 + C.lane] = t; }
                    __builtin_amdgcn_fence(__ATOMIC_RELEASE, "wavefront"); __builtin_amdgcn_wave_barrier(); __builtin_amdgcn_fence(__ATOMIC_ACQUIRE, "wavefront");
#pragma unroll
                    for (int e = 0; e < 8; ++e) lg[e] = rsc[512 + e];
                    __builtin_amdgcn_fence(__ATOMIC_RELEASE, "wavefront"); __builtin_amdgcn_wave_barrier(); __builtin_amdgcn_fence(__ATOMIC_ACQUIRE, "wavefront");
#ifdef DIAG_LOGITS
                    if (C.lane == 0) { float* LG = (float*)(C.ws + 514 * MiB) + (size_t)m * 8;
#pragma unroll
                        for (int e = 0; e < 8; ++e) LG[e] = lg[e]; }
#endif
                    int i0 = 0; float v0 = lg[0];
#pragma unroll
                    for (int e = 1; e < 8; ++e) if (lg[e] > v0) { v0 = lg[e]; i0 = e; }
                    int i1 = -1; float v1 = -INFINITY;
#pragma unroll
                    for (int e = 0; e < 8; ++e) if (e != i0 && lg[e] > v1) { v1 = lg[e]; i1 = e; }
                    const float e1 = __expf(v1 - v0), g0 = 1.0f / (1.0f + e1), g1 = e1 * g0;
                    if (C.lane == 0) { topi[2 * m] = i0; topi[2 * m + 1] = i1; topg[2 * m] = g0; topg[2 * m + 1] = g1;
                        const int lr = m - blk * 64; lsel[2 * lr] = i0; lsel[2 * lr + 1] = i1; }
                }
            }
        }
        if (MODE == 2) {
            __syncthreads();
            if (C.tid < 128) { const int e = lsel[C.tid]; int rk = 0; for (int t2 = 0; t2 < C.tid; ++t2) rk += (lsel[t2] == e) ? 1 : 0; ((int*)list)[(size_t)NE * M + blk * 128 + C.tid] = (e << 16) | rk; }
            if (C.tid >= 128 && C.tid < 136) { const int e = C.tid - 128; int c = 0; for (int t2 = 0; t2 < 128; ++t2) c += (lsel[t2] == e) ? 1 : 0; ((int*)list)[(size_t)NE * M + (M / 64) * 128 + blk * 8 + e] = c; }
            __syncthreads();
        }
    }
}
__device__ __forceinline__ void phase_moe_lists(const Ctx& C, int* list, const float* sa, float* lsa, float* lhs, float hidk) {
    const int* RANK = list + (size_t)NE * M; const int* CNTB = RANK + (M / 64) * 128; LAS int* base = (LAS int*)C.lds;
    for (int blk = C.vcu; blk < M / 64; blk += C.G) {
        __syncthreads();
        { float s = 0.f;
#pragma unroll
          for (int i = 0; i < 4; ++i) { const int b2 = C.lane + 64 * i; s += (b2 < blk) ? (float)CNTB[b2 * 8 + C.wave] : 0.f; }
          s = wave_sum(s); if (C.lane == 0) base[C.wave] = (int)s; }
        __syncthreads();
        if (C.tid < 128) { const int v = RANK[blk * 128 + C.tid], e = v >> 16, rk = v & 0xffff; list[e * M + base[e] + rk] = ((blk * 64 + (C.tid >> 1)) << 1) | (C.tid & 1); lsa[e * M + base[e] + rk] = sa[blk * 64 + (C.tid >> 1)]; lhs[e * M + base[e] + rk] = hidk * sa[M + blk * 64 + (C.tid >> 1)]; }
    }
}
__device__ __forceinline__ void phase_gmlp(const Ctx& C, const bf16* PROJ, const float* sumv, const float* ssqv, const float* lng, const float* lnb, const bf16* WST, const float* bs, bf16* GM) {
    typedef __attribute__((ext_vector_type(16))) float f32x16; typedef unsigned u32x4v __attribute__((ext_vector_type(4)));
    LAS bf16* VT = (LAS bf16*)C.lds;
    const int r32 = C.lane & 31, hi = C.lane >> 5;
    const int xg = C.G >> 3, xq = C.vcu / (xg > 0 ? xg : 1), xr = C.vcu - xq * xg;
    for (int uu = xr; uu < 128; uu += xg) {
        const int u = xq * 128 + uu;
        const int c = u >> 3, g = u & 7, t0 = c * CHUNK, ch0 = g * 64;
        { const int s = C.tid >> 2, dq = (C.tid & 3) * 16, row = t0 + s; const f32x4 sa = *(const f32x4*)(sumv + row * 8), sb = *(const f32x4*)(sumv + row * 8 + 4), qa = *(const f32x4*)(ssqv + row * 8), qb = *(const f32x4*)(ssqv + row * 8 + 4);
          const float mean = (((sa[0] + sa[1]) + (sa[2] + sa[3])) + ((sb[0] + sb[1]) + (sb[2] + sb[3]))) * (1.0f / GW), var = (((qa[0] + qa[1]) + (qa[2] + qa[3])) + ((qb[0] + qb[1]) + (qb[2] + qb[3]))) * (1.0f / GW) - mean * mean, rstd = 1.0f / sqrtf(var + EPS);
          const u32x4v w0 = *(const u32x4v*)(PROJ + (size_t)row * NPROJ + PC_V + ch0 + dq), w1 = *(const u32x4v*)(PROJ + (size_t)row * NPROJ + PC_V + ch0 + dq + 8);
#pragma unroll
          for (int i = 0; i < 8; ++i) { const unsigned wa = (i < 4) ? w0[i] : w1[i - 4]; const int d = dq + 2 * i;
              const float a = (__uint_as_float(wa << 16) - mean) * rstd * lng[ch0 + d] + lnb[ch0 + d], b = (__uint_as_float(wa & 0xffff0000u) - mean) * rstd * lng[ch0 + d + 1] + lnb[ch0 + d + 1];
              VT[d * 136 + s] = (bf16)f2bf(a); VT[(d + 1) * 136 + s] = (bf16)f2bf(b); } }
        __syncthreads();
        const int dblk = C.wave & 1, tblk = C.wave >> 1; f32x16 acc = {};
        const bf16* wrow = WST + ((size_t)g * CHUNK + 32 * tblk + r32) * CHUNK + 8 * hi;
        for (int ks = 0; ks <= 2 * tblk + 1; ++ks) {
            const bf16x8 af = *(const LAS bf16x8*)(VT + (32 * dblk + r32) * 136 + 16 * ks + 8 * hi);
            const bf16x8 bfr = *(const bf16x8*)(wrow + 16 * ks);
            acc = __builtin_amdgcn_mfma_f32_32x32x16_bf16(af, bfr, acc, 0, 0, 0);
        }
        const int tl = 32 * tblk + r32, row = t0 + tl; const float bias = bs[g * CHUNK + tl];
#pragma unroll
        for (int q = 0; q < 4; ++q) { const int ch = ch0 + 32 * dblk + 8 * q + 4 * hi; f32x4 uv; ld_bf4(PROJ + (size_t)row * NPROJ + PC_U + ch, uv);
            const f32x4 z = (f32x4){acc[4 * q] + bias, acc[4 * q + 1] + bias, acc[4 * q + 2] + bias, acc[4 * q + 3] + bias}, o = uv * z;
            *(unsigned long long*)(GM + (size_t)row * GW + ch) = (unsigned long long)pk2(o.x, o.y) | ((unsigned long long)pk2(o.z, o.w) << 32); }
        __syncthreads();
    }
}
__device__ __forceinline__ void moe_tab_build(const Ctx& C, const int* list, LAS int* tab) {
    const int* CNTB = list + (size_t)NE * M + (M / 64) * 128;
    __syncthreads();
    { float s = 0.f;
#pragma unroll
      for (int i = 0; i < 4; ++i) s += (float)CNTB[(C.lane + 64 * i) * 8 + C.wave];
      s = wave_sum(s); if (C.lane == 0) tab[16 + C.wave] = (int)s; }
    __syncthreads();
    if (C.tid == 0) { int acc = 0; for (int e = 0; e < 8; ++e) { tab[e] = acc; acc += (tab[16 + e] + 255) >> 8; } tab[8] = acc; }
    __syncthreads();
}
__device__ __forceinline__ int moe_expert_of(const LAS int* tab, int panel) { int e = 0;
#pragma unroll
    for (int q = 1; q < 8; ++q) e += (panel >= tab[q]) ? 1 : 0; return e; }
__device__ __forceinline__ void phase_gather(const Ctx& C, const LAS int* tab, const bf16* H, const int* list, const float* topg, bf16* XG, int* rowdest, float* rowgate) {
    typedef unsigned u32x4v __attribute__((ext_vector_type(4)));
    const int total = tab[8] * 256;
    for (int p = C.gw; p < total; p += C.NGW) {
        const int e = moe_expert_of(tab, p >> 8), i = p - tab[e] * 256; u32x4v v0 = {0u, 0u, 0u, 0u}, v1 = {0u, 0u, 0u, 0u}; int dest = -1; float gt = 0.f;
        if (i < tab[16 + e]) { dest = list[e * M + i]; gt = topg[dest]; const u32x4v* src = (const u32x4v*)(H + (size_t)(dest >> 1) * D); v0 = src[C.lane]; v1 = src[64 + C.lane]; }
        u32x4v* dst = (u32x4v*)(XG + (size_t)p * D); dst[C.lane] = v0; dst[64 + C.lane] = v1;
        if (C.lane == 0) { rowdest[p] = dest; rowgate[p] = gt; }
    }
}
struct MoeOrder {
    pg8::StaticOrder S; int p0; size_t estride; int absA; const LAS int* tab; const int* list; int rowbytes; const float* lsa;
    long limit;
    __device__ bool next(int i, pg8::Unit& u) const { const long L = (long)i * S.G + S.c; if (L >= limit) return false; return at(L, u); }
    __device__ bool at(long L, pg8::Unit& u) const { if (!S.at(L, u)) return false; const int P = p0 + u.pm; const int e = __builtin_amdgcn_readfirstlane(moe_expert_of(tab, P)); u.aux = P; u.aoff = (size_t)(absA ? P : u.pm) * S.astep; u.boff += (size_t)e * estride; return true; }
    __device__ __forceinline__ float rowscale_of(const pg8::Unit& u, int rl) const { const int P = u.aux, e = __builtin_amdgcn_readfirstlane(moe_expert_of(tab, P)), i = (P - tab[e]) * 256 + rl; return (i < tab[16 + e]) ? lsa[e * M + i] : 0.f; }
    __device__ __forceinline__ int rowtok(const pg8::Unit& u, int rl) const {
        const int P = u.aux, e = __builtin_amdgcn_readfirstlane(moe_expert_of(tab, P)), i = (P - tab[e]) * 256 + rl; return (i < tab[16 + e]) ? (list[e * M + i] >> 1) : 0; }
    __device__ __forceinline__ void avoff(const pg8::Unit& u, const int (&R)[2], const int (&C)[2], unsigned (&v)[2][2]) const {
        const int P = u.aux, e = __builtin_amdgcn_readfirstlane(moe_expert_of(tab, P)), base = (P - tab[e]) * 256, cnt = tab[16 + e];
#pragma unroll
        for (int h = 0; h < 2; ++h)
#pragma unroll
            for (int i = 0; i < 2; ++i) { const int r = base + h * 128 + R[i]; const int tk = (r < cnt) ? list[e * M + r] : 0; v[h][i] = (unsigned)(tk >> 1) * (unsigned)rowbytes + (unsigned)C[i] * 2u; }
    }
};
struct OneUnit { MoeOrder S; long L; __device__ bool next(int i, pg8::Unit& u) const { if (i != 0) return false; return S.at(L, u); }
    __device__ __forceinline__ float rowscale_of(const pg8::Unit& u, int rl) const { return S.rowscale_of(u, rl); } };
__device__ __forceinline__ void phase_moe_reduce(const Ctx& C, const MoeOrder& S, long nfull, int nleft, const float* SP, const int* list, const float* topg, const LAS int* tab, bf16* Y2) {
    for (int it = C.gw; it < nleft * 256; it += C.NGW) {
        const int j = it >> 8, r = it & 255; pg8::Unit u; if (!S.at(nfull + j, u)) continue;
        const int P = u.aux, e = __builtin_amdgcn_readfirstlane(moe_expert_of(tab, P)), i = (P - tab[e]) * 256 + r;
        if (i >= tab[16 + e]) continue;
        const int d = list[e * M + i]; const float gt = topg[d];
        const float* p = SP + ((size_t)(2 * j) * 256 + r) * 256 + 4 * C.lane; const size_t ts = (size_t)256 * 256;
        const f32x4 s = *(const f32x4*)p + *(const f32x4*)(p + ts);
        *(unsigned long long*)(Y2 + (size_t)d * D + u.pn * 256 + 4 * C.lane) = (unsigned long long)pk2(s.x * gt, s.y * gt) | ((unsigned long long)pk2(s.z * gt, s.w * gt) << 32);
    }
}
#ifndef EN_LEFT
#define EN_LEFT 1
#endif
#ifndef ATTN_BOUND2
#define ATTN_BOUND2 4096.0f
#endif
#ifndef ATTN_FASTSEL
#define ATTN_FASTSEL true
#endif
#ifndef PR_ATT
#define PR_ATT 1
#endif
#ifndef PR_G1
#define PR_G1 1
#endif
#ifndef PR_GMLP
#define PR_GMLP 1
#endif
#ifndef PR_QKV
#define PR_QKV 1
#endif
#ifndef PR_OUT
#define PR_OUT 1
#endif
#ifndef PR_FFN1
#define PR_FFN1 1
#endif
#ifndef PR_FFN2
#define PR_FFN2 1
#endif
#ifndef PR_MOE1
#define PR_MOE1 1
#endif
#ifndef PR_MOE2
#define PR_MOE2 1
#endif
#ifndef PR_P0
#define PR_P0 1
#endif
#ifndef EN_ALL
#define EN_ALL 1
#endif
#ifndef DIAG_TWIN_OFF
#define DIAG_TWIN_OFF WS_ACT
#endif
#ifndef EN_FFN2
#define EN_FFN2 1
#endif
#ifndef EN_BR2
#define EN_BR2 1
#endif
#ifndef EN_C1
#define EN_C1 1
#endif
#ifndef EN_C2
#define EN_C2 1
#endif
#ifndef EN_C3
#define EN_C3 1
#endif
#ifndef EN_P0
#define EN_P0 EN_ALL
#endif
#ifndef EN_P1
#define EN_P1 EN_ALL
#endif
#ifndef EN_G1
#define EN_G1 EN_ALL
#endif
#ifndef EN_C
#define EN_C EN_ALL
#endif
#ifndef EN_ATT
#define EN_ATT EN_ALL
#endif
#ifndef EN_BR
#define EN_BR EN_ALL
#endif
#ifndef EN_OUT
#define EN_OUT EN_ALL
#endif
#ifndef EN_T1
#define EN_T1 EN_ALL
#endif
#ifndef EN_FFN
#define EN_FFN EN_ALL
#endif
#ifndef EN_T2
#define EN_T2 EN_ALL
#endif
#ifndef EN_GA
#define EN_GA EN_ALL
#endif
#ifndef EN_MOE
#define EN_MOE EN_ALL
#endif
#ifndef EN_FIN
#define EN_FIN EN_ALL
#endif
constexpr int NPHASES = 23;
__global__ void __launch_bounds__(NWAVES * 64, 2) mega_fwd(Args args) {
    extern __shared__ __attribute__((aligned(16))) unsigned char lds[];
    Ctx C; C.lds = (LAS unsigned char*)lds; C.ws = args.ws; C.ctl = (gu32*)(args.ws + WS_CTL);
    C.tid = threadIdx.x; C.lane = C.tid & 63; C.wave = __builtin_amdgcn_readfirstlane(C.tid >> 6);
    for (int u = threadIdx.x; u < (LDS_BYTES - LDSCTL_OFF) / 4; u += NWAVES * 64) ((LAS unsigned*)(C.lds + LDSCTL_OFF))[u] = 0u;
    __syncthreads();
    C.G = gridDim.x;
    int cid = blockIdx.x;
    { volatile LAS unsigned* MI = (volatile LAS unsigned*)(C.lds + MISC_OFF);
      if (threadIdx.x == 0) { const unsigned xcc = xb_xcc_id(); const unsigned rk = __hip_atomic_fetch_add((gu32*)(args.ws + WS_CTL) + CW_XRANK + 64 * xcc, 1u, RLX_AGENT); MI[16] = xcc; MI[17] = rk; }
      __syncthreads();
      const int xcc = (int)MI[16], rk = (int)MI[17], per = C.G >> 3;
      if ((C.G & 7) == 0 && xcc < 8 && rk < per) { C.vcu = xcc * per + rk; cid = rk * 8 + xcc; } else { const int bx = blockIdx.x; C.vcu = (C.G % 8 == 0) ? (bx % 8) * (C.G / 8) + bx / 8 : bx; cid = bx; } }
    C.gw = C.vcu * NWAVES + C.wave; C.NGW = C.G * NWAVES;
    volatile LAS unsigned* MISC = (volatile LAS unsigned*)(C.lds + MISC_OFF);
    LAS int* moetab = (LAS int*)(C.lds + MISC_OFF + 256);
    LAS unsigned long long* ptab = (LAS unsigned long long*)(C.lds + MISC_OFF + 512);
    if (threadIdx.x < 29) ptab[threadIdx.x] = (unsigned long long)args.in[threadIdx.x];
    __syncthreads();
    XcdBarrier bar = xcd_barrier_post((unsigned*)(C.ctl + CW_BAR), MISC + 8);
    const int lo = args.ph_lo, hi = args.ph_hi;
    unsigned char* ws = args.ws;
#define IN(k) (lo <= (k) && (k) < hi)
#define FRESH() do { C.lane = fresh_lane(); C.tid = C.wave * 64 + C.lane; } while (0)
#define SEAM(k) do { if ((k) + 1 < hi) { XcdBarrier b_ = bar; { unsigned long long bp_ = (unsigned long long)b_.bar; asm volatile("" : "+s"(bp_)); b_.bar = (unsigned*)(GAS unsigned*)bp_; } xcd_barrier(b_, C.wave == 0 && fresh_lane() == 0); } } while (0)
#define INF(i) (inptr(ptab, (i)))
#define WSF(off) ([&]() { unsigned long long b_ = (unsigned long long)ws; asm volatile("" : "+s"(b_)); return (float*)(b_ + (off)); }())
    bf16* const Hb = (bf16*)(ws + WS_H); bf16* const PROJ = (bf16*)(ws + WS_PROJ); bf16* const Qb = (bf16*)(ws + WS_Q); bf16* const KNb = (bf16*)(ws + WS_KN); bf16* const VVb = (bf16*)(ws + WS_VV);
    bf16* const KPEb = (bf16*)(ws + WS_KPE); bf16* const GMb = (bf16*)(ws + WS_GM); bf16* const ATTb = (bf16*)(ws + WS_ATT); bf16* const Yb = (bf16*)(ws + WS_Y); bf16* const MRG = Hb; bf16* const H1b = (bf16*)(ws + WS_GM);
    const float* const MOD = (const float*)(ws + WS_MOD); const float* const cosT = (const float*)(ws + WS_COS); const float* const sinT = (const float*)(ws + WS_SIN);
    float* const xres = args.out; bf16* const xbf = (bf16*)(ws + WS_XB);

    if (IN(0)) { FRESH(); _Pragma("unroll") for (int rep_ = 0; rep_ < PR_P0; ++rep_) { phase_prologue<0>(C, ptab); { XcdBarrier b_ = bar; { unsigned long long bp_ = (unsigned long long)b_.bar; asm volatile("" : "+s"(bp_)); b_.bar = (unsigned*)(GAS unsigned*)bp_; } xcd_barrier(b_, C.wave == 0 && fresh_lane() == 0); } FRESH(); phase_prologue<1>(C, ptab); }
        if (EN_P1) phase_prenorm<true>(C, INF(0), INF(5), MOD + 1 * D, MOD + 0 * D, Hb, WSF(WS_SA));
        SEAM(0); }
#pragma unroll
    for (int l = 0; l < NL; ++l) {
        const int pb = (l == 0) ? 1 : 10;
        const float* mod = MOD + l * 6 * D;
        float* st_sumv = (float*)(ws + WS_PST + (size_t)l * 2 * MiB); float* st_ssqv = st_sumv + 8 * M; float* st_ssqq = st_sumv + 16 * M; float* st_ssqkv = st_sumv + 24 * M;
        if (EN_G1 && IN(pb + 1)) { FRESH();
#ifdef DIAG_L2FLUSH
            if (l == 1) { typedef unsigned u32x4f __attribute__((ext_vector_type(4))); const u32x4f* src = (const u32x4f*)(ws + WS_W13 + (size_t)C.vcu * (DIAG_L2FLUSH * 65536)); u32x4f acc_ = {0u, 0u, 0u, 0u};
                for (int i = 0; i < DIAG_L2FLUSH * 8; ++i) { const u32x4f v = src[i * 512 + C.tid]; acc_ ^= v; }
                if ((acc_.x ^ acc_.y ^ acc_.z ^ acc_.w) == 0x12345678u) ((unsigned*)(ws + WS_TOPI))[C.tid] = 1u; __syncthreads(); }
#endif
            pg8::Gemm g{l == 0 ? Hb : H1b, (const bf16*)(ws + WS_WIN + (size_t)l * NPROJ * D), D / 2, D / 2, D / 2, WSF(WS_SA), slots_max(WSF(WS_AMAX) + 512 + 256 * l, C.G, C.lane) * (1.0f / 127.0f)}; pg8::StaticOrder S; S.init(M, NPROJ, D / 2, D / 2, C.G, cid);
            pg8::EpiProj E{PROJ, KPEb, st_sumv, st_ssqv, st_ssqq, st_ssqkv, cosT, sinT};
#if 1
            _Pragma("unroll") for (int rep_ = 0; rep_ < PR_G1; ++rep_) pg8::gemm_phase<pg8::EpiProj, pg8::StaticOrder, true, PG8_SP2_DEFAULT, false, true>(C.lds + RING_OFF, g, S, E, C.wave);
            moe_tail(C, ptab, cid, 192, l ? TB_G1_1 : TB_G1_0, TAIL_G1);
#endif
            SEAM(pb + 1);
        }
        if (EN_C && IN(pb + 2)) { FRESH();
            _Pragma("unroll") for (int rep_ = 0; rep_ < PR_GMLP; ++rep_) phase_gmlp(C, PROJ, st_sumv, st_ssqv, INF(10) + l * GW, INF(11) + l * GW, (const bf16*)(ws + WS_WST) + (size_t)l * NGRP * CHUNK * CHUNK, INF(13) + l * NGRP * CHUNK, GMb);
            {
              const int first = C.G > 192 ? 192 : 0;
              if (cid >= first) for (int blk = cid - first; blk < M / 256; blk += C.G - first) { const int ln = fresh_lane();
                  const attn3::u32x4* kp = (const attn3::u32x4*)(KPEb + (size_t)(blk * 256 + C.wave * 32 + (ln & 31)) * 32) + 2 * (ln >> 5); float q = 0.f;
                  _Pragma("unroll") for (int i = 0; i < 2; ++i) { const attn3::u32x4 w = kp[i];
                      _Pragma("unroll") for (int j = 0; j < 4; ++j) { const float a = __builtin_bit_cast(float, w[j] << 16), b = __builtin_bit_cast(float, w[j] & 0xffff0000u); q += a * a; q += b * b; } }
                  q = wave_max_nn(xsum32(q));
                  if (ln == 0) __hip_atomic_fetch_max((unsigned*)(ws + WS_CTL) + CW_KMAX + 32 * l + 16, __builtin_bit_cast(unsigned, q), __ATOMIC_RELAXED, __HIP_MEMORY_SCOPE_AGENT); } }
            if (EN_C2) { pg8::Gemm g{PROJ + PC_CQ, (const bf16*)(ws + WS_WUQ) + (size_t)l * 768 * QLORA, NPROJ, QLORA, QLORA}; pg8::StaticOrder S; S.init(M, 768, NPROJ, QLORA, C.G, cid);
              pg8::EpiQ E{Qb, st_ssqq, cosT, sinT, 0.10206207261596577f * 1.4426950408889634f};
              _Pragma("unroll") for (int rep_ = 0; rep_ < PR_QKV; ++rep_) pg8::gemm_phase<pg8::EpiQ, pg8::StaticOrder>(C.lds + RING_OFF, g, S, E, C.wave);
              moe_tail(C, ptab, cid, 192, l ? TB_Q_1 : TB_Q_0, TAIL_Q); }
            if (EN_C3) { pg8::Gemm g{PROJ + PC_CKV, (const bf16*)(ws + WS_WUKV) + (size_t)l * 1024 * KVLORA, NPROJ, KVLORA, KVLORA}; pg8::StaticOrder S; S.init(M, 1024, NPROJ, KVLORA, C.G, cid);
              pg8::EpiKV E{KNb, VVb, st_ssqkv, (float*)(ws + WS_KMAXS) + l * 2048};
              _Pragma("unroll") for (int rep_ = 0; rep_ < PR_QKV; ++rep_) pg8::gemm_phase<pg8::EpiKV, pg8::StaticOrder>(C.lds + RING_OFF, g, S, E, C.wave); }
            SEAM(pb + 2);
        }
        if (EN_ATT && IN(pb + 3)) { FRESH();
_Pragma("unroll") for (int rep_ = 0; rep_ < PR_ATT; ++rep_)
            for (int ui = C.vcu; ui < 256; ui += C.G) { const int h = ui >> 5, s = ui & 31;
#ifdef ATTN_V1
                attn1::attn_unit(h, 63 - s, Qb, KNb, KPEb, VVb, ATTb, C.lds + RING_OFF, C.wave);
                attn1::attn_unit(h, s, Qb, KNb, KPEb, VVb, ATTb, C.lds + RING_OFF, C.wave); }
#else
                const unsigned* kmx = (const unsigned*)(ws + WS_CTL) + CW_KMAX + 32 * l;
#define KMXF(i) __builtin_bit_cast(float, __hip_atomic_load(kmx + (i), __ATOMIC_RELAXED, __HIP_MEMORY_SCOPE_AGENT))
                float kn2; { const float* km = (const float*)(ws + WS_KMAXS) + l * 2048 + h * 256 + 2 * fresh_lane(); const pg8::f32x2 a0 = *(const pg8::f32x2*)km, a1 = *(const pg8::f32x2*)(km + 128);
                    kn2 = wave_max_nn(fmaxf(a0.x + a1.x, a0.y + a1.y)); }
                const float kb2 = (kn2 + KMXF(16)) * 1.05f;
#undef KMXF
                const bool fast = ATTN_FASTSEL && fmaxf(attn3::qnorm2_max(h, 63 - s, (const attn3::bf16*)Qb, C.wave), attn3::qnorm2_max(h, s, (const attn3::bf16*)Qb, C.wave)) * kb2 < ATTN_BOUND2;
                if (fast) { _Pragma("nounroll") for (int k2 = 0; k2 < 2; ++k2)
                    attn3::attn_unit<8, true>(h, k2 ? s : 63 - s, (const attn3::bf16*)Qb, (const attn3::bf16*)KNb, (const attn3::bf16*)KPEb, (const attn3::bf16*)VVb, (attn3::bf16*)ATTb, (char*)lds + RING_OFF, C.wave); }
                else { _Pragma("nounroll") for (int k2 = 0; k2 < 2; ++k2)
                    attn3::attn_unit<8, false>(h, k2 ? s : 63 - s, (const attn3::bf16*)Qb, (const attn3::bf16*)KNb, (const attn3::bf16*)KPEb, (const attn3::bf16*)VVb, (attn3::bf16*)ATTb, (char*)lds + RING_OFF, C.wave); } }
#endif
            SEAM(pb + 3);
        }
        if (EN_BR && IN(pb + 4)) { FRESH();
            { pg8::Gemm g{GMb, (const bf16*)(ws + WS_WA) + (size_t)l * D * GW, GW, GW, GW}; pg8::StaticOrder S; S.init(M, D, GW, GW, C.G, cid);
#ifdef DIAG_BR_PLAIN
              pg8::EpiPlain E{MRG, D}; pg8::gemm_phase<pg8::EpiPlain, pg8::StaticOrder>(C.lds + RING_OFF, g, S, E, C.wave); }
#else
              pg8::EpiGate<0> E{MRG, PROJ + PC_GA}; pg8::gemm_phase<pg8::EpiGate<0>, pg8::StaticOrder>(C.lds + RING_OFF, g, S, E, C.wave); }
#endif
            if (EN_BR2) { pg8::Gemm g{ATTb, (const bf16*)(ws + WS_WB) + (size_t)l * D * GW, GW, GW, GW}; pg8::StaticOrder S; S.init(M, D, GW, GW, C.G, cid);
              pg8::EpiGate<1> E{MRG, PROJ + PC_GB}; pg8::gemm_phase<pg8::EpiGate<1>, pg8::StaticOrder>(C.lds + RING_OFF, g, S, E, C.wave); }
            SEAM(pb + 4);
        }
        if (EN_OUT && IN(pb + 5)) { FRESH();
            pg8::Gemm g{MRG, (const bf16*)(ws + WS_WO) + (size_t)l * D * D, D, D, D}; pg8::StaticOrder S; S.init(M, D, D, D, C.G, cid);
            pg8::EpiPlain E{Yb, D}; _Pragma("unroll") for (int rep_ = 0; rep_ < PR_OUT; ++rep_) pg8::gemm_phase<pg8::EpiPlain, pg8::StaticOrder>(C.lds + RING_OFF, g, S, E, C.wave);
            SEAM(pb + 5);
        }
        if (l == 0) {
            if (EN_T1 && IN(7)) { FRESH(); phase_resid<1, false, true, true>(C, INF(0), xbf, Yb, nullptr, D, mod + 2 * D, INF(6) + l * D, INF(7) + l * D, mod + 4 * D, mod + 3 * D, H1b, nullptr, nullptr, nullptr, nullptr, nullptr, nullptr, WSF(WS_SA) + M, HID_KAPPA * slots_sum(WSF(WS_AMAX) + 1536, C.G, C.lane) * (1.0f / (2.0f * D * FF * 127.0f))); SEAM(7); }
            if (EN_FFN && IN(8)) { FRESH();
                pg8::Gemm g{H1b, (const bf16*)(ws + WS_WGU), D / 2, D / 2, D / 2, WSF(WS_SA) + M, slots_max(WSF(WS_AMAX), C.G, C.lane) * (1.0f / 127.0f)}; pg8::StaticOrder S; S.init(M, 2 * FFP, D / 2, D / 2, C.G, cid);
#ifdef DIAG_FFN1_PLAIN
#ifndef DIAG_PLAIN_SHIFT
#define DIAG_PLAIN_SHIFT 0
#endif
                pg8::EpiPlain E{(bf16*)(ws + WS_ACT) + DIAG_PLAIN_SHIFT, 2 * FFP}; pg8::gemm_phase<pg8::EpiPlain, pg8::StaticOrder>(C.lds + RING_OFF, g, S, E, C.wave);
#else
#ifdef DIAG_FFN1_NOALIGN
                pg8::EpiSwiGLU E{(bf16*)(ws + WS_ACT), FFP}; pg8::gemm_phase<pg8::EpiSwiGLU, pg8::StaticOrder, false, true>(C.lds + RING_OFF, g, S, E, C.wave);
#else
                pg8::EpiSwiGLU8s E{ws + WS_ACT, FFP, WSF(WS_SA) + 2 * M}; _Pragma("unroll") for (int rep_ = 0; rep_ < PR_FFN1; ++rep_) pg8::gemm_phase<pg8::EpiSwiGLU8s, pg8::StaticOrder, true, PG8_SP2_DEFAULT, false, true>(C.lds + RING_OFF, g, S, E, C.wave);
                moe_tail(C, ptab, cid, 128, TB_FFN, TAIL_FFN);
#endif
#ifdef DIAG_FFN1_TWICE
                { pg8::EpiSwiGLU E2{(bf16*)(ws + DIAG_TWIN_OFF), FFP}; pg8::gemm_phase<pg8::EpiSwiGLU, pg8::StaticOrder>(C.lds + RING_OFF, g, S, E2, C.wave); }
#endif
#endif
                SEAM(8);
            }
            if (EN_FFN && EN_FFN2 && IN(9)) { FRESH();
                pg8::Gemm g{(const bf16*)(ws + WS_ACT), (const bf16*)(ws + WS_WD), FFP / 2, FFP / 2, FFP / 2, WSF(WS_SA) + 2 * M, slots_max(WSF(WS_AMAX) + 1792, C.G, C.lane) * (1.0f / 127.0f)}; pg8::StaticOrder S; S.init(M, D, FFP / 2, FFP / 2, C.G, cid);
                pg8::EpiPlain E{Yb, D}; _Pragma("unroll") for (int rep_ = 0; rep_ < PR_FFN2; ++rep_) pg8::gemm_phase<pg8::EpiPlain, pg8::StaticOrder, true, PG8_SP2_DEFAULT, false, true>(C.lds + RING_OFF, g, S, E, C.wave);
                SEAM(9);
            }
            if (EN_T1 && IN(10)) { FRESH(); const float* mod1 = MOD + 6 * D;
                phase_resid<1, true, true, true>(C, xbf, xbf, Yb, nullptr, D, mod + 5 * D, INF(8) + l * D, INF(5) + D, mod1 + 1 * D, mod1 + 0 * D, H1b, nullptr, nullptr, nullptr, nullptr, nullptr, nullptr, WSF(WS_SA)); SEAM(10); }
        } else {
            int* topi = (int*)(ws + WS_TOPI); float* topg = (float*)(ws + WS_TOPG); int* list = (int*)(ws + WS_LIST);
            bf16* ACTM = (bf16*)(ws + WS_ACTM); bf16* Y2 = (bf16*)(ws + WS_Y2);
            if (EN_T2 && IN(16)) { FRESH(); phase_resid<2, true, true, true>(C, xbf, xbf, Yb, nullptr, D, mod + 2 * D, INF(6) + l * D, INF(7) + l * D, mod + 4 * D, mod + 3 * D, Hb, INF(24), INF(25), topi, topg, list, C.ctl + CW_MOE, WSF(WS_SA) + 2 * M); SEAM(16); }
            if (EN_T2 && IN(17)) { FRESH(); phase_moe_lists(C, list, WSF(WS_SA) + 2 * M, WSF(WS_LSA), WSF(WS_LHS), HID_KAPPA * slots_sum(WSF(WS_AMAX) + 1280, C.G, C.lane) * (1.0f / ((float)W13_SAMPLES * 127.0f))); SEAM(17); }
            if (EN_MOE && IN(18)) { FRESH();
                moe_tab_build(C, list, moetab);
                const int np = moetab[8];
                pg8::Gemm g{Hb, (const bf16*)(ws + WS_W13), D / 2, D / 2, D / 2, WSF(WS_SA) + 2 * M, slots_max(WSF(WS_AMAX) + 256, C.G, C.lane) * (W13_RANGE / 127.0f)};
                MoeOrder S; S.S.init(np * 256, 2 * EFF, D / 2, D / 2, C.G, cid); S.p0 = 0; S.estride = (size_t)2 * EFF * D; S.absA = 1; S.tab = moetab; S.list = list; S.rowbytes = D; S.lsa = WSF(WS_LSA); S.limit = (long)np * 2 * EFF / 256;
                pg8::EpiSwiGLU8 E{(unsigned char*)ACTM, EFF, WSF(WS_LHS), moetab, M}; _Pragma("unroll") for (int rep_ = 0; rep_ < PR_MOE1; ++rep_) pg8::gemm_phase<pg8::EpiSwiGLU8, MoeOrder, true, true, true, true>(C.lds + RING_OFF, g, S, E, C.wave);
                SEAM(19);
            }
            if (EN_MOE && IN(20)) { FRESH();
                moe_tab_build(C, list, moetab);
                const int np = moetab[8]; const long U = (long)np * 4, nfull = (U / C.G) * C.G; const int nleft = (int)(U - nfull);
                const float b2 = slots_max(WSF(WS_AMAX) + 1024, C.G, C.lane) * (W13_RANGE / 127.0f);
                MoeOrder S; S.S.init(np * 256, D, EFF / 2, EFF / 2, C.G, cid); S.p0 = 0; S.estride = (size_t)D * EFF; S.absA = 1; S.tab = moetab; S.list = list; S.rowbytes = 0; S.lsa = WSF(WS_LHS); S.limit = (2 * nleft <= C.G) ? nfull : U;
                { pg8::Gemm g{ACTM, (const bf16*)(ws + WS_W2), EFF / 2, EFF / 2, EFF / 2, nullptr, b2};
                  pg8::EpiMoeDown E{Y2, list, topg, moetab, M}; _Pragma("unroll") for (int rep_ = 0; rep_ < PR_MOE2; ++rep_) pg8::gemm_phase<pg8::EpiMoeDown, MoeOrder, true, PG8_SP2_DEFAULT, false, true, true>(C.lds + RING_OFF, g, S, E, C.wave); }
                if (EN_LEFT && 2 * nleft <= C.G && cid < 2 * nleft) { const int j = cid >> 1, kq = cid & 1; OneUnit O1; O1.S = S; O1.L = nfull + j; {
                    pg8::Gemm g{(const bf16*)((const unsigned char*)ACTM + kq * (EFF / 2)), (const bf16*)(ws + WS_W2 + kq * (EFF / 2)), EFF / 2, EFF / 2, EFF / 4, nullptr, b2};
                    pg8::EpiF32Tile E{(float*)(ws + WS_SP) + (size_t)cid * 256 * 256}; pg8::gemm_phase<pg8::EpiF32Tile, OneUnit, true, PG8_SP2_DEFAULT, false, true, true>(C.lds + RING_OFF, g, O1, E, C.wave); } }
                SEAM(20);
            }
            if (EN_MOE && IN(21)) { FRESH();
                moe_tab_build(C, list, moetab);
                const int np = moetab[8]; const long U = (long)np * 4, nfull = (U / C.G) * C.G; const int nleft = (int)(U - nfull);
                if (2 * nleft <= C.G && nleft > 0) { MoeOrder S; S.S.init(np * 256, D, EFF / 2, EFF / 2, C.G, cid); S.p0 = 0; S.estride = (size_t)D * EFF; S.absA = 1; S.tab = moetab; S.list = list; S.rowbytes = 0; S.limit = nfull;
                    phase_moe_reduce(C, S, nfull, nleft, (const float*)(ws + WS_SP), list, topg, moetab, Y2); }
                SEAM(21);
            }
            if (EN_FIN && IN(22)) { FRESH(); phase_resid<0, true, false>(C, xbf, xres, Y2, Y2 + D, 2 * D, mod + 5 * D, INF(8) + l * D, nullptr, nullptr, nullptr, nullptr, nullptr, nullptr, nullptr, nullptr, nullptr, nullptr); }
        }
    }
#undef IN
#undef SEAM
#undef INF
}
#ifndef MK_DIAG
#define MK_DIAG 0
#endif
extern "C" void kernel_launch(void* const* d_in, const int* in_sizes, int n_in, void* d_out, int out_size, void* d_ws, size_t ws_size, hipStream_t stream) {
    static int grid = 0;
    if (grid == 0) {
        if (n_in != 29 || in_sizes[0] != M * D || out_size != M * D || ws_size < WS_END) { fprintf(stderr, "kernel_launch: unexpected sizes n_in %d in0 %d out %d ws %zu\n", n_in, n_in > 0 ? in_sizes[0] : -1, out_size, ws_size); grid = -1; return; }
        int dev = 0, cus = 0, per_cu = 0;
        if (hipGetDevice(&dev) != hipSuccess || hipDeviceGetAttribute(&cus, hipDeviceAttributeMultiprocessorCount, dev) != hipSuccess) { grid = -1; return; }
        if (hipFuncSetAttribute((const void*)mega_fwd, hipFuncAttributeMaxDynamicSharedMemorySize, LDS_BYTES) != hipSuccess) { fprintf(stderr, "hipFuncSetAttribute failed\n"); grid = -1; return; }
        if (hipOccupancyMaxActiveBlocksPerMultiprocessor(&per_cu, (const void*)mega_fwd, NWAVES * 64, LDS_BYTES) != hipSuccess || per_cu < 1) fprintf(stderr, "occupancy query reports %d\n", per_cu);
        (void)hipGetLastError();
        grid = cus;
    }
    if (grid < 0) return;
    if (hipMemsetAsync((char*)d_ws + WS_CTL, 0, CTL_ZERO_BYTES, stream) != hipSuccess) return;
    Args a{};
    for (int i = 0; i < 29; ++i) a.in[i] = d_in[i];
    a.out = (float*)d_out; a.ws = (unsigned char*)d_ws;
#if MK_DIAG
    diag_run(a, grid, stream);
#else
    a.ph_lo = 0; a.ph_hi = NPHASES;
    hipLaunchKernelGGL(mega_fwd, dim3(grid), dim3(NWAVES * 64), LDS_BYTES, stream, a);
#endif
}
```
